# Optimizing an MI355X kernel written in HIP

```python
import jax, jax.numpy as jnp
from jax import lax
import numpy as np

D_MODEL = 2048
BATCH = 1
SEQ = 16384
DEPTH = 2

N_HEADS = 16
HEAD_DIM = D_MODEL // N_HEADS
N_KV_GROUPS = 4
HEADS_PER_GROUP = N_HEADS // N_KV_GROUPS
KV_WIDTH = N_KV_GROUPS * HEAD_DIM
CMP_BLOCK = 32
CMP_STRIDE = 16
SLC_BLOCK = 64
RATIO = SLC_BLOCK // CMP_STRIDE
N_SLC = 16
WINDOW = 512
Q_BLOCK = 128
CMP_HIDDEN = 2 * HEAD_DIM
ROPE_THETA = 10000.0
NSA_IN_WIDTH = N_HEADS * HEAD_DIM + 6 * KV_WIDTH + 3 * N_HEADS

POOL_WINDOWS = (2, 4, 8, 16)
N_POOL_GROUPS = 4
POOL_GROUP = D_MODEL // N_POOL_GROUPS

MEM_LEN = 256
MEM_HEADS = 4
MEM_HEAD_DIM = 128
MEM_WIDTH = MEM_HEADS * MEM_HEAD_DIM

D_FF = 5632
N_EXPERTS = 8
TOP_K = 2
MOE_BLOCK = 512

N_MIXER_A_LAYERS = (DEPTH + 1) // 2
N_MIXER_B_LAYERS = DEPTH // 2
EPS = 1e-6
NEG_INF = -1e30
FORCE = 1e9

kernel_name = "hybrid_nsa_pool_moe_trunk"


def rmsnorm(x, g):
    xf = x.astype(jnp.float32)
    r = lax.rsqrt(jnp.mean(xf * xf, axis=-1, keepdims=True) + EPS)
    return (xf * r).astype(x.dtype) * g


def rope(x, pos):
    half = x.shape[-1] // 2
    inv = ROPE_THETA ** (-jnp.arange(half, dtype=jnp.float32) / half)
    ang = pos.astype(jnp.float32)[:, None] * inv[None, :]
    shape = (1, pos.shape[0]) + (1,) * (x.ndim - 3) + (half,)
    cos = jnp.cos(ang).reshape(shape).astype(x.dtype)
    sin = jnp.sin(ang).reshape(shape).astype(x.dtype)
    x1, x2 = x[..., :half], x[..., half:]
    return jnp.concatenate([x1 * cos - x2 * sin, x2 * cos + x1 * sin], axis=-1)


def masked_softmax(s, mask):
    p = jax.nn.softmax(jnp.where(mask, s, NEG_INF), axis=-1)
    return jnp.where(mask, p, 0.0)


def swiglu(h, wg, wu, wd):
    return (jax.nn.silu(h @ wg) * (h @ wu)) @ wd


def nsa_mixer(h, w_in, gate_b, pe_k, pe_v, ck_w1, ck_w2, cv_w1, cv_w2, w_out):
    B, S, D = h.shape
    G, Hg, HD = N_KV_GROUPS, HEADS_PER_GROUP, HEAD_DIM
    nc = S // CMP_STRIDE - 1
    ns = S // SLC_BLOCK
    n_sel = min(N_SLC, ns)
    nb = S // Q_BLOCK
    pos = jnp.arange(S)

    proj = h @ w_in
    D0 = N_HEADS * HD
    cuts = [D0 + i * KV_WIDTH for i in range(7)]
    q, k_c, v_c, k_s, v_s, k_w, v_w, gates = jnp.split(proj, cuts, axis=-1)
    q = rope(q.reshape(B, S, G, Hg, HD), pos) * (HD ** -0.5)
    k_s = rope(k_s.reshape(B, S, G, HD), pos)
    v_s = v_s.reshape(B, S, G, HD)
    k_w = rope(k_w.reshape(B, S, G, HD), pos)
    v_w = v_w.reshape(B, S, G, HD)
    gates = jax.nn.sigmoid(gates + gate_b).reshape(B, S, 3, G, Hg)

    def compress(t, pe, w1, w2):
        ch = t.reshape(B, S // CMP_STRIDE, CMP_STRIDE, G, HD)
        blk = jnp.concatenate([ch[:, :-1], ch[:, 1:]], axis=2) + pe[None, None, :, None, :]
        blk = blk.transpose(0, 1, 3, 2, 4).reshape(B, nc, G, CMP_BLOCK * HD)
        return jax.nn.gelu(blk @ w1) @ w2

    cmp_pos = jnp.arange(nc) * CMP_STRIDE + CMP_BLOCK - 1
    kc = rope(compress(k_c.reshape(B, S, G, HD), pe_k, ck_w1, ck_w2), cmp_pos)
    vc = compress(v_c.reshape(B, S, G, HD), pe_v, cv_w1, cv_w2)

    kb = k_s.reshape(B, ns, SLC_BLOCK, G, HD).transpose(0, 3, 1, 2, 4)
    vb = v_s.reshape(B, ns, SLC_BLOCK, G, HD).transpose(0, 3, 1, 2, 4)
    kw = jnp.pad(k_w, ((0, 0), (WINDOW, 0), (0, 0), (0, 0)))
    vw = jnp.pad(v_w, ((0, 0), (WINDOW, 0), (0, 0), (0, 0)))
    b_ix = jnp.arange(B)[:, None, None, None]
    g_ix = jnp.arange(G)[None, :, None, None]
    slc_w = jnp.array([1.0, 2.0, 2.0, 2.0], jnp.float32)
    blk_id = jnp.arange(ns)

    def block(qb):
        t0 = qb * Q_BLOCK
        qpos = t0 + jnp.arange(Q_BLOCK)
        qq = lax.dynamic_slice_in_dim(q, t0, Q_BLOCK, axis=1)
        gg = lax.dynamic_slice_in_dim(gates, t0, Q_BLOCK, axis=1)

        s_c = jnp.einsum('bqghd,bcgd->bghqc', qq, kc).astype(jnp.float32)
        m_c = cmp_pos[None, :] <= qpos[:, None]
        p_c = masked_softmax(s_c, m_c)
        o_c = jnp.einsum('bghqc,bcgd->bqghd', p_c.astype(vc.dtype), vc)

        imp = jnp.pad(p_c.sum(axis=2), ((0, 0), (0, 0), (0, 0), (1, RATIO)))
        s_blk = (imp[..., :RATIO * ns].reshape(B, G, Q_BLOCK, ns, RATIO) @ slc_w
                 + imp[..., RATIO:RATIO * ns + 1:RATIO])
        cur = qpos // SLC_BLOCK
        valid = blk_id[None, :] * SLC_BLOCK <= qpos[:, None]
        forced = ((blk_id[None, :] == 0) | (blk_id[None, :] == cur[:, None])
                  | (blk_id[None, :] == cur[:, None] - 1))
        s_blk = jnp.where(forced, FORCE, jnp.where(valid, s_blk, NEG_INF))
        _, idx = lax.top_k(s_blk, n_sel)

        kg = kb[b_ix, g_ix, idx]
        vg = vb[b_ix, g_ix, idx]
        s_s = jnp.einsum('bqghd,bgqnkd->bghqnk', qq, kg).astype(jnp.float32)
        key_pos = idx[..., None] * SLC_BLOCK + jnp.arange(SLC_BLOCK)
        m_s = key_pos <= qpos[None, None, :, None, None]
        p_s = masked_softmax(s_s.reshape(B, G, Hg, Q_BLOCK, n_sel * SLC_BLOCK),
                             m_s[:, :, None].reshape(B, G, 1, Q_BLOCK, n_sel * SLC_BLOCK))
        o_s = jnp.einsum('bghqnk,bgqnkd->bqghd',
                         p_s.reshape(B, G, Hg, Q_BLOCK, n_sel, SLC_BLOCK).astype(vg.dtype), vg)

        kk = lax.dynamic_slice_in_dim(kw, t0, Q_BLOCK + WINDOW, axis=1)
        vv = lax.dynamic_slice_in_dim(vw, t0, Q_BLOCK + WINDOW, axis=1)
        kpos = t0 - WINDOW + jnp.arange(Q_BLOCK + WINDOW)
        diff = qpos[:, None] - kpos[None, :]
        m_w = (diff >= 0) & (diff < WINDOW) & (kpos[None, :] >= 0)
        s_w = jnp.einsum('bqghd,bkgd->bghqk', qq, kk).astype(jnp.float32)
        p_w = masked_softmax(s_w, m_w)
        o_w = jnp.einsum('bghqk,bkgd->bqghd', p_w.astype(vv.dtype), vv)

        o = (gg[:, :, 0, :, :, None] * o_c + gg[:, :, 1, :, :, None] * o_s
             + gg[:, :, 2, :, :, None] * o_w)
        return o.reshape(B, Q_BLOCK, N_HEADS * HD)

    out = lax.map(block, jnp.arange(nb))
    out = out.transpose(1, 0, 2, 3).reshape(B, S, N_HEADS * HD)
    return out @ w_out


def pool_mixer(h, w_pool, b_pool, scale):
    B, S, D = h.shape
    hf = h.astype(jnp.float32)
    c0 = jnp.concatenate([jnp.zeros((B, 1, D), jnp.float32), jnp.cumsum(hf, axis=1)], axis=1)
    pos = jnp.arange(S)
    diffs = []
    for g, w in enumerate(POOL_WINDOWS):
        lo, hi = g * POOL_GROUP, (g + 1) * POOL_GROUP
        cg = c0[:, :, lo:hi]
        lag = jnp.concatenate([jnp.zeros((B, w - 1, POOL_GROUP), jnp.float32), cg[:, :S + 1 - w]], axis=1)
        cnt = jnp.minimum(pos + 1, w).astype(jnp.float32)[None, :, None]
        diffs.append((cg[:, 1:] - lag) / cnt - hf[:, :, lo:hi])
    d = jnp.stack(diffs, axis=2).astype(h.dtype)
    z = jnp.einsum('bsgc,gce->bsge', d, w_pool) + b_pool
    return z.reshape(B, S, D) * scale


def mem_attn(h, memn, wq, wk, wv, wo):
    B, S, _ = h.shape
    M = memn.shape[1]
    q = (h @ wq).reshape(B, S, MEM_HEADS, MEM_HEAD_DIM) * (MEM_HEAD_DIM ** -0.5)
    k = (memn @ wk).reshape(B, M, MEM_HEADS, MEM_HEAD_DIM)
    v = (memn @ wv).reshape(B, M, MEM_HEADS, MEM_HEAD_DIM)
    s = jnp.einsum('bshd,bmhd->bhsm', q, k).astype(jnp.float32)
    p = jax.nn.softmax(s, axis=-1).astype(v.dtype)
    o = jnp.einsum('bhsm,bmhd->bshd', p, v).reshape(B, S, MEM_WIDTH)
    return o @ wo


def moe(h, router, wg, wu, wd):
    B, S, D = h.shape
    N = B * S
    xf = h.reshape(N, D)
    logits = (xf @ router).astype(jnp.float32)
    top_val, top_idx = lax.top_k(logits, TOP_K)
    gate = jax.nn.softmax(top_val, axis=-1)
    e_flat = top_idx.reshape(-1)
    t_flat = jnp.repeat(jnp.arange(N, dtype=jnp.int32), TOP_K)
    w_flat = gate.reshape(-1)
    order = jnp.argsort(e_flat)
    e_sorted, t_sorted, w_sorted = e_flat[order], t_flat[order], w_flat[order]
    counts = jnp.zeros((N_EXPERTS,), jnp.int32).at[e_flat].add(1)
    padded = (counts + MOE_BLOCK - 1) // MOE_BLOCK * MOE_BLOCK
    off = jnp.cumsum(counts) - counts
    poff = jnp.cumsum(padded) - padded
    pend = poff + padded
    dest = poff[e_sorted] + jnp.arange(N * TOP_K, dtype=jnp.int32) - off[e_sorted]
    n_blk = (N * TOP_K + MOE_BLOCK - 1) // MOE_BLOCK + N_EXPERTS
    cap = n_blk * MOE_BLOCK
    tok_buf = jnp.full((cap,), N, jnp.int32).at[dest].set(t_sorted)
    w_buf = jnp.zeros((cap,), jnp.float32).at[dest].set(w_sorted)
    blk_start = jnp.arange(n_blk) * MOE_BLOCK
    blk_exp = jnp.minimum(jnp.sum(pend[None, :] <= blk_start[:, None], axis=1), N_EXPERTS - 1)
    x_pad = jnp.concatenate([xf, jnp.zeros((1, D), xf.dtype)], axis=0)

    def expert_block(args):
        toks, e = args
        return swiglu(x_pad[toks], wg[e], wu[e], wd[e])

    out = lax.map(expert_block, (tok_buf.reshape(n_blk, MOE_BLOCK), blk_exp))
    out = out.reshape(cap, D) * w_buf[:, None].astype(out.dtype)
    y = jnp.zeros((N + 1, D), out.dtype).at[tok_buf].add(out)[:N]
    return y.reshape(B, S, D)


def setup_inputs(seed: int = 0) -> dict:
    key = jax.random.key(seed)
    ks = iter(jax.random.split(key, 32))
    f32 = jnp.float32
    na, nb = N_MIXER_A_LAYERS, N_MIXER_B_LAYERS

    def w(shape, fan_in):
        return jax.random.normal(next(ks), shape, f32) * (fan_in ** -0.5)

    def gain(shape):
        return 1.0 + 0.02 * jax.random.normal(next(ks), shape, f32)

    def small(shape, s):
        return s * jax.random.normal(next(ks), shape, f32)

    return {
        "x": jax.random.normal(next(ks), (BATCH, SEQ, D_MODEL), f32),
        "mem": jax.random.normal(next(ks), (BATCH, MEM_LEN, D_MODEL), f32),
        "norm_mix": gain((DEPTH, D_MODEL)),
        "norm_mem_q": gain((DEPTH, D_MODEL)),
        "norm_mem_kv": gain((DEPTH, D_MODEL)),
        "norm_ffn": gain((DEPTH, D_MODEL)),
        "norm_final": gain((D_MODEL,)),
        "nsa_w_in": w((na, D_MODEL, NSA_IN_WIDTH), D_MODEL),
        "nsa_gate_b": small((na, 3 * N_HEADS), 0.1),
        "nsa_pe_k": small((na, CMP_BLOCK, HEAD_DIM), 0.1),
        "nsa_pe_v": small((na, CMP_BLOCK, HEAD_DIM), 0.1),
        "nsa_cmp_k_w1": w((na, CMP_BLOCK * HEAD_DIM, CMP_HIDDEN), CMP_BLOCK * HEAD_DIM),
        "nsa_cmp_k_w2": w((na, CMP_HIDDEN, HEAD_DIM), CMP_HIDDEN),
        "nsa_cmp_v_w1": w((na, CMP_BLOCK * HEAD_DIM, CMP_HIDDEN), CMP_BLOCK * HEAD_DIM),
        "nsa_cmp_v_w2": w((na, CMP_HIDDEN, HEAD_DIM), CMP_HIDDEN),
        "nsa_w_out": w((na, N_HEADS * HEAD_DIM, D_MODEL), N_HEADS * HEAD_DIM),
        "pool_w": w((nb, N_POOL_GROUPS, POOL_GROUP, POOL_GROUP), POOL_GROUP),
        "pool_b": small((nb, N_POOL_GROUPS, POOL_GROUP), 0.01),
        "pool_scale": gain((nb, D_MODEL)),
        "mem_wq": w((DEPTH, D_MODEL, MEM_WIDTH), D_MODEL),
        "mem_wk": w((DEPTH, D_MODEL, MEM_WIDTH), D_MODEL),
        "mem_wv": w((DEPTH, D_MODEL, MEM_WIDTH), D_MODEL),
        "mem_wo": w((DEPTH, MEM_WIDTH, D_MODEL), MEM_WIDTH),
        "ffn_w_gate": w((na, D_MODEL, D_FF), D_MODEL),
        "ffn_w_up": w((na, D_MODEL, D_FF), D_MODEL),
        "ffn_w_down": w((na, D_FF, D_MODEL), D_FF),
        "moe_router": w((nb, D_MODEL, N_EXPERTS), D_MODEL),
        "moe_w_gate": w((nb, N_EXPERTS, D_MODEL, D_FF), D_MODEL),
        "moe_w_up": w((nb, N_EXPERTS, D_MODEL, D_FF), D_MODEL),
        "moe_w_down": w((nb, N_EXPERTS, D_FF, D_MODEL), D_FF),
    }


def reference(x, mem, norm_mix, norm_mem_q, norm_mem_kv, norm_ffn, norm_final,
              nsa_w_in, nsa_gate_b, nsa_pe_k, nsa_pe_v, nsa_cmp_k_w1, nsa_cmp_k_w2,
              nsa_cmp_v_w1, nsa_cmp_v_w2, nsa_w_out,
              pool_w, pool_b, pool_scale,
              mem_wq, mem_wk, mem_wv, mem_wo,
              ffn_w_gate, ffn_w_up, ffn_w_down,
              moe_router, moe_w_gate, moe_w_up, moe_w_down):
    h = x
    for i in range(DEPTH):
        j = i // 2
        u = rmsnorm(h, norm_mix[i])
        if i % 2 == 0:
            h = h + nsa_mixer(u, nsa_w_in[j], nsa_gate_b[j], nsa_pe_k[j], nsa_pe_v[j],
                              nsa_cmp_k_w1[j], nsa_cmp_k_w2[j], nsa_cmp_v_w1[j], nsa_cmp_v_w2[j],
                              nsa_w_out[j])
        else:
            h = h + pool_mixer(u, pool_w[j], pool_b[j], pool_scale[j])
        memn = rmsnorm(mem, norm_mem_kv[i])
        h = h + mem_attn(rmsnorm(h, norm_mem_q[i]), memn, mem_wq[i], mem_wk[i], mem_wv[i], mem_wo[i])
        u = rmsnorm(h, norm_ffn[i])
        if i % 2 == 0:
            h = h + swiglu(u, ffn_w_gate[j], ffn_w_up[j], ffn_w_down[j])
        else:
            h = h + moe(u, moe_router[j], moe_w_gate[j], moe_w_up[j], moe_w_down[j])
    return rmsnorm(h, norm_final)
```

```cpp
#include <hip/hip_runtime.h>
#include <type_traits>
#include <cstdio>
#include <cstdint>

#ifndef PROBE_SMALL
#define PROBE_SMALL 0
#endif
#ifndef NSA_PROBE
#define NSA_PROBE 0
#endif
#ifndef REPEAT_MASK
#define REPEAT_MASK 0u
#endif
#ifndef PHASE_MASK
#define PHASE_MASK 0xffffffffu
#endif
#ifndef N_LAUNCH_MODE
#define N_LAUNCH_MODE 1
#endif

#define LAS __attribute__((address_space(3)))
#define GAS __attribute__((address_space(1)))
typedef unsigned short bf16_t;
typedef short bf16x8 __attribute__((ext_vector_type(8)));
typedef float f32x4 __attribute__((ext_vector_type(4)));
typedef float f32x2 __attribute__((ext_vector_type(2)));
typedef unsigned u32x4 __attribute__((ext_vector_type(4)));
typedef unsigned u32x2 __attribute__((ext_vector_type(2)));
typedef int v4i_t __attribute__((ext_vector_type(4)));
typedef int v8i_t __attribute__((ext_vector_type(8)));

constexpr int T = 16384, D = 2048, NHEAD = 16, HD = 128, NGRP = 4;
constexpr int NSA_W = 5168;
constexpr int DFF = 5632, NEXP = 8;
constexpr int MEML = 256, MEMW = 512;
constexpr int NCMP = 1023;
constexpr float EPS = 1e-6f, NEGF = -1e30f, L2E = 1.4426950408889634f, QSCALE = 0.08838834764831845f;
constexpr int NWAVES = 8, NTHREADS = 512;

constexpr size_t MiB = 1ull << 20;
constexpr size_t alm(size_t x) { return (x + MiB - 1) / MiB * MiB; }
constexpr size_t WS_CTL = 0;
constexpr size_t WS_WIN = 1 * MiB;
constexpr size_t WS_WG = WS_WIN + alm(5120ull * 2048 * 2);
constexpr size_t WS_WOUT = WS_WG + alm(256ull * 2048 * 2);
constexpr size_t WS_MWQ = WS_WOUT + alm(2048ull * 2048 * 2);
constexpr size_t WS_MWKV = WS_MWQ + alm(2ull * 512 * 2048 * 2);
constexpr size_t WS_MWO = WS_MWKV + alm(2ull * 1024 * 2048 * 2);
constexpr size_t WS_FGU = WS_MWO + alm(2ull * 2048 * 512 * 2);
constexpr size_t WS_FD = WS_FGU + alm(11264ull * 2048 * 2);
constexpr size_t WS_MGU = WS_FD + alm(2048ull * 5632 * 2);
constexpr size_t WS_MD = WS_MGU + alm(8ull * 11264 * 2048 * 2);
constexpr size_t WS_PW = WS_MD + alm(8ull * 2048 * 5632 * 2);
constexpr size_t WS_C1 = WS_PW + alm(2048ull * 512 * 2);
constexpr size_t WS_C2 = WS_C1 + alm(2ull * 256 * 4096 * 2);
constexpr size_t WS_ROPE = WS_C2 + alm(2ull * 256 * 256 * 2);
constexpr size_t WS_H = WS_ROPE + alm((size_t)T * 64 * 8);
constexpr size_t WS_APA = WS_H + alm((size_t)T * D * 4);
constexpr size_t WS_APB = WS_APA + alm((size_t)T * D * 2);
constexpr size_t WS_MISC = WS_APB + alm((size_t)T * D * 2);
constexpr size_t WS_QM = WS_MISC;
constexpr size_t WS_OM = WS_QM + alm((size_t)T * 512 * 2);
constexpr size_t WS_MEMN = WS_OM + alm((size_t)T * 512 * 2);
constexpr size_t WS_KM = WS_MEMN + alm(2ull * 256 * 2048 * 2);
constexpr size_t WS_VMT = WS_KM + alm(2ull * 256 * 512 * 2);
constexpr size_t WS_SSQ = WS_VMT + alm(2ull * 512 * 256 * 2);
constexpr size_t WS_GATES = WS_SSQ + alm((size_t)T * 32 * 4);
constexpr size_t WS_B1 = WS_GATES + alm((size_t)T * 48 * 4);
constexpr size_t WS_MOE = WS_B1 + MiB;
constexpr size_t WS_IMP = WS_MOE + 2 * MiB;
constexpr size_t WS_R1 = WS_IMP + 32 * MiB;
constexpr int MAXSLOT = 34816;
constexpr size_t R1_BYTES = alm((size_t)MAXSLOT * DFF * 2);
constexpr size_t WS_END = WS_R1 + R1_BYTES;
constexpr size_t R_Q = 0;
constexpr size_t R_BLKK = R_Q + alm((size_t)T * 2048 * 2);
constexpr size_t R_BLKV = R_BLKK + alm(4096ull * 4096 * 2);
constexpr size_t R_KS = R_BLKV + alm(4096ull * 4096 * 2);
constexpr size_t R_VS = R_KS + alm((size_t)T * 512 * 2);
constexpr size_t R_KW = R_VS + alm((size_t)T * 512 * 2);
constexpr size_t R_VW = R_KW + alm((size_t)T * 512 * 2);
constexpr size_t R_VST = R_VW + alm((size_t)T * 512 * 2);
constexpr size_t R_VWT = R_VST + alm((size_t)T * 512 * 2);
constexpr size_t R_KC = R_VWT + alm((size_t)T * 512 * 2);
constexpr size_t R_VCT = R_KC + alm(4ull * 1024 * 128 * 2);
constexpr size_t R_HID = R_VCT + alm(4ull * 128 * 1024 * 2);
constexpr size_t R_O = R_HID + alm(2ull * 4096 * 256 * 2);
constexpr size_t R_NSA_END = R_O + alm((size_t)T * 2048 * 4);
static_assert(R_NSA_END <= R1_BYTES, "NSA overlay");
static_assert(WS_END <= 1476395008ull, "workspace");
constexpr int MO_TOPI = 0;
constexpr int MO_TOPW = MO_TOPI + T * 2;
constexpr int MO_CNTB = MO_TOPW + T * 2;
constexpr int MO_TOKS = MO_CNTB + 256 * 8;
constexpr int MO_PAIR = MO_TOKS + MAXSLOT;
constexpr int MO_GATE = MO_PAIR + MAXSLOT;
constexpr int MO_TILEE = MO_GATE + MAXSLOT;
constexpr int MO_NT = MO_TILEE + 160;
constexpr int MO_SLOT = MO_NT + 1;
static_assert((MO_SLOT + 2 * T) * 4 <= 2 * (int)MiB, "moe tables");
constexpr size_t WS_PART = WS_MGU + 8ull * 11264 * 2048;
struct MoeSplit { int F, R, sk; };
__device__ __forceinline__ MoeSplit moe_split(int ntile, int G) {
    MoeSplit m; m.F = ntile; m.R = 0; m.sk = 1;
    if (G == 256) { m.F = ntile & ~31; m.R = ntile - m.F; m.sk = m.R == 0 ? 1 : m.R <= 8 ? 4 : m.R <= 16 ? 2 : 1; if (m.sk == 1) { m.F = ntile; m.R = 0; } }
    return m;
}

constexpr int CW_BAR = 4096, CW_NSAQ = 8192;

constexpr int LDS_BYTES = 155648;
constexpr int MISC_OFF = LDS_BYTES - 256;

__device__ __forceinline__ unsigned cvt_pk_bf16(float lo, float hi) { unsigned r; asm("v_cvt_pk_bf16_f32 %0, %1, %2" : "=v"(r) : "v"(lo), "v"(hi)); return r; }
__device__ __forceinline__ bf16_t f2bf(float f) { return (bf16_t)(cvt_pk_bf16(f, 0.f) & 0xffffu); }
__device__ __forceinline__ float clamp448(float x) { return fminf(fmaxf(x, -448.f), 448.f); }
__device__ __forceinline__ unsigned pk4_fp8(float a, float b, float c, float d) {
    unsigned r = 0; r = __builtin_amdgcn_cvt_pk_fp8_f32(clamp448(a), clamp448(b), r, false); r = __builtin_amdgcn_cvt_pk_fp8_f32(clamp448(c), clamp448(d), r, true); return r; }
__device__ __forceinline__ float wave_sum(float v) {
#pragma unroll
    for (int o = 32; o >= 1; o >>= 1) v += __shfl_xor(v, o);
    return v;
}
__device__ __forceinline__ float fast_rcp(float x) { return __builtin_amdgcn_rcpf(x); }
__device__ __forceinline__ float fast_exp(float x) { return __builtin_amdgcn_exp2f(x * L2E); }
__device__ __forceinline__ float sigmoidf_(float x) { return fast_rcp(1.f + fast_exp(-x)); }
__device__ __forceinline__ float gelu_tanh(float x) { const float y = 0.7978845608028654f * (x + 0.044715f * x * x * x); const float t = 1.f - 2.f * fast_rcp(1.f + fast_exp(2.f * y)); return 0.5f * x * (1.f + t); }
#define LDS_WAIT() asm volatile("s_waitcnt lgkmcnt(0)" ::: "memory")
#define VM_WAIT() asm volatile("s_waitcnt vmcnt(0)" ::: "memory")

#define XB_TMO      128
#define XB_XCNT(j)  (256  + 64 * (j))
#define XB_XSUB(j)  (1280 + 64 * (j))
#define XB_XGEN(j)  (2304 + 64 * (j))
#define XB_TOP      3328
#define XB_TOPGEN   3392
#define XCD_BAR_WORDS 3456
#define XB_SPIN_CAP (1u << 18)
__device__ __forceinline__ unsigned xb_ld(unsigned* p)              { return __hip_atomic_load(p, __ATOMIC_RELAXED, __HIP_MEMORY_SCOPE_AGENT); }
__device__ __forceinline__ unsigned xb_add(unsigned* p, unsigned v) { return __hip_atomic_fetch_add(p, v, __ATOMIC_RELAXED, __HIP_MEMORY_SCOPE_AGENT); }
__device__ __forceinline__ unsigned xb_xcc_id() { return (unsigned)__builtin_amdgcn_s_getreg((3 << 11) | 20) & 0xFu; }
#define XB_SPIN(cond, bar) do { unsigned _sp = 0; while (cond) { __builtin_amdgcn_s_sleep(1); \
    if ((++_sp & 255u) == 0u) { if (xb_ld(&(bar)[XB_TMO])) break; if (_sp > XB_SPIN_CAP) { atomicAdd(&(bar)[XB_TMO], 1u); break; } } } } while (0)
struct XcdBarrier { unsigned* bar; unsigned x; volatile LAS unsigned* st; };
__device__ __forceinline__ XcdBarrier xcd_barrier_post(unsigned* bar, volatile LAS unsigned* st) {
    XcdBarrier b; b.bar = bar; b.x = xb_xcc_id(); b.st = st;
    if (threadIdx.x == 0) (void)xb_add(&bar[XB_XCNT(b.x)], 1u);
    return b;
}
__device__ __forceinline__ void xcd_barrier_complete(unsigned* bar, unsigned x, unsigned& nloc, unsigned& nx) {
    const unsigned G = gridDim.x * gridDim.y * gridDim.z;
    unsigned sum, cnt, mine, sp = 0u;
    for (;;) {
        sum = 0u; cnt = 0u; mine = 0u;
#pragma unroll
        for (unsigned j = 0; j < 16; ++j) { const unsigned c = xb_ld(&bar[XB_XCNT(j)]); sum += c; cnt += (c > 0u) ? 1u : 0u; mine = (j == x) ? c : mine; }
        if (sum == G) break;
        __builtin_amdgcn_s_sleep(1);
        if ((++sp & 255u) == 0u) { if (xb_ld(&bar[XB_TMO])) break; if (sp > XB_SPIN_CAP) { atomicAdd(&bar[XB_TMO], 1u); break; } }
    }
    nloc = mine > 0u ? mine : 1u; nx = cnt > 0u ? cnt : 1u;
}
__device__ __forceinline__ void xcd_barrier(const XcdBarrier& b) {
    asm volatile("s_waitcnt vmcnt(0)" ::: "memory");
    __syncthreads();
    if (threadIdx.x == 0) {
        unsigned* bar = b.bar;
        __builtin_amdgcn_s_waitcnt(0);
        unsigned nloc = b.st[0], nx = b.st[1];
        if (nloc == 0u) { xcd_barrier_complete(bar, b.x, nloc, nx); b.st[0] = nloc; b.st[1] = nx; }
        const unsigned old = xb_add(&bar[XB_XSUB(b.x)], 1u);
        const unsigned gen = old / nloc;
        if (old + 1u == (gen + 1u) * nloc) {
            __builtin_amdgcn_fence(__ATOMIC_RELEASE, "agent");
            asm volatile("s_waitcnt vmcnt(0)" ::: "memory");
            const unsigned og = xb_add(&bar[XB_TOP], 1u);
            const unsigned tg = og / nx;
            if (og + 1u == (tg + 1u) * nx) xb_add(&bar[XB_TOPGEN], 1u);
            else XB_SPIN(xb_ld(&bar[XB_TOPGEN]) == tg, bar);
            __builtin_amdgcn_fence(__ATOMIC_ACQUIRE, "agent");
            xb_add(&bar[XB_XGEN(b.x)], 1u);
            asm volatile("s_waitcnt vmcnt(0)" ::: "memory");
        } else {
            XB_SPIN(xb_ld(&bar[XB_XGEN(b.x)]) == gen, bar);
            __builtin_amdgcn_fence(__ATOMIC_ACQUIRE, "agent");
            asm volatile("s_waitcnt vmcnt(0)" ::: "memory");
        }
    }
    __syncthreads();
}

namespace gm {
constexpr int BM = 256, BK = 64, HALF = 128, HTB = HALF * BK * 2, STAGE_BYTES = 8 * HTB, NXCD = 8, WGM = 8;
__device__ __forceinline__ int lds_byte(int r, int c) { const int st = (r >> 4) * 2 + (c >> 5), rr = r & 15, cc = c & 31, ob = rr * 64 + cc * 2; return st * 1024 + (ob ^ (((ob >> 9) & 1) << 5)); }
__device__ __forceinline__ void stage_rc(int b, int& R, int& C) { const int st = b / 1024, sb = b % 1024, swz = sb ^ (((sb >> 9) & 1) << 5); R = (st >> 1) * 16 + swz / 64; C = (st & 1) * 32 + (swz % 64) / 2; }
__device__ __forceinline__ int perm32(int rho) { const int n = rho >> 4, i = rho & 15; return 8 * (i >> 2) + 4 * n + (i & 3); }

struct GUnit { const char* A; const char* B; int pm, pn, x0, x1; };

struct TileOrder {
    int nM, nN, nwg, G, c;
    __device__ __forceinline__ void init(int nM_, int nN_, int G_, int c_) { nM = nM_; nN = nN_; nwg = nM * nN; G = G_; c = c_; }
    __device__ __forceinline__ bool map(int i, int& pm, int& pn) const {
        const long L = (long)i * G + c; if (L >= nwg) return false;
        int wgid = (int)L; { const int q = nwg / NXCD, r = nwg % NXCD, xcd = wgid % NXCD, off = wgid / NXCD; wgid = (xcd < r ? xcd * (q + 1) : r * (q + 1) + (xcd - r) * q) + off; }
        const int nig = WGM * nN, gid = wgid / nig, fm = gid * WGM, gsz = (nM - fm) < WGM ? (nM - fm) : WGM;
        pm = fm + ((wgid % nig) % gsz); pn = (wgid % nig) / gsz; return true;
    }
};
struct Sched {
    TileOrder o; const char* A; const char* B; size_t a_tile, b_tile; int pn_shift; size_t a_pn_bytes; const int* tile_e; size_t b_exp;
    __device__ __forceinline__ bool next(int i, GUnit& u) const {
        int pm, pn; if (!o.map(i, pm, pn)) return false;
        u.pm = pm; u.pn = pn; u.x0 = 0; u.x1 = 0;
        u.A = A + (size_t)pm * a_tile + (size_t)(pn >> pn_shift) * a_pn_bytes;
        size_t bo = (size_t)pn * b_tile;
        if (tile_e) { const int e = __builtin_amdgcn_readfirstlane(tile_e[pm]); bo += (size_t)e * b_exp; u.x0 = e; }
        u.B = B + bo; return true;
    }
};
struct SchedSK { TileOrder o; const char* A; const char* B; size_t a_tile, b_tile; const int* tile_e; size_t b_exp; int F, R, sk, G, c;
    __device__ __forceinline__ bool next(int i, GUnit& u) const {
        const int L = i * G + c; int pm, pn, kt0 = 0, ntk = 44, ks1 = 0;
        if (L < F * 8) { if (!o.map(i, pm, pn)) return false; }
        else { const int Lt = L - F * 8; if (Lt >= R * 8 * sk) return false;
            pm = F + Lt / (8 * sk); pn = (Lt / sk) & 7; const int ks = Lt % sk; ks1 = ks + 1;
            if (sk == 4) { kt0 = 11 * ks + (ks & 1); ntk = 12 - 2 * (ks & 1); } else { kt0 = 22 * ks; ntk = 22; } }
        u.pm = pm; u.pn = pn; u.x1 = ntk | (ks1 << 8);
        const int e = __builtin_amdgcn_readfirstlane(tile_e[pm]); u.x0 = e;
        u.A = A + (size_t)pm * a_tile + (size_t)kt0 * 128; u.B = B + (size_t)pn * b_tile + (size_t)e * b_exp + (size_t)kt0 * 128; return true;
    }
};
struct OneUnit { GUnit u; bool on; __device__ __forceinline__ bool next(int i, GUnit& o) const { if (i || !on) return false; o = u; return true; } };

template <class Epi, class Sched_, bool GATHER, bool F8 = false, int SCW = 127, int SCA = 127, bool VARNT = false>
__device__ __forceinline__ void gemm_phase(LAS unsigned char* lds, const int nt_, const int lda, const int ldb, const Sched_& S, const Epi& E, const int* __restrict__ rowtab) {
    constexpr int EB = F8 ? 1 : 2;
    const int tid = threadIdx.x, wid = __builtin_amdgcn_readfirstlane(tid >> 6), lane = tid & 63, wr = wid >> 2, wc = wid & 3, fr = lane & 15, fq = lane >> 4;
    int Rr[2], Cc[2]; unsigned voffB[2];
#pragma unroll
    for (int i = 0; i < 2; ++i) { stage_rc(tid * 16 + i * 8192, Rr[i], Cc[i]); const int Rb = Epi::PERM ? ((Rr[i] & ~31) + perm32(Rr[i] & 31)) : Rr[i]; voffB[i] = (unsigned)(Rb * ldb * EB + Cc[i] * 2); }
    unsigned oA[2][2], oN[2][2];
    const size_t kstep = (size_t)(BK * 2);
    const size_t hstepB = (size_t)HALF * ldb * EB;
    const unsigned ldsw = (unsigned)wid * 1024u;
    const int aoff = lds_byte(wr * 64 + fr, fq * 8), boff = lds_byte(wc * 32 + fr, fq * 8);
#define G_SA(b, h) (((b) * 2 + (h)) * HTB)
#define G_SB(b, h) ((4 + (b) * 2 + (h)) * HTB)
#define G_STAGE(bufoff, gbase, voff) do { _Pragma("unroll") for (int _i = 0; _i < 2; ++_i) \
        __builtin_amdgcn_global_load_lds((const unsigned*)((const char*)(gbase) + (voff)[_i]), (LAS unsigned*)(lds + (bufoff) + ldsw + _i * 8192), 16, 0, 0); } while (0)
#define G_LD8(p) __builtin_shufflevector(*(const LAS v4i_t*)(p), *(const LAS v4i_t*)((p) + 1024), 0, 1, 2, 3, 4, 5, 6, 7)
#define G_LDA(dst, b, h) do { if constexpr (F8) { _Pragma("unroll") for (int m = 0; m < 4; ++m) dst##8[m] = G_LD8(lds + G_SA(b, h) + aoff + m * 2048); } \
        else { _Pragma("unroll") for (int m = 0; m < 4; ++m) _Pragma("unroll") for (int k = 0; k < 2; ++k) dst[m][k] = *(const LAS bf16x8*)(lds + G_SA(b, h) + aoff + m * 2048 + k * 1024); } } while (0)
#define G_LDB(dst, b, h) do { if constexpr (F8) { _Pragma("unroll") for (int n = 0; n < 2; ++n) dst##8[n] = G_LD8(lds + G_SB(b, h) + boff + n * 2048); } \
        else { _Pragma("unroll") for (int n = 0; n < 2; ++n) _Pragma("unroll") for (int k = 0; k < 2; ++k) dst[n][k] = *(const LAS bf16x8*)(lds + G_SB(b, h) + boff + n * 2048 + k * 1024); } } while (0)
#define G_MMA(ai, bj, At, Bt) do { __builtin_amdgcn_s_setprio(1); \
        if constexpr (F8) { _Pragma("unroll") for (int m = 0; m < 4; ++m) _Pragma("unroll") for (int n = 0; n < 2; ++n) \
            asm volatile("v_mfma_scale_f32_16x16x128_f8f6f4 %0, %1, %2, %0, %3, %4 op_sel_hi:[0,0,0]" : "+v"(acc[ai][bj][m][n]) : "v"(Bt##8[n]), "v"(At##8[m]), "v"(scw_reg), "v"(sca_reg)); } \
        else { _Pragma("unroll") for (int m = 0; m < 4; ++m) _Pragma("unroll") for (int n = 0; n < 2; ++n) _Pragma("unroll") for (int k = 0; k < 2; ++k) \
            acc[ai][bj][m][n] = __builtin_amdgcn_mfma_f32_16x16x32_bf16(Bt[n][k], At[m][k], acc[ai][bj][m][n], 0, 0, 0); } \
        __builtin_amdgcn_s_setprio(0); } while (0)
#define G_WAIT_V(n) asm volatile("s_waitcnt vmcnt(" #n ")" ::: "memory")
#define G_WAIT_L(n) asm volatile("s_waitcnt lgkmcnt(" #n ")" ::: "memory")
#define G_BAR __builtin_amdgcn_s_barrier()
#define G_SCHED __builtin_amdgcn_sched_barrier(0)
#define G_SETOFF(dst, U) do { _Pragma("unroll") for (int _h = 0; _h < 2; ++_h) _Pragma("unroll") for (int _i = 0; _i < 2; ++_i) { \
        if constexpr (GATHER) dst[_h][_i] = (unsigned)rowtab[(U).pm * 256 + _h * 128 + Rr[_i]] * (unsigned)(lda * EB) + (unsigned)(Cc[_i] * 2); \
        else dst[_h][_i] = (unsigned)((_h * 128 + Rr[_i]) * lda * EB + Cc[_i] * 2); } } while (0)
    GUnit cur, nxt; int ui = 0;
    if (!S.next(0, cur)) return;
    G_SETOFF(oA, cur);
    f32x4 acc[2][2][4][2];
#pragma unroll
    for (int a = 0; a < 2; ++a)
#pragma unroll
        for (int b = 0; b < 2; ++b)
#pragma unroll
            for (int m = 0; m < 4; ++m)
#pragma unroll
                for (int n = 0; n < 2; ++n) acc[a][b][m][n] = (f32x4){0.f, 0.f, 0.f, 0.f};
    bf16x8 At[4][2], B0[2][2], B1[2][2]; v8i_t At8[4], B08[2], B18[2]; const int scw_reg = SCW * 0x01010101, sca_reg = SCA * 0x01010101;
    const char* cA = cur.A; const char* cB = cur.B;
    G_STAGE(G_SB(0, 0), cB, voffB); G_STAGE(G_SB(0, 1), cB + hstepB, voffB); G_STAGE(G_SA(0, 0), cA, oA[0]); G_STAGE(G_SA(0, 1), cA, oA[1]);
    if (wr == 1) G_BAR;
    G_WAIT_V(2); G_BAR;
    G_STAGE(G_SB(1, 0), cB + kstep, voffB); G_STAGE(G_SA(1, 0), cA + kstep, oA[0]); G_STAGE(G_SB(1, 1), cB + hstepB + kstep, voffB);
    G_WAIT_V(6); G_BAR;
    for (;;) {
        const bool has_next = S.next(ui + 1, nxt);
        const char* nA = has_next ? nxt.A : cA; const char* nB = has_next ? nxt.B : cB;
        if constexpr (GATHER) {
            if (has_next) { G_SETOFF(oN, nxt); }
            else {
#pragma unroll
                for (int h = 0; h < 2; ++h)
#pragma unroll
                    for (int i = 0; i < 2; ++i) oN[h][i] = oA[h][i]; }
            asm volatile("" : "+v"(oN[0][0]), "+v"(oN[0][1]), "+v"(oN[1][0]), "+v"(oN[1][1]));
        }
        const int nt = VARNT ? __builtin_amdgcn_readfirstlane(cur.x1 & 255) : nt_;
        for (int t = 0; t < nt; t += 2) {
            const bool last = (t == nt - 2);
            const char* a1 = cA + (size_t)(t + 1) * kstep;
            const char* a2 = last ? nA : cA + (size_t)(t + 2) * kstep; const char* b2 = last ? nB : cB + (size_t)(t + 2) * kstep;
            const char* a3 = a2 + kstep; const char* b3 = b2 + kstep;
            G_LDB(B0, 0, 0); G_LDB(B1, 0, 1); G_SCHED; G_LDA(At, 0, 0); G_STAGE(G_SA(1, 1), a1, oA[1]);
            G_WAIT_V(8); G_WAIT_L(0); G_BAR; G_MMA(0, 0, At, B0); G_MMA(0, 1, At, B1); G_BAR; G_SCHED;
            if constexpr (GATHER) { if (last) {
#pragma unroll
                for (int h = 0; h < 2; ++h)
#pragma unroll
                    for (int i = 0; i < 2; ++i) oA[h][i] = oN[h][i]; } }
            G_LDA(At, 0, 1); G_STAGE(G_SB(0, 0), b2, voffB); G_STAGE(G_SB(0, 1), b2 + hstepB, voffB); G_STAGE(G_SA(0, 0), a2, oA[0]);
            G_WAIT_V(8); G_WAIT_L(0); G_BAR; G_MMA(1, 0, At, B0); G_MMA(1, 1, At, B1); G_BAR; G_SCHED;
            G_LDB(B0, 1, 0); G_LDB(B1, 1, 1); G_SCHED; G_LDA(At, 1, 0); G_STAGE(G_SA(0, 1), a2, oA[1]);
            G_WAIT_V(8); G_WAIT_L(0); G_BAR; G_MMA(0, 0, At, B0); G_MMA(0, 1, At, B1); G_BAR; G_SCHED;
            G_LDA(At, 1, 1); G_STAGE(G_SB(1, 0), b3, voffB); G_STAGE(G_SB(1, 1), b3 + hstepB, voffB); G_STAGE(G_SA(1, 0), a3, oA[0]);
            G_WAIT_V(8); G_WAIT_L(0); G_BAR; G_MMA(1, 0, At, B0); G_MMA(1, 1, At, B1); G_BAR; G_SCHED;
        }
        if constexpr (F8) asm volatile("s_nop 15\n\ts_nop 15" ::: "memory");
        if (wr == 0) G_BAR;
        E(acc, cur, wr, wc, fr, fq);
        if (!has_next) break;
#pragma unroll
        for (int a = 0; a < 2; ++a)
#pragma unroll
            for (int b = 0; b < 2; ++b)
#pragma unroll
                for (int m = 0; m < 4; ++m)
#pragma unroll
                    for (int n = 0; n < 2; ++n) acc[a][b][m][n] = (f32x4){0.f, 0.f, 0.f, 0.f};
        cur = nxt; cA = nA; cB = nB; ++ui;
        if (wr == 1) G_BAR;
    }
    G_WAIT_V(0);
    G_BAR;
#undef G_SA
#undef G_SB
#undef G_STAGE
#undef G_LDA
#undef G_LDB
#undef G_MMA
#undef G_LD8
#undef G_WAIT_V
#undef G_WAIT_L
#undef G_BAR
#undef G_SCHED
#undef G_SETOFF
}

typedef f32x4 Acc[2][2][4][2];

__device__ __forceinline__ float row_rstd(const float* ssqp, int row, int fq) {
    const f32x4* p = (const f32x4*)(ssqp + (size_t)row * 32 + 8 * fq); const f32x4 a = p[0], b = p[1];
    float s = (a.x + a.y) + (a.z + a.w) + (b.x + b.y) + (b.z + b.w);
    s += __shfl_xor(s, 16); s += __shfl_xor(s, 32);
    return __builtin_amdgcn_rsqf(s * (1.0f / 2048.0f) + EPS);
}

struct EpiInProj {
    static constexpr bool PERM = true;
    bf16_t* q; bf16_t* blkK; bf16_t* blkV; bf16_t* ks; bf16_t* vs; bf16_t* kw; bf16_t* vw; const float* rope;
    __device__ __forceinline__ void operator()(const Acc& acc, const GUnit& u, int wr, int wc, int fr, int fq) const {
        const int hh = wc >> 1, i0 = (wc & 1) * 32 + 8 * fq, H = 2 * u.pn + hh;
        const int seg = (H - 16) >> 2, gi = (H - 16) & 3;
        const bool isq = H < 16, rope_on = isq || seg == 2 || seg == 4;
        const float sc = isq ? QSCALE : 1.0f;
        const int row0 = u.pm * 256 + wr * 64 + fr;
        f32x4 csn[4];
        if (rope_on) { const f32x4* cs = (const f32x4*)(rope + ((size_t)row0 * 64 + i0) * 2);
#pragma unroll
            for (int p = 0; p < 4; ++p) csn[p] = cs[p]; }
#pragma unroll
        for (int ai = 0; ai < 2; ++ai)
#pragma unroll
            for (int m = 0; m < 4; ++m) {
                const int row = row0 + ai * 128 + m * 16;
                float x1[8], x2[8];
#pragma unroll
                for (int n = 0; n < 2; ++n)
#pragma unroll
                    for (int j = 0; j < 4; ++j) { x1[4 * n + j] = acc[ai][0][m][n][j]; x2[4 * n + j] = acc[ai][1][m][n][j]; }
                if (rope_on) {
                    f32x4 csv[4];
#pragma unroll
                    for (int p = 0; p < 4; ++p) csv[p] = csn[p];
                    if (ai * 4 + m < 7) { const int rown = row0 + ((ai * 4 + m + 1) >> 2) * 128 + ((ai * 4 + m + 1) & 3) * 16; const f32x4* cs = (const f32x4*)(rope + ((size_t)rown * 64 + i0) * 2);
#pragma unroll
                        for (int p = 0; p < 4; ++p) csn[p] = cs[p]; }
#pragma unroll
                    for (int p = 0; p < 4; ++p) { const f32x4 c = csv[p];
                        const float a0 = x1[2 * p], b0 = x2[2 * p], a1 = x1[2 * p + 1], b1 = x2[2 * p + 1];
                        x1[2 * p] = a0 * c.x - b0 * c.y; x2[2 * p] = b0 * c.x + a0 * c.y;
                        x1[2 * p + 1] = a1 * c.z - b1 * c.w; x2[2 * p + 1] = b1 * c.z + a1 * c.w; }
                }
                u32x4 w1, w2;
                w1.x = cvt_pk_bf16(x1[0] * sc, x1[1] * sc); w1.y = cvt_pk_bf16(x1[2] * sc, x1[3] * sc); w1.z = cvt_pk_bf16(x1[4] * sc, x1[5] * sc); w1.w = cvt_pk_bf16(x1[6] * sc, x1[7] * sc);
                w2.x = cvt_pk_bf16(x2[0] * sc, x2[1] * sc); w2.y = cvt_pk_bf16(x2[2] * sc, x2[3] * sc); w2.z = cvt_pk_bf16(x2[4] * sc, x2[5] * sc); w2.w = cvt_pk_bf16(x2[6] * sc, x2[7] * sc);
                if (isq) { bf16_t* d = q + (size_t)row * 2048 + H * 128 + i0; *(u32x4*)d = w1; *(u32x4*)(d + 64) = w2; }
                else if (seg < 2) {
                    unsigned char* blk = (unsigned char*)(seg == 0 ? blkK : blkV); const int c1 = row >> 4, i1 = row & 15;
                    u32x2 f1, f2; f1.x = pk4_fp8(4.f * x1[0], 4.f * x1[1], 4.f * x1[2], 4.f * x1[3]); f1.y = pk4_fp8(4.f * x1[4], 4.f * x1[5], 4.f * x1[6], 4.f * x1[7]);
                    f2.x = pk4_fp8(4.f * x2[0], 4.f * x2[1], 4.f * x2[2], 4.f * x2[3]); f2.y = pk4_fp8(4.f * x2[4], 4.f * x2[5], 4.f * x2[6], 4.f * x2[7]);
                    if (c1 < NCMP) { unsigned char* d = blk + (size_t)(c1 * 4 + gi) * 4096 + i1 * 128 + i0; *(u32x2*)d = f1; *(u32x2*)(d + 64) = f2; }
                    if (c1 >= 1) { unsigned char* d = blk + (size_t)((c1 - 1) * 4 + gi) * 4096 + (i1 + 16) * 128 + i0; *(u32x2*)d = f1; *(u32x2*)(d + 64) = f2; }
                } else {
                    bf16_t* buf = seg == 2 ? ks : seg == 3 ? vs : seg == 4 ? kw : vw;
                    bf16_t* d = buf + (size_t)row * 512 + gi * 128 + i0; *(u32x4*)d = w1; *(u32x4*)(d + 64) = w2;
                }
            }
    }
};
struct EpiCmp1 {
    static constexpr bool PERM = true;
    bf16_t* hid; const float* b1;
    __device__ __forceinline__ void operator()(const Acc& acc, const GUnit& u, int wr, int wc, int fr, int fq) const {
        const int row0 = u.pm * 256 + wr * 64 + fr, col0 = wc * 32 + 8 * fq; const float* bb = b1 + u.x0 * 16 * 256; bf16_t* hb = hid + (size_t)u.x0 * 4096 * 256;
#pragma unroll
        for (int bj = 0; bj < 2; ++bj) {
            f32x4 bv0 = (f32x4){0.f, 0.f, 0.f, 0.f}, bv1 = bv0;
#pragma unroll 2
            for (int kc = 0; kc < 16; ++kc) { bv0 += *(const f32x4*)(bb + kc * 256 + bj * 128 + col0); bv1 += *(const f32x4*)(bb + kc * 256 + bj * 128 + col0 + 4); }
#pragma unroll
            for (int ai = 0; ai < 2; ++ai)
#pragma unroll
                for (int m = 0; m < 4; ++m) { const int row = row0 + ai * 128 + m * 16;
                    const f32x4 v0 = acc[ai][bj][m][0] + bv0, v1 = acc[ai][bj][m][1] + bv1; u32x4 w;
                    w.x = cvt_pk_bf16(gelu_tanh(v0.x), gelu_tanh(v0.y)); w.y = cvt_pk_bf16(gelu_tanh(v0.z), gelu_tanh(v0.w));
                    w.z = cvt_pk_bf16(gelu_tanh(v1.x), gelu_tanh(v1.y)); w.w = cvt_pk_bf16(gelu_tanh(v1.z), gelu_tanh(v1.w));
                    *(u32x4*)(hb + (size_t)row * 256 + bj * 128 + col0) = w; }
        }
    }
};
struct EpiCmp2 {
    static constexpr bool PERM = true;
    bf16_t* kc; bf16_t* vct; const float* rope;
    __device__ __forceinline__ void operator()(const Acc& acc, const GUnit& u, int wr, int wc, int fr, int fq) const {
        if (wc >= 2) return;
        const int i0 = wc * 32 + 8 * fq, row0 = u.pm * 256 + wr * 64 + fr;
#pragma unroll
        for (int ai = 0; ai < 2; ++ai)
#pragma unroll
            for (int m = 0; m < 4; ++m) {
                const int row = row0 + ai * 128 + m * 16, c = row >> 2, g = row & 3; const bool ok = c < NCMP;
                float x1[8], x2[8];
#pragma unroll
                for (int n = 0; n < 2; ++n)
#pragma unroll
                    for (int j = 0; j < 4; ++j) { x1[4 * n + j] = ok ? acc[ai][0][m][n][j] : 0.f; x2[4 * n + j] = ok ? acc[ai][1][m][n][j] : 0.f; }
                if (u.x0 == 0) {
                    if (ok) { const f32x4* cs = (const f32x4*)(rope + ((size_t)(16 * c + 31) * 64 + i0) * 2);
#pragma unroll
                        for (int p = 0; p < 4; ++p) { const f32x4 cc = cs[p];
                            const float a0 = x1[2 * p], b0 = x2[2 * p], a1 = x1[2 * p + 1], b1 = x2[2 * p + 1];
                            x1[2 * p] = a0 * cc.x - b0 * cc.y; x2[2 * p] = b0 * cc.x + a0 * cc.y;
                            x1[2 * p + 1] = a1 * cc.z - b1 * cc.w; x2[2 * p + 1] = b1 * cc.z + a1 * cc.w; } }
                    u32x4 w1, w2;
                    w1.x = cvt_pk_bf16(x1[0], x1[1]); w1.y = cvt_pk_bf16(x1[2], x1[3]); w1.z = cvt_pk_bf16(x1[4], x1[5]); w1.w = cvt_pk_bf16(x1[6], x1[7]);
                    w2.x = cvt_pk_bf16(x2[0], x2[1]); w2.y = cvt_pk_bf16(x2[2], x2[3]); w2.z = cvt_pk_bf16(x2[4], x2[5]); w2.w = cvt_pk_bf16(x2[6], x2[7]);
                    bf16_t* d = kc + ((size_t)g * 1024 + c) * 128 + i0; *(u32x4*)d = w1; *(u32x4*)(d + 64) = w2;
                } else {
#pragma unroll
                    for (int j = 0; j < 8; ++j) { vct[((size_t)g * 128 + i0 + j) * 1024 + c] = f2bf(x1[j]); vct[((size_t)g * 128 + 64 + i0 + j) * 1024 + c] = f2bf(x2[j]); }
                }
            }
    }
};
struct EpiGates {
    static constexpr bool PERM = false;
    float* gates; const float* gb;
    __device__ __forceinline__ void operator()(const Acc& acc, const GUnit& u, int wr, int wc, int fr, int fq) const {
        if (wc >= 2) return;
        const int row0 = u.pm * 256 + wr * 64 + fr;
#pragma unroll
        for (int n = 0; n < 2; ++n) {
            if (wc == 1 && n == 1) continue;
            const int c = 32 * wc + 16 * n + 4 * fq; const f32x4 bv = *(const f32x4*)(gb + c);
#pragma unroll
            for (int ai = 0; ai < 2; ++ai)
#pragma unroll
                for (int m = 0; m < 4; ++m) { const int row = row0 + ai * 128 + m * 16; const f32x4 v = acc[ai][0][m][n] + bv;
                    *(f32x4*)(gates + (size_t)row * 48 + c) = (f32x4){sigmoidf_(v.x), sigmoidf_(v.y), sigmoidf_(v.z), sigmoidf_(v.w)}; }
        }
    }
};
struct EpiMemKV {
    static constexpr bool PERM = true;
    bf16_t* km; bf16_t* vmt;
    __device__ __forceinline__ void operator()(const Acc& acc, const GUnit& u, int wr, int wc, int fr, int fq) const {
        const int row0 = wr * 64 + fr, l = u.x0;
#pragma unroll
        for (int ai = 0; ai < 2; ++ai)
#pragma unroll
            for (int m = 0; m < 4; ++m) { const int row = row0 + ai * 128 + m * 16;
#pragma unroll
                for (int bj = 0; bj < 2; ++bj) { const f32x4 v0 = acc[ai][bj][m][0], v1 = acc[ai][bj][m][1];
                    if (u.pn < 2) { u32x4 w; w.x = cvt_pk_bf16(v0.x, v0.y); w.y = cvt_pk_bf16(v0.z, v0.w); w.z = cvt_pk_bf16(v1.x, v1.y); w.w = cvt_pk_bf16(v1.z, v1.w);
                        *(u32x4*)(km + ((size_t)l * 256 + row) * 512 + u.pn * 256 + bj * 128 + wc * 32 + 8 * fq) = w; }
                    else { const int d0 = (u.pn - 2) * 256 + bj * 128 + wc * 32 + 8 * fq; bf16_t* vb = vmt + (size_t)l * 512 * 256;
#pragma unroll
                        for (int j = 0; j < 4; ++j) { vb[(size_t)(d0 + j) * 256 + row] = f2bf(v0[j]); vb[(size_t)(d0 + 4 + j) * 256 + row] = f2bf(v1[j]); } }
                }
            }
    }
};
template <bool HAS_AP, bool HAS_SSQ, bool POOL, bool AP8 = false>
struct EpiRes {
    static constexpr bool PERM = false;
    const float* hin; float* hout; bf16_t* ap; const float* gain; float* ssqp; const float* bias; const float* scale;
    __device__ __forceinline__ void operator()(const Acc& acc, const GUnit& u, int wr, int wc, int fr, int fq) const {
        const int row0 = u.pm * 256 + wr * 64 + fr, col0 = u.pn * 256 + wc * 32 + 4 * fq;
        f32x4 gv[2][2], bv[2][2], sv[2][2];
#pragma unroll
        for (int bj = 0; bj < 2; ++bj)
#pragma unroll
            for (int n = 0; n < 2; ++n) { const int c = col0 + bj * 128 + n * 16;
                if (HAS_AP) gv[bj][n] = *(const f32x4*)(gain + c);
                if (POOL) { bv[bj][n] = *(const f32x4*)(bias + c); sv[bj][n] = *(const f32x4*)(scale + c); } }
        f32x4 hnx[2][2];
#pragma unroll
        for (int bj = 0; bj < 2; ++bj)
#pragma unroll
            for (int n = 0; n < 2; ++n) hnx[bj][n] = *(const f32x4*)(hin + (size_t)row0 * D + col0 + bj * 128 + n * 16);
#pragma unroll
        for (int ai = 0; ai < 2; ++ai)
#pragma unroll
            for (int m = 0; m < 4; ++m) { const int row = row0 + ai * 128 + m * 16; const size_t off = (size_t)row * D + col0; float ss = 0.f;
                f32x4 hcur[2][2];
#pragma unroll
                for (int bj = 0; bj < 2; ++bj)
#pragma unroll
                    for (int n = 0; n < 2; ++n) hcur[bj][n] = hnx[bj][n];
                if (ai * 4 + m < 7) { const int rown = row0 + ((ai * 4 + m + 1) >> 2) * 128 + ((ai * 4 + m + 1) & 3) * 16;
#pragma unroll
                    for (int bj = 0; bj < 2; ++bj)
#pragma unroll
                        for (int n = 0; n < 2; ++n) hnx[bj][n] = *(const f32x4*)(hin + (size_t)rown * D + col0 + bj * 128 + n * 16); }
#pragma unroll
                for (int bj = 0; bj < 2; ++bj)
#pragma unroll
                    for (int n = 0; n < 2; ++n) { const f32x4 hv = hcur[bj][n]; f32x4 v = acc[ai][bj][m][n];
                        if (POOL) v = (v + bv[bj][n]) * sv[bj][n];
                        const f32x4 o = hv + v; *(f32x4*)(hout + off + bj * 128 + n * 16) = o;
                        if (HAS_SSQ) ss += (o.x * o.x + o.y * o.y) + (o.z * o.z + o.w * o.w);
                        if (HAS_AP) { const f32x4 z = o * gv[bj][n];
                            if (AP8) *(unsigned*)((unsigned char*)ap + off + bj * 128 + n * 16) = pk4_fp8(4.f * z.x, 4.f * z.y, 4.f * z.z, 4.f * z.w);
                            else { u32x2 w; w.x = cvt_pk_bf16(z.x, z.y); w.y = cvt_pk_bf16(z.z, z.w); *(u32x2*)(ap + off + bj * 128 + n * 16) = w; } } }
                if (HAS_SSQ) { ss += __shfl_xor(ss, 16); ss += __shfl_xor(ss, 32); if (fq == 0) ssqp[(size_t)row * 32 + u.pn * 4 + wc] = ss; }
            }
    }
};
struct EpiMemQ {
    static constexpr bool PERM = true;
    bf16_t* qm; const float* ssqp;
    __device__ __forceinline__ void operator()(const Acc& acc, const GUnit& u, int wr, int wc, int fr, int fq) const {
        const int row0 = u.pm * 256 + wr * 64 + fr, col0 = u.pn * 256 + wc * 32 + 8 * fq;
        float rr[2][4];
#pragma unroll
        for (int ai = 0; ai < 2; ++ai)
#pragma unroll
            for (int m = 0; m < 4; ++m) rr[ai][m] = row_rstd(ssqp, row0 + ai * 128 + m * 16, fq) * QSCALE;
#pragma unroll
        for (int ai = 0; ai < 2; ++ai)
#pragma unroll
            for (int m = 0; m < 4; ++m) { const int row = row0 + ai * 128 + m * 16; const float r = rr[ai][m];
#pragma unroll
                for (int bj = 0; bj < 2; ++bj) { const f32x4 v0 = acc[ai][bj][m][0] * r, v1 = acc[ai][bj][m][1] * r; u32x4 w;
                    w.x = cvt_pk_bf16(v0.x, v0.y); w.y = cvt_pk_bf16(v0.z, v0.w); w.z = cvt_pk_bf16(v1.x, v1.y); w.w = cvt_pk_bf16(v1.z, v1.w);
                    *(u32x4*)(qm + (size_t)row * 512 + col0 + bj * 128) = w; } }
    }
};
template <bool RSTD, bool F8OUT = false>
struct EpiSwiglu {
    static constexpr bool PERM = true;
    bf16_t* act; const float* ssqp;
    __device__ __forceinline__ void operator()(const Acc& acc, const GUnit& u, int wr, int wc, int fr, int fq) const {
        const int row0 = u.pm * 256 + wr * 64 + fr, col0 = u.pn * 128 + wc * 32 + 8 * fq;
        float rr[2][4];
#pragma unroll
        for (int ai = 0; ai < 2; ++ai)
#pragma unroll
            for (int m = 0; m < 4; ++m) rr[ai][m] = RSTD ? row_rstd(ssqp, row0 + ai * 128 + m * 16, fq) : 1.f;
#pragma unroll
        for (int ai = 0; ai < 2; ++ai)
#pragma unroll
            for (int m = 0; m < 4; ++m) { const int row = row0 + ai * 128 + m * 16; const float r = rr[ai][m];
                float o[8];
#pragma unroll
                for (int n = 0; n < 2; ++n)
#pragma unroll
                    for (int j = 0; j < 4; ++j) { const float g = acc[ai][0][m][n][j] * r, uu = acc[ai][1][m][n][j] * r; o[4 * n + j] = g * sigmoidf_(g) * uu; }
                if constexpr (F8OUT) { u32x2 w; w.x = pk4_fp8(16.f * o[0], 16.f * o[1], 16.f * o[2], 16.f * o[3]); w.y = pk4_fp8(16.f * o[4], 16.f * o[5], 16.f * o[6], 16.f * o[7]);
                    *(u32x2*)((unsigned char*)act + (size_t)row * DFF + col0) = w; }
                else { u32x4 w; w.x = cvt_pk_bf16(o[0], o[1]); w.y = cvt_pk_bf16(o[2], o[3]); w.z = cvt_pk_bf16(o[4], o[5]); w.w = cvt_pk_bf16(o[6], o[7]);
                    *(u32x4*)(act + (size_t)row * DFF + col0) = w; } }
    }
};
struct EpiMoeDown {
    static constexpr bool PERM = true;
    bf16_t* ybuf; const int* pair; const float* gate; float* part; int tail_row0, part_rows;
    __device__ __forceinline__ void operator()(const Acc& acc, const GUnit& u, int wr, int wc, int fr, int fq) const {
        const int row0 = u.pm * 256 + wr * 64 + fr, col0 = u.pn * 256 + wc * 32 + 8 * fq;
        int prs[2][4]; float gs[2][4];
#pragma unroll
        for (int ai = 0; ai < 2; ++ai)
#pragma unroll
            for (int m = 0; m < 4; ++m) { prs[ai][m] = pair[row0 + ai * 128 + m * 16]; gs[ai][m] = gate[row0 + ai * 128 + m * 16]; }
        const int ks1 = __builtin_amdgcn_readfirstlane(u.x1 >> 8);
        if (ks1) {
            float* pb = part + ((size_t)(ks1 - 1) * part_rows + (row0 - tail_row0)) * D + col0;
#pragma unroll
            for (int ai = 0; ai < 2; ++ai)
#pragma unroll
                for (int m = 0; m < 4; ++m) { const float g = gs[ai][m];
                    if (prs[ai][m] >= 0) {
#pragma unroll
                        for (int bj = 0; bj < 2; ++bj) { float* q = pb + (size_t)(ai * 128 + m * 16) * D + bj * 128; *(f32x4*)q = acc[ai][bj][m][0] * g; *(f32x4*)(q + 4) = acc[ai][bj][m][1] * g; } } }
            return;
        }
#pragma unroll
        for (int ai = 0; ai < 2; ++ai)
#pragma unroll
            for (int m = 0; m < 4; ++m) { const int pr = prs[ai][m]; const float g = gs[ai][m];
                if (pr >= 0) {
#pragma unroll
                    for (int bj = 0; bj < 2; ++bj) { const f32x4 v0 = acc[ai][bj][m][0] * g, v1 = acc[ai][bj][m][1] * g; u32x4 w;
                        w.x = cvt_pk_bf16(v0.x, v0.y); w.y = cvt_pk_bf16(v0.z, v0.w); w.z = cvt_pk_bf16(v1.x, v1.y); w.w = cvt_pk_bf16(v1.z, v1.w);
                        *(u32x4*)(ybuf + (size_t)pr * D + col0 + bj * 128) = w; } } }
    }
};
}

struct CT { bf16x8 q[4]; f32x4 o[8]; float m, l; };
__device__ __forceinline__ f32x4 mfma16(bf16x8 a, bf16x8 b, f32x4 c) { return __builtin_amdgcn_mfma_f32_16x16x32_bf16(a, b, c, 0, 0, 0); }
__device__ __forceinline__ void ct_init(CT& c) {
#pragma unroll
    for (int d = 0; d < 8; ++d) c.o[d] = (f32x4){0.f, 0.f, 0.f, 0.f};
    c.m = NEGF; c.l = 0.f;
}
template <int NCT>
__device__ __forceinline__ void att_scores(const CT (&ct)[NCT], const bf16_t* Kp, int kstr, int lane, f32x4 (&s)[NCT][2]) {
    const int i = lane & 15, g = lane >> 4;
    const bf16_t* k0 = Kp + (size_t)(8 * (i >> 2) + (i & 3)) * kstr + 8 * g;
#pragma unroll
    for (int c = 0; c < NCT; ++c) { s[c][0] = (f32x4){0.f, 0.f, 0.f, 0.f}; s[c][1] = (f32x4){0.f, 0.f, 0.f, 0.f}; }
#pragma unroll
    for (int ks = 0; ks < 4; ++ks) {
        const bf16x8 ka = *(const bf16x8*)(k0 + 32 * ks), kb = *(const bf16x8*)(k0 + (size_t)4 * kstr + 32 * ks);
#pragma unroll
        for (int c = 0; c < NCT; ++c) { s[c][0] = mfma16(ka, ct[c].q[ks], s[c][0]); s[c][1] = mfma16(kb, ct[c].q[ks], s[c][1]); }
    }
}
__device__ __forceinline__ bf16x8 att_softmax(CT& c, const f32x4 (&s)[2], const bool (&valid)[8], bool do_pv) {
    float sv[8];
#pragma unroll
    for (int e = 0; e < 8; ++e) sv[e] = valid[e] ? s[e >> 2][e & 3] : NEGF;
    float mx = fmaxf(fmaxf(fmaxf(sv[0], sv[1]), fmaxf(sv[2], sv[3])), fmaxf(fmaxf(sv[4], sv[5]), fmaxf(sv[6], sv[7])));
    mx = fmaxf(mx, __shfl_xor(mx, 16)); mx = fmaxf(mx, __shfl_xor(mx, 32));
    const float mnew = fmaxf(c.m, mx), alpha = __builtin_amdgcn_exp2f((c.m - mnew) * L2E);
    float p[8], ps = 0.f;
#pragma unroll
    for (int e = 0; e < 8; ++e) { p[e] = valid[e] ? __builtin_amdgcn_exp2f((sv[e] - mnew) * L2E) : 0.f; ps += p[e]; }
    c.l = c.l * alpha + ps; c.m = mnew;
    if (do_pv) {
#pragma unroll
        for (int d = 0; d < 8; ++d) c.o[d] = c.o[d] * alpha;
    }
    u32x4 w; w.x = cvt_pk_bf16(p[0], p[1]); w.y = cvt_pk_bf16(p[2], p[3]); w.z = cvt_pk_bf16(p[4], p[5]); w.w = cvt_pk_bf16(p[6], p[7]);
    return __builtin_bit_cast(bf16x8, w);
}
template <int NCT>
__device__ __forceinline__ void att_pv(CT (&ct)[NCT], const bf16x8 (&pb)[NCT], const bf16_t* Vp, int vstr, int lane) {
    const int i = lane & 15, g = lane >> 4;
    const bf16_t* v0 = Vp + (size_t)i * vstr + 8 * g;
#pragma unroll
    for (int d = 0; d < 8; ++d) { const bf16x8 vf = *(const bf16x8*)(v0 + (size_t)(16 * d) * vstr);
#pragma unroll
        for (int c = 0; c < NCT; ++c) ct[c].o[d] = mfma16(vf, pb[c], ct[c].o[d]); }
}
__device__ __forceinline__ float ct_lsum(const CT& c) { float l = c.l; l += __shfl_xor(l, 16); l += __shfl_xor(l, 32); return l; }

struct Args { const float* in[30]; float* out; unsigned char* ws; int ph_lo, ph_hi; };

struct TrDesc { const float* src; unsigned char* dst; int ldw, ldt, nvalid; float scale; };
__device__ __forceinline__ void tr_load(const TrDesc& d, float (&v)[32], int lane) {
    const int nn = lane & 31, kh = lane >> 5; const bool ok = nn < d.nvalid; const float* W = d.src + (size_t)kh * d.ldw + (ok ? nn : 0);
#pragma unroll
    for (int i = 0; i < 32; ++i) v[i] = W[(size_t)(2 * i) * d.ldw];
    if (!ok) {
#pragma unroll
        for (int i = 0; i < 32; ++i) v[i] = 0.f; }
}
__device__ __forceinline__ void tr_store(const TrDesc& d, const float (&v)[32], LAS float* scr, int lane) {
    const int nn = lane & 31, kh = lane >> 5;
#pragma unroll
    for (int i = 0; i < 32; ++i) scr[(2 * i + kh) * 33 + nn] = v[i];
    LDS_WAIT(); asm volatile("" ::: "memory");
    if (d.scale != 0.f) {
        const int c = lane & 3; const float sc = d.scale;
#pragma unroll
        for (int j = 0; j < 2; ++j) { const int n = (lane >> 2) + 16 * j; const LAS float* s = scr + (16 * c) * 33 + n;
            u32x4 o; o.x = pk4_fp8(sc * s[0 * 33], sc * s[1 * 33], sc * s[2 * 33], sc * s[3 * 33]); o.y = pk4_fp8(sc * s[4 * 33], sc * s[5 * 33], sc * s[6 * 33], sc * s[7 * 33]);
            o.z = pk4_fp8(sc * s[8 * 33], sc * s[9 * 33], sc * s[10 * 33], sc * s[11 * 33]); o.w = pk4_fp8(sc * s[12 * 33], sc * s[13 * 33], sc * s[14 * 33], sc * s[15 * 33]);
            *(u32x4*)(d.dst + (size_t)n * d.ldt + 16 * c) = o; }
    } else {
        const int c = lane & 7; bf16_t* WT = (bf16_t*)d.dst;
#pragma unroll
        for (int j = 0; j < 4; ++j) { const int n = (lane >> 3) + 8 * j; const LAS float* s = scr + (8 * c) * 33 + n;
            u32x4 o; o.x = cvt_pk_bf16(s[0 * 33], s[1 * 33]); o.y = cvt_pk_bf16(s[2 * 33], s[3 * 33]); o.z = cvt_pk_bf16(s[4 * 33], s[5 * 33]); o.w = cvt_pk_bf16(s[6 * 33], s[7 * 33]);
            *(u32x4*)(WT + (size_t)n * d.ldt + 8 * c) = o; }
    }
    LDS_WAIT(); asm volatile("" ::: "memory");
}
__device__ __forceinline__ int map_in(int n0) { const int H = n0 >> 7, d = n0 & 127; return 256 * (H >> 1) + 128 * (d >> 6) + 64 * (H & 1) + (d & 63); }
__device__ __forceinline__ int map_gu(int c, int up) { return 256 * (c >> 7) + 128 * up + (c & 127); }
__device__ __forceinline__ int map_c2(int d) { return 128 * (d >> 6) + (d & 63); }
__device__ __forceinline__ void rms_row_bf16(const float* xrow, const float* gain, bf16_t* orow, int lane) {
    const f32x4* xr = (const f32x4*)xrow + lane; f32x4 v[8]; float s = 0.f;
#pragma unroll
    for (int j = 0; j < 8; ++j) { v[j] = xr[64 * j]; s += (v[j].x * v[j].x + v[j].y * v[j].y) + (v[j].z * v[j].z + v[j].w * v[j].w); }
    const float r = __builtin_amdgcn_rsqf(wave_sum(s) * (1.0f / D) + EPS);
    const f32x4* gr = (const f32x4*)gain + lane; u32x2* o8 = (u32x2*)orow + lane;
#pragma unroll
    for (int j = 0; j < 8; ++j) { const f32x4 g = gr[64 * j]; const f32x4 z = (v[j] * r) * g; u32x2 w; w.x = cvt_pk_bf16(z.x, z.y); w.y = cvt_pk_bf16(z.z, z.w); o8[64 * j] = w; }
}
__device__ __forceinline__ void rms_row_f8(const float* xrow, const float* gain, unsigned char* orow, int lane) {
    const f32x4* xr = (const f32x4*)xrow + lane; f32x4 v[8]; float s = 0.f;
#pragma unroll
    for (int j = 0; j < 8; ++j) { v[j] = xr[64 * j]; s += (v[j].x * v[j].x + v[j].y * v[j].y) + (v[j].z * v[j].z + v[j].w * v[j].w); }
    const float r = __builtin_amdgcn_rsqf(wave_sum(s) * (1.0f / D) + EPS) * 4.0f;
    const f32x4* gr = (const f32x4*)gain + lane; unsigned* o4 = (unsigned*)orow + lane;
#pragma unroll
    for (int j = 0; j < 8; ++j) { const f32x4 g = gr[64 * j]; const f32x4 z = (v[j] * r) * g; o4[64 * j] = pk4_fp8(z.x, z.y, z.z, z.w); }
}
__device__ __forceinline__ void tr_decode(const Args& a, int it, TrDesc& dd) {
    unsigned char* ws = a.ws;
    constexpr int I_MOE = 45056, I_F = 5632, I_IN = 5120, I_ING = 64, I_OUT = 2048, I_M4 = 1024, I_PW = 512, I_C1 = 512, I_C2 = 16;
        const float* src; int ldw, nvalid = 32, ldt; unsigned char* dst; float scale = 0.f;
        int r = it;
        if (r < 3 * I_MOE) { const int which = r / I_MOE, rr = r % I_MOE, e = rr / 5632, q = rr % 5632;
            if (which < 2) { const int kb = q / 176, nb = q % 176;
                src = a.in[27 + which] + (size_t)e * 2048 * 5632 + (size_t)(kb * 64) * 5632 + nb * 32; ldw = 5632; scale = 64.f; dst = ws + WS_MGU + ((size_t)e * 11264 + map_gu(nb * 32, which)) * 2048 + kb * 64; ldt = 2048; }
            else { const int kb = q / 64, nb = q % 64;
                src = a.in[29] + (size_t)e * 5632 * 2048 + (size_t)(kb * 64) * 2048 + nb * 32; ldw = 2048; scale = 128.f; dst = ws + WS_MD + ((size_t)e * 2048 + nb * 32) * 5632 + kb * 64; ldt = 5632; } }
        else if ((r -= 3 * I_MOE) < 2 * I_F) { const int which = r / I_F, q = r % I_F, kb = q / 176, nb = q % 176;
            src = a.in[23 + which] + (size_t)(kb * 64) * 5632 + nb * 32; ldw = 5632; dst = ws + WS_FGU + ((size_t)map_gu(nb * 32, which) * 2048 + kb * 64) * 2; ldt = 2048; }
        else if ((r -= 2 * I_F) < I_F) { const int kb = r / 64, nb = r % 64;
            src = a.in[25] + (size_t)(kb * 64) * 2048 + nb * 32; ldw = 2048; scale = 128.f; dst = ws + WS_FD + (size_t)(nb * 32) * 5632 + kb * 64; ldt = 5632; }
        else if ((r -= I_F) < I_IN) { const int kb = r / 160, nb = r % 160;
            src = a.in[7] + (size_t)(kb * 64) * NSA_W + nb * 32; ldw = NSA_W; scale = 64.f; dst = ws + WS_WIN + (size_t)map_in(nb * 32) * 2048 + kb * 64; ldt = 2048; }
        else if ((r -= I_IN) < I_ING) { const int kb = r / 2, nb = r % 2;
            src = a.in[7] + (size_t)(kb * 64) * NSA_W + 5120 + nb * 32; ldw = NSA_W; nvalid = 48 - 32 * nb; scale = 64.f; dst = ws + WS_WG + (size_t)(nb * 32) * 2048 + kb * 64; ldt = 2048; }
        else if ((r -= I_ING) < I_OUT) { const int kb = r / 64, nb = r % 64;
            src = a.in[15] + (size_t)(kb * 64) * 2048 + nb * 32; ldw = 2048; scale = 64.f; dst = ws + WS_WOUT + (size_t)(nb * 32) * 2048 + kb * 64; ldt = 2048; }
        else if ((r -= I_OUT) < I_M4) { const int l = r / 512, q = r % 512, kb = q / 16, nb = q % 16;
            src = a.in[19] + (size_t)l * 2048 * 512 + (size_t)(kb * 64) * 512 + nb * 32; ldw = 512; scale = 64.f; dst = ws + WS_MWQ + ((size_t)l * 512 + nb * 32) * 2048 + kb * 64; ldt = 2048; }
        else if ((r -= I_M4) < 2 * I_M4) { const int which = r / I_M4, rr = r % I_M4, l = rr / 512, q = rr % 512, kb = q / 16, nb = q % 16;
            src = a.in[20 + which] + (size_t)l * 2048 * 512 + (size_t)(kb * 64) * 512 + nb * 32; ldw = 512; dst = ws + WS_MWKV + (((size_t)l * 1024 + which * 512 + nb * 32) * 2048 + kb * 64) * 2; ldt = 2048; }
        else if ((r -= 2 * I_M4) < I_M4) { const int l = r / 512, q = r % 512, kb = q / 64, nb = q % 64;
            src = a.in[22] + (size_t)l * 512 * 2048 + (size_t)(kb * 64) * 2048 + nb * 32; ldw = 2048; dst = ws + WS_MWO + (((size_t)l * 2048 + nb * 32) * 512 + kb * 64) * 2; ldt = 512; }
        else if ((r -= I_M4) < I_PW) { const int g = r / 128, q = r % 128, kb = q / 16, nb = q % 16;
            src = a.in[16] + (size_t)g * 512 * 512 + (size_t)(kb * 64) * 512 + nb * 32; ldw = 512; dst = ws + WS_PW + (((size_t)g * 512 + nb * 32) * 512 + kb * 64) * 2; ldt = 512; }
        else if ((r -= I_PW) < 2 * I_C1) { const int kv = r / I_C1, q = r % I_C1, kb = q / 8, nb = q % 8;
            src = a.in[kv ? 13 : 11] + (size_t)(kb * 64) * 256 + nb * 32; ldw = 256; scale = 64.f; dst = ws + WS_C1 + ((size_t)kv * 256 + nb * 32) * 4096 + kb * 64; ldt = 4096; }
        else { r -= 2 * I_C1; const int kv = r / I_C2, q = r % I_C2, kb = q / 4, nb = q % 4;
            src = a.in[kv ? 14 : 12] + (size_t)(kb * 64) * 128 + nb * 32; ldw = 128; dst = ws + WS_C2 + (((size_t)kv * 256 + map_c2(nb * 32)) * 256 + kb * 64) * 2; ldt = 256; }
        dd.src = src; dd.dst = dst; dd.ldw = ldw; dd.ldt = ldt; dd.nvalid = nvalid; dd.scale = scale;
}
constexpr int TRN_MOE = 90112 + 29056;
constexpr int TRN_TOTAL = TRN_MOE + 16896 + 2048 + 1024 + 1024 + 512, TRP0_TOTAL = 5184 + 2048 + 1056;
__device__ __forceinline__ int tr_map_nsa(int n) { n -= TRN_MOE; return n < 0 ? n + TRN_MOE : n < 16896 ? 135168 + n : n < 18944 ? 157248 + (n - 16896) : n < 19968 ? 159296 + (n - 18944) : n < 20992 ? 162368 + (n - 19968) : 163392 + (n - 20992); }
__device__ __forceinline__ int tr_map_p0(int v) { return v < 5184 ? 152064 + v : v < 7232 ? 160320 + (v - 5184) : 163904 + (v - 7232); }
template <bool NSAMAP>
__device__ __forceinline__ void tr_run(const Args& a, LAS float* scr, int n0, int n1, int w, int nw, int lane) {
    int it = n0 + w; TrDesc dc; float vc[32];
    dc.src = nullptr; dc.dst = nullptr; dc.ldw = 0; dc.ldt = 0; dc.nvalid = 0; dc.scale = 0.f;
    if (it < n1) { tr_decode(a, NSAMAP ? tr_map_nsa(it) : tr_map_p0(it), dc); tr_load(dc, vc, lane); }
    while (it < n1) {
        const int itn = it + nw; TrDesc dn = dc; float vn[32];
        if (itn < n1) { tr_decode(a, NSAMAP ? tr_map_nsa(itn) : tr_map_p0(itn), dn); tr_load(dn, vn, lane); }
        else {
#pragma unroll
            for (int i = 0; i < 32; ++i) vn[i] = 0.f; }
        tr_store(dc, vc, scr, lane);
        dc = dn;
#pragma unroll
        for (int i = 0; i < 32; ++i) vc[i] = vn[i];
        it = itn;
    }
}
constexpr int TR_NDEF = 45056 - 29056, TR_D0 = 3 * 45056 - TR_NDEF, TR_D1 = TR_D0, TR_D2 = TR_D1 + 8000, TR_D3 = 3 * 45056;
constexpr int TR_PER_UNIT = 144;
static_assert(1024 * TR_PER_UNIT >= TRN_TOTAL, "deferred ranges");
__device__ __forceinline__ void tr_moe_range(const Args& a, LAS float* scr, int r0, int r1, int w, int nw, int lane) {
    auto decode = [&](int r, TrDesc& dd) { const int which = r / 45056, rr = r % 45056, e = rr / 5632, q = rr % 5632; dd.nvalid = 32;
        if (which < 2) { const int kb = q / 176, nb = q % 176;
            dd.src = a.in[27 + which] + (size_t)e * 2048 * 5632 + (size_t)(kb * 64) * 5632 + nb * 32; dd.ldw = 5632; dd.scale = 64.f; dd.dst = a.ws + WS_MGU + ((size_t)e * 11264 + map_gu(nb * 32, which)) * 2048 + kb * 64; dd.ldt = 2048; }
        else { const int kb = q / 64, nb = q % 64;
            dd.src = a.in[29] + (size_t)e * 5632 * 2048 + (size_t)(kb * 64) * 2048 + nb * 32; dd.ldw = 2048; dd.scale = 128.f; dd.dst = a.ws + WS_MD + ((size_t)e * 2048 + nb * 32) * 5632 + kb * 64; dd.ldt = 5632; } };
    int it = r0 + w; TrDesc dc; float vc[32];
    if (it < r1) { decode(it, dc); tr_load(dc, vc, lane); }
    while (it < r1) {
        const int itn = it + nw; TrDesc dn = dc; float vn[32];
        if (itn < r1) { decode(itn, dn); tr_load(dn, vn, lane); }
        else {
#pragma unroll
            for (int i = 0; i < 32; ++i) vn[i] = 0.f; }
        tr_store(dc, vc, scr, lane);
        dc = dn;
#pragma unroll
        for (int i = 0; i < 32; ++i) vc[i] = vn[i];
        it = itn;
    }
}
__device__ __forceinline__ void phase_prologue(const Args& a, LAS unsigned char* lds, int gw, int ngw, int wave, int lane) {
    unsigned char* ws = a.ws;
    LAS float* scr = (LAS float*)(lds + wave * 8448);
    constexpr int I_MOE = 45056, I_F = 5632, I_IN = 5120, I_ING = 64, I_OUT = 2048, I_M4 = 1024, I_PW = 512, I_C1 = 512, I_C2 = 16;
    constexpr int NITEMS = 3 * I_MOE + 3 * I_F + I_IN + I_ING + I_OUT + 4 * I_M4 + I_PW + 2 * I_C1 + 2 * I_C2;
    auto decode = [&](int it, TrDesc& dd) { tr_decode(a, it, dd); };
    tr_run<false>(a, scr, 0, TRP0_TOTAL, gw, ngw, lane);
    for (int m = gw; m < T; m += ngw) rms_row_f8(a.in[0] + (size_t)m * D, a.in[2], ws + WS_APA + (size_t)m * D, lane);
    for (int m = gw; m < 2 * MEML; m += ngw) { const int l = m >> 8, r = m & 255; rms_row_bf16(a.in[1] + (size_t)r * D, a.in[4] + l * D, (bf16_t*)(ws + WS_MEMN) + (size_t)m * D, lane); }
    { float* rope = (float*)(ws + WS_ROPE);
      for (int idx = gw * 64 + lane; idx < T * 64; idx += ngw * 64) { const int pos = idx >> 6, i = idx & 63;
          const float inv = (float)exp(-(double)i * (9.210340371976184 / 64.0)); const float ang = (float)pos * inv; double sn, cs; sincos((double)ang, &sn, &cs);
          *(f32x2*)(rope + (size_t)idx * 2) = (f32x2){(float)cs, (float)sn}; } }
    if (gw < 32) { const int kv = gw >> 4, kc = gw & 15; const float* pe = a.in[kv ? 10 : 9] + kc * 256; const float* w1 = a.in[kv ? 13 : 11] + (size_t)kc * 256 * 256; f32x4 s = (f32x4){0.f, 0.f, 0.f, 0.f};
#pragma unroll 8
        for (int k = 0; k < 256; ++k) s += pe[k] * *(const f32x4*)(w1 + (size_t)k * 256 + 4 * lane);
        *(f32x4*)((float*)(ws + WS_B1) + (kv * 16 + kc) * 256 + 4 * lane) = s; }
}

__device__ __forceinline__ void vtrans_item(const bf16_t* __restrict__ src, bf16_t* __restrict__ dst, LAS bf16_t* scr, int lane) {
    const int ch = lane & 15, tr = lane >> 4;
    u32x4 v[16];
#pragma unroll
    for (int it = 0; it < 16; ++it) v[it] = *(const u32x4*)(src + (size_t)(tr + 4 * it) * 512 + ch * 8);
#pragma unroll
    for (int it = 0; it < 16; ++it) { const int t = tr + 4 * it; const unsigned w[4] = {v[it].x, v[it].y, v[it].z, v[it].w};
#pragma unroll
        for (int j = 0; j < 4; ++j) { scr[(ch * 8 + 2 * j) * 72 + t] = (bf16_t)(w[j] & 0xffffu); scr[(ch * 8 + 2 * j + 1) * 72 + t] = (bf16_t)(w[j] >> 16); } }
    LDS_WAIT(); asm volatile("" ::: "memory");
    const int c8 = lane & 7, dr = lane >> 3;
#pragma unroll
    for (int rr = 0; rr < 16; ++rr) { const int d = rr * 8 + dr; const u32x4 o = *(const LAS u32x4*)(scr + d * 72 + c8 * 8); *(u32x4*)(dst + (size_t)d * T + c8 * 8) = o; }
    LDS_WAIT(); asm volatile("" ::: "memory");
}

constexpr int NSA_MK = 131072, NSA_WUN = 133120, NSA_BUN = 133632, NSA_JL = 133696, NSA_NJ = 133952;
__device__ __forceinline__ float red16_max(float m) { auto rr = __builtin_amdgcn_permlane16_swap(__float_as_uint(m), __float_as_uint(m), false, false); return fmaxf(__uint_as_float(rr[0]), __uint_as_float(rr[1])); }
__device__ __forceinline__ float red32_max(float m) { auto rr = __builtin_amdgcn_permlane32_swap(__float_as_uint(m), __float_as_uint(m), false, false); return fmaxf(__uint_as_float(rr[0]), __uint_as_float(rr[1])); }
__device__ __forceinline__ float red16_sum(float m) { auto rr = __builtin_amdgcn_permlane16_swap(__float_as_uint(m), __float_as_uint(m), false, false); return __uint_as_float(rr[0]) + __uint_as_float(rr[1]); }
__device__ __forceinline__ float red32_sum(float m) { auto rr = __builtin_amdgcn_permlane32_swap(__float_as_uint(m), __float_as_uint(m), false, false); return __uint_as_float(rr[0]) + __uint_as_float(rr[1]); }
#define DPP_I(x, ctrl) __builtin_amdgcn_mov_dpp((x), (ctrl), 0xF, 0xF, true)
__device__ __forceinline__ float wave_max_dpp(float v) {
    v = fmaxf(v, __builtin_bit_cast(float, DPP_I(__builtin_bit_cast(int, v), 0xB1)));
    v = fmaxf(v, __builtin_bit_cast(float, DPP_I(__builtin_bit_cast(int, v), 0x4E)));
    v = fmaxf(v, __builtin_bit_cast(float, DPP_I(__builtin_bit_cast(int, v), 0x141)));
    v = fmaxf(v, __builtin_bit_cast(float, DPP_I(__builtin_bit_cast(int, v), 0x140)));
    return red32_max(red16_max(v));
}
__device__ __forceinline__ unsigned umin_(unsigned a, unsigned b) { return a < b ? a : b; }
__device__ __forceinline__ unsigned wave_min_dpp(unsigned v) {
    v = umin_(v, (unsigned)DPP_I((int)v, 0xB1)); v = umin_(v, (unsigned)DPP_I((int)v, 0x4E)); v = umin_(v, (unsigned)DPP_I((int)v, 0x141)); v = umin_(v, (unsigned)DPP_I((int)v, 0x140));
    { auto rr = __builtin_amdgcn_permlane16_swap(v, v, false, false); v = umin_(rr[0], rr[1]); }
    { auto rr = __builtin_amdgcn_permlane32_swap(v, v, false, false); v = umin_(rr[0], rr[1]); }
    return v;
}
__device__ __forceinline__ float quad_sum(float v) {
    int x = __builtin_bit_cast(int, v);
    float a = v + __builtin_bit_cast(float, __builtin_amdgcn_mov_dpp(x, 0xB1, 0xF, 0xF, true));
    int y = __builtin_bit_cast(int, a);
    return a + __builtin_bit_cast(float, __builtin_amdgcn_mov_dpp(y, 0x4E, 0xF, 0xF, true));
}
struct StageLane { unsigned kp[2], vp[2]; };
__device__ __forceinline__ StageLane stage_lane(int wave, int lane) {
    StageLane L;
#pragma unroll
    for (int k = 0; k < 2; ++k) { const int rho = 4 * (2 * wave + k) + (lane >> 4), pos = lane & 15, i = rho & 15, c = pos ^ i, key = 32 * (rho >> 5) + 8 * (i >> 2) + (i & 3) + 4 * ((rho >> 4) & 1);
        L.kp[k] = (unsigned)key | ((unsigned)c << 8);
        const int r = 8 * (2 * wave + k) + (lane >> 3), pv = lane & 7, cv = pv ^ ((r >> 1) & 7); L.vp[k] = (unsigned)r | ((unsigned)cv << 8); }
    return L;
}
__device__ __forceinline__ void nsa_stage(LAS unsigned char* buf, const bf16_t* Kp, int kshift, const bf16_t* Vp, int vshift, bool doV, int wave, const StageLane& L) {
#pragma unroll
    for (int k = 0; k < 2; ++k) { const unsigned off = ((L.kp[k] & 255u) << kshift) + ((L.kp[k] >> 8) << 4);
        __builtin_amdgcn_global_load_lds((const unsigned*)((const char*)Kp + off), (LAS unsigned*)(buf + (2 * wave + k) * 1024), 16, 0, 0); }
    if (doV) {
#pragma unroll
        for (int k = 0; k < 2; ++k) { const unsigned off = ((L.vp[k] & 255u) << vshift) + ((L.vp[k] >> 8) << 4);
            __builtin_amdgcn_global_load_lds((const unsigned*)((const char*)Vp + off), (LAS unsigned*)(buf + 16384 + (2 * wave + k) * 1024), 16, 0, 0); } }
}
__device__ __forceinline__ bf16x8 lds_k(const LAS unsigned char* buf, int h, int tt, int ks, int i, int g) { return *(const LAS bf16x8*)(buf + (16 * (2 * h + tt) + i) * 256 + (((4 * ks + g) ^ i) << 4)); }
__device__ __forceinline__ bf16x8 lds_v(const LAS unsigned char* buf, int h, int dt, int i, int g) { return *(const LAS bf16x8*)(buf + 16384 + (16 * dt + i) * 128 + (((4 * h + g) ^ (i >> 1)) << 4)); }
__device__ __forceinline__ void nsa_scores(const CT (&ct)[2], const LAS unsigned char* buf, int h, const bool (&act)[2], int i, int g, f32x4 (&s)[2][2]) {
#pragma unroll
    for (int c = 0; c < 2; ++c) { s[c][0] = (f32x4){0.f, 0.f, 0.f, 0.f}; s[c][1] = (f32x4){0.f, 0.f, 0.f, 0.f}; }
#pragma unroll
    for (int ks = 0; ks < 4; ++ks) { const bf16x8 ka = lds_k(buf, h, 0, ks, i, g), kb = lds_k(buf, h, 1, ks, i, g);
#pragma unroll
        for (int c = 0; c < 2; ++c) if (act[c]) { s[c][0] = mfma16(ka, ct[c].q[ks], s[c][0]); s[c][1] = mfma16(kb, ct[c].q[ks], s[c][1]); } }
}
template <bool DO_PV>
__device__ __forceinline__ bf16x8 nsa_softmax(CT& c, const f32x4 (&s)[2], const bool (&valid)[8]) {
    float sv[8];
#pragma unroll
    for (int e = 0; e < 8; ++e) sv[e] = valid[e] ? s[e >> 2][e & 3] : NEGF;
    float mx = fmaxf(fmaxf(fmaxf(sv[0], sv[1]), fmaxf(sv[2], sv[3])), fmaxf(fmaxf(sv[4], sv[5]), fmaxf(sv[6], sv[7])));
    mx = red16_max(mx); mx = red32_max(mx);
    const float mnew = fmaxf(c.m, mx), alpha = __builtin_amdgcn_exp2f((c.m - mnew) * L2E);
    float p[8], ps = 0.f;
#pragma unroll
    for (int e = 0; e < 8; ++e) { p[e] = valid[e] ? __builtin_amdgcn_exp2f((sv[e] - mnew) * L2E) : 0.f; ps += p[e]; }
    c.l = c.l * alpha + ps; c.m = mnew;
    if (DO_PV) {
#pragma unroll
        for (int d = 0; d < 8; ++d) c.o[d] = c.o[d] * alpha;
    }
    u32x4 w; w.x = cvt_pk_bf16(p[0], p[1]); w.y = cvt_pk_bf16(p[2], p[3]); w.z = cvt_pk_bf16(p[4], p[5]); w.w = cvt_pk_bf16(p[6], p[7]);
    return __builtin_bit_cast(bf16x8, w);
}
__device__ __forceinline__ void nsa_pv(CT (&ct)[2], const LAS unsigned char* buf, int h, const bool (&act)[2], const bf16x8 (&pb)[2], int i, int g) {
#pragma unroll
    for (int d = 0; d < 8; ++d) { const bf16x8 vf = lds_v(buf, h, d, i, g);
#pragma unroll
        for (int c = 0; c < 2; ++c) if (act[c]) ct[c].o[d] = mfma16(vf, pb[c], ct[c].o[d]); }
}
__device__ __forceinline__ float ct_lsum2(const CT& c) { return red32_sum(red16_sum(c.l)); }

template <int MASK>
__device__ __forceinline__ void nsa_slc_tile(CT (&ct)[2], const LAS unsigned char* buf, const bool (&selq)[2], const int (&myq)[2], const int j, const int i16, const int g4) {
    const bool act[2] = {(MASK & 1) != 0, (MASK & 2) != 0};
#pragma unroll
    for (int h = 0; h < 2; ++h) { f32x4 s[2][2]; nsa_scores(ct, buf, h, act, i16, g4, s);
        bf16x8 pb[2];
#pragma unroll
        for (int c = 0; c < 2; ++c) if (act[c]) { bool valid[8];
#pragma unroll
            for (int e = 0; e < 8; ++e) valid[e] = selq[c] && (64 * j + 32 * h + 8 * g4 + e <= myq[c]);
            pb[c] = nsa_softmax<true>(ct[c], s[c], valid); }
        nsa_pv(ct, buf, h, act, pb, i16, g4); }
}
#define PIN8(x) asm volatile("" : "+v"((x)[0]), "+v"((x)[1]), "+v"((x)[2]), "+v"((x)[3]), "+v"((x)[4]), "+v"((x)[5]), "+v"((x)[6]), "+v"((x)[7]))
template <int C>
__device__ __forceinline__ void nsa_slc_fast(CT (&ct)[2], const LAS unsigned char* buf, const bool selq, const int i16, const int g4) {
    CT& c = ct[C];
    f32x4 s[2][2];
#pragma unroll
    for (int h = 0; h < 2; ++h) { s[h][0] = (f32x4){0.f, 0.f, 0.f, 0.f}; s[h][1] = (f32x4){0.f, 0.f, 0.f, 0.f};
        bf16x8 kf[8];
#pragma unroll
        for (int ks = 0; ks < 4; ++ks) { kf[2 * ks] = lds_k(buf, h, 0, ks, i16, g4); kf[2 * ks + 1] = lds_k(buf, h, 1, ks, i16, g4); }
        PIN8(kf);
#pragma unroll
        for (int ks = 0; ks < 4; ++ks) { s[h][0] = mfma16(kf[2 * ks], c.q[ks], s[h][0]); s[h][1] = mfma16(kf[2 * ks + 1], c.q[ks], s[h][1]); } }
    bf16x8 vf[8];
#pragma unroll
    for (int d = 0; d < 8; ++d) vf[d] = lds_v(buf, 0, d, i16, g4);
    float mx = fmaxf(fmaxf(fmaxf(s[0][0].x, s[0][0].y), fmaxf(s[0][0].z, s[0][0].w)), fmaxf(fmaxf(s[0][1].x, s[0][1].y), fmaxf(s[0][1].z, s[0][1].w)));
    mx = fmaxf(mx, fmaxf(fmaxf(fmaxf(s[1][0].x, s[1][0].y), fmaxf(s[1][0].z, s[1][0].w)), fmaxf(fmaxf(s[1][1].x, s[1][1].y), fmaxf(s[1][1].z, s[1][1].w))));
    mx = selq ? mx : NEGF;
    mx = red16_max(mx); mx = red32_max(mx);
    const float mnew = fmaxf(c.m, mx), nb = -mnew * L2E;
    if (__builtin_amdgcn_ballot_w64(mnew != c.m) != 0ull) {
        const float alpha = __builtin_amdgcn_exp2f((c.m - mnew) * L2E); c.l *= alpha; c.m = mnew;
#pragma unroll
        for (int d = 0; d < 8; ++d) c.o[d] = c.o[d] * alpha;
    }
    const unsigned keep = selq ? 0xffffffffu : 0u; float ps = 0.f;
    bf16x8 pb[2];
#pragma unroll
    for (int h = 0; h < 2; ++h) { float p[8];
#pragma unroll
        for (int e = 0; e < 8; ++e) { p[e] = __builtin_amdgcn_exp2f(__builtin_fmaf(s[h][e >> 2][e & 3], L2E, nb)); ps += p[e]; }
        u32x4 w; w.x = cvt_pk_bf16(p[0], p[1]) & keep; w.y = cvt_pk_bf16(p[2], p[3]) & keep; w.z = cvt_pk_bf16(p[4], p[5]) & keep; w.w = cvt_pk_bf16(p[6], p[7]) & keep;
        pb[h] = __builtin_bit_cast(bf16x8, w); }
    c.l += selq ? ps : 0.f;
    PIN8(vf);
#pragma unroll
    for (int d = 0; d < 8; ++d) c.o[d] = mfma16(vf[d], pb[0], c.o[d]);
#pragma unroll
    for (int d = 0; d < 8; ++d) vf[d] = lds_v(buf, 1, d, i16, g4);
    PIN8(vf);
#pragma unroll
    for (int d = 0; d < 8; ++d) c.o[d] = mfma16(vf[d], pb[1], c.o[d]);
}
#define NSA_WAITV(n) asm volatile("s_waitcnt vmcnt(" #n ")" ::: "memory")
#define NSA_BAR() do { asm volatile("" ::: "memory"); __builtin_amdgcn_s_barrier(); asm volatile("" ::: "memory"); } while (0)
__device__ __forceinline__ void nsa_unit(const unsigned char* ws, const int Tq, const int grp, LAS unsigned char* lds, const int wave, const int lane_in) {
    int lane = lane_in; asm volatile("" : "+v"(lane));
    const unsigned char* r1 = ws + WS_R1;
    const bf16_t* qb = (const bf16_t*)(r1 + R_Q);
#define kc ((const bf16_t*)(r1 + R_KC) + (size_t)grp * 1024 * 128)
#define vct ((const bf16_t*)(r1 + R_VCT) + (size_t)grp * 128 * 1024)
#define ks ((const bf16_t*)(r1 + R_KS) + grp * 128)
#define vst ((const bf16_t*)(r1 + R_VST) + (size_t)grp * 128 * T)
#define kw ((const bf16_t*)(r1 + R_KW) + grp * 128)
#define vwt ((const bf16_t*)(r1 + R_VWT) + (size_t)grp * 128 * T)
    const float* gates = (const float*)(ws + WS_GATES); unsigned char* ob = (unsigned char*)(ws + WS_R1 + R_BLKK); float* part = (float*)(ws + WS_R1 + R_O);
    float* imp_own = (float*)(ws + WS_IMP) + (size_t)blockIdx.x * 32768 + wave * 8 * 256;
    LAS unsigned* mk = (LAS unsigned*)(lds + NSA_MK);
    LAS unsigned* wun = (LAS unsigned*)(lds + NSA_WUN);
    LAS unsigned* bun = (LAS unsigned*)(lds + NSA_BUN);
    LAS unsigned char* jl = (LAS unsigned char*)(lds + NSA_JL);
    LAS int* njp = (LAS int*)(lds + NSA_NJ);
    const int i16 = lane & 15, g4 = lane >> 4, qi = i16 >> 2, hd = grp * 4 + (i16 & 3);
    const int q0 = Tq * 64 + wave * 8;
    const StageLane SL = stage_lane(wave, lane);
    int myq[2]; CT ct[2];
#pragma unroll
    for (int c = 0; c < 2; ++c) { myq[c] = q0 + 4 * c + qi;
#pragma unroll
        for (int ksx = 0; ksx < 4; ++ksx) ct[c].q[ksx] = *(const bf16x8*)(qb + (size_t)myq[c] * 2048 + hd * 128 + 32 * ksx + 8 * g4); }
    const bool act2[2] = {true, true};
    NSA_BAR();
    if (threadIdx.x < 8) bun[threadIdx.x] = 0u;
    const int nst = (4 * Tq + 3 + 63) >> 6;
    {
    ct_init(ct[0]); ct_init(ct[1]);
#pragma unroll
    for (int p = 0; p < 3; ++p) if (p < nst) nsa_stage(lds + p * 32768, kc + (size_t)(64 * p) * 128, 8, vct, 11, false, wave, SL);
    const int nfull = nst > 2 ? nst - 2 : 0;
    auto p1step = [&](const int st, auto MK) { constexpr bool MASKED = decltype(MK)::value;
        if (st + 2 < nst) NSA_WAITV(4); else if (st + 1 < nst) NSA_WAITV(2); else NSA_WAITV(0);
        NSA_BAR();
        if (st + 3 < nst) nsa_stage(lds + ((st + 3) & 3) * 32768, kc + (size_t)(64 * (st + 3)) * 128, 8, vct, 11, false, wave, SL);
        const LAS unsigned char* buf = lds + (st & 3) * 32768;
#pragma unroll
        for (int h = 0; h < 2; ++h) { f32x4 s[2][2]; nsa_scores(ct, buf, h, act2, i16, g4, s);
#pragma unroll
            for (int c = 0; c < 2; ++c) { bool valid[8];
#pragma unroll
                for (int e = 0; e < 8; ++e) { const int cidx = 64 * st + 32 * h + 8 * g4 + e; valid[e] = MASKED ? (16 * cidx + 31 <= myq[c]) : true; }
                (void)nsa_softmax<false>(ct[c], s[c], valid); } } };
    for (int st = 0; st < nfull; ++st) p1step(st, std::false_type{});
    for (int st = nfull; st < nst; ++st) p1step(st, std::true_type{});
    float mfin[2], linv[2];
#pragma unroll
    for (int c = 0; c < 2; ++c) { const float l = ct_lsum2(ct[c]); mfin[c] = ct[c].m; linv[c] = l > 0.f ? 1.0f / l : 0.f; }
    VM_WAIT(); NSA_BAR();
#pragma unroll
    for (int p = 0; p < 3; ++p) if (p < nst) nsa_stage(lds + p * 32768, kc + (size_t)(64 * p) * 128, 8, vct + 64 * p, 11, true, wave, SL);
    auto p2step = [&](const int st, auto MK) { constexpr bool MASKED = decltype(MK)::value;
        if (st + 2 < nst) NSA_WAITV(8); else if (st + 1 < nst) NSA_WAITV(4); else NSA_WAITV(0);
        NSA_BAR();
        if (st + 3 < nst) nsa_stage(lds + ((st + 3) & 3) * 32768, kc + (size_t)(64 * (st + 3)) * 128, 8, vct + 64 * (st + 3), 11, true, wave, SL);
        const LAS unsigned char* buf = lds + (st & 3) * 32768;
#pragma unroll
        for (int h = 0; h < 2; ++h) { f32x4 s[2][2]; nsa_scores(ct, buf, h, act2, i16, g4, s);
            bf16x8 pb[2];
#pragma unroll
            for (int c = 0; c < 2; ++c) { float p[8];
#pragma unroll
                for (int e = 0; e < 8; ++e) { const int cidx = 64 * st + 32 * h + 8 * g4 + e; const bool valid = MASKED ? (16 * cidx + 31 <= myq[c]) : true;
                    p[e] = valid ? __builtin_amdgcn_exp2f((s[c][e >> 2][e & 3] - mfin[c]) * L2E) * linv[c] : 0.f; }
                u32x4 w; w.x = cvt_pk_bf16(p[0], p[1]); w.y = cvt_pk_bf16(p[2], p[3]); w.z = cvt_pk_bf16(p[4], p[5]); w.w = cvt_pk_bf16(p[6], p[7]);
                pb[c] = __builtin_bit_cast(bf16x8, w);
#pragma unroll
                for (int e = 0; e < 8; ++e) p[e] = quad_sum(p[e]);
                if ((lane & 3) == 0) { float* row = imp_own + (4 * c + qi) * 256;
#pragma unroll
                    for (int tt = 0; tt < 2; ++tt) { const int j = 16 * st + 8 * h + 2 * g4 + tt;
                        row[j] = 2.f * (p[4 * tt] + p[4 * tt + 1] + p[4 * tt + 2]) + p[4 * tt + 3];
                        if (j + 1 < 256) row[16384 + j + 1] = p[4 * tt + 3]; } }
            }
            nsa_pv(ct, buf, h, act2, pb, i16, g4);
        } };
    for (int st = 0; st < nfull; ++st) p2step(st, std::false_type{});
    for (int st = nfull; st < nst; ++st) p2step(st, std::true_type{});
    }
#pragma unroll
    for (int c = 0; c < 2; ++c) { int ln = lane; asm volatile("" : "+v"(ln)); const int hd_ = grp * 4 + (ln & 3), mq_ = q0 + 4 * c + ((ln & 15) >> 2), g4_ = ln >> 4;
        const float gt = gates[(size_t)mq_ * 48 + 0 * 16 + hd_]; float* pp = part + (size_t)mq_ * 2048 + hd_ * 128 + 4 * g4_;
#pragma unroll
        for (int d = 0; d < 8; ++d) *(f32x4*)(pp + 16 * d) = ct[c].o[d] * gt; }
    VM_WAIT();
    const int curT = q0 >> 6;
    float vall[8][4];
#pragma unroll
    for (int qq = 0; qq < 8; ++qq)
#pragma unroll
        for (int k = 0; k < 4; ++k) { const int j = lane + 64 * k; const bool cand = (curT + 1 > 16) & (j >= 1) & (j <= curT - 2); const int jj = cand ? j : 1;
            const float v = __hip_atomic_load(imp_own + qq * 256 + jj, __ATOMIC_RELAXED, __HIP_MEMORY_SCOPE_AGENT) + __hip_atomic_load(imp_own + 16384 + qq * 256 + jj, __ATOMIC_RELAXED, __HIP_MEMORY_SCOPE_AGENT);
            vall[qq][k] = cand ? v : -1.f; }
#pragma unroll
    for (int qq = 0; qq < 8; ++qq) {
        const int cur = curT; bool sel[4]; float val[4];
#pragma unroll
        for (int k = 0; k < 4; ++k) { const int j = lane + 64 * k;
            if (cur + 1 <= 16) { sel[k] = (j <= cur); val[k] = -1.f; }
            else { sel[k] = (j == 0) | (j == cur) | (j == cur - 1); val[k] = vall[qq][k]; } }
        if (cur + 1 > 16) {
            int key[4];
#pragma unroll
            for (int k = 0; k < 4; ++k) key[k] = __float_as_int(val[k]);
            auto count_ge = [&](const int cand) { int cnt = 0;
#pragma unroll
                for (int k = 0; k < 4; ++k) cnt += __builtin_popcountll(__ballot(key[k] >= cand));
                return cnt; };
            int thr = count_ge(1 << 30) >= 13 ? (1 << 30) : 0;
            for (int b = 28; b >= 0; b -= 2) {
                const int c1 = thr | (1 << b), c2 = thr | (2 << b), c3 = thr | (3 << b);
                const int n1 = count_ge(c1), n2 = count_ge(c2), n3 = count_ge(c3);
                thr = n3 >= 13 ? c3 : (n2 >= 13 ? c2 : (n1 >= 13 ? c1 : thr)); }
            int above = 0;
#pragma unroll
            for (int k = 0; k < 4; ++k) above += __builtin_popcountll(__ballot(key[k] > thr));
            int rem = 13 - above;
#pragma unroll
            for (int k = 0; k < 4; ++k) { const bool eq = (key[k] == thr); const unsigned long long E = __ballot(eq);
                const int rank = (int)__builtin_amdgcn_mbcnt_hi((unsigned)(E >> 32), __builtin_amdgcn_mbcnt_lo((unsigned)E, 0u));
                sel[k] = sel[k] | (key[k] > thr) | (eq & (rank < rem)); rem -= __builtin_popcountll(E); }
        }
#pragma unroll
        for (int k = 0; k < 4; ++k) { const unsigned long long bb = __ballot(sel[k]); if (lane == 0) { mk[(wave * 8 + qq) * 8 + 2 * k] = (unsigned)bb; mk[(wave * 8 + qq) * 8 + 2 * k + 1] = (unsigned)(bb >> 32); } }
    }
    LDS_WAIT(); asm volatile("" ::: "memory");
    if (lane < 16) { const int c = lane >> 3, w8 = lane & 7; const LAS unsigned* m0 = mk + (wave * 8 + 4 * c) * 8 + w8; const unsigned u = m0[0] | m0[8] | m0[16] | m0[24];
        wun[(wave * 2 + c) * 8 + w8] = u; (void)__hip_atomic_fetch_or(bun + w8, u, __ATOMIC_RELAXED, __HIP_MEMORY_SCOPE_WORKGROUP); }
    LDS_WAIT(); NSA_BAR();
    if (threadIdx.x < 256) { const int j = threadIdx.x; unsigned below = 0;
#pragma unroll
        for (int w8 = 0; w8 < 8; ++w8) { const unsigned u = bun[w8]; below += (w8 < (j >> 5)) ? __builtin_popcount(u) : 0; if (j == 255 && w8 == 7) {} }
        const unsigned uw = bun[j >> 5]; if ((uw >> (j & 31)) & 1u) jl[below + __builtin_popcount(uw & ((1u << (j & 31)) - 1u))] = (unsigned char)j;
        if (j == 0) { int n = 0;
#pragma unroll
            for (int w8 = 0; w8 < 8; ++w8) n += __builtin_popcount(bun[w8]); njp[0] = n; } }
    LDS_WAIT(); NSA_BAR();
    {
    ct_init(ct[0]); ct_init(ct[1]);
    {
        const int nj = __builtin_amdgcn_readfirstlane(njp[0]);
        const int nm = nj - 1, np = (nm + 1) >> 1;
        if (nm > 0) { const int j0 = __builtin_amdgcn_readfirstlane((int)jl[0]); nsa_stage(lds, ks + (size_t)(64 * j0) * 512, 10, vst + 64 * j0, 15, true, wave, SL);
          if (1 < nm) { const int j1 = __builtin_amdgcn_readfirstlane((int)jl[1]); nsa_stage(lds + 32768, ks + (size_t)(64 * j1) * 512, 10, vst + 64 * j1, 15, true, wave, SL); } }
        else nsa_stage(lds, ks + (size_t)(64 * Tq) * 512, 10, vst + 64 * Tq, 15, true, wave, SL);
        for (int p = 0; p < np; ++p) {
            NSA_WAITV(0); NSA_BAR();
            { LAS unsigned char* nb = lds + ((p + 1) & 1) * 65536;
              if (p + 1 < np) {
                const int j0 = __builtin_amdgcn_readfirstlane((int)jl[2 * p + 2]); nsa_stage(nb, ks + (size_t)(64 * j0) * 512, 10, vst + 64 * j0, 15, true, wave, SL);
                if (2 * p + 3 < nm) { const int j1 = __builtin_amdgcn_readfirstlane((int)jl[2 * p + 3]); nsa_stage(nb + 32768, ks + (size_t)(64 * j1) * 512, 10, vst + 64 * j1, 15, true, wave, SL); } }
              else nsa_stage(nb, ks + (size_t)(64 * Tq) * 512, 10, vst + 64 * Tq, 15, true, wave, SL); }
#pragma unroll
            for (int bq = 0; bq < 2; ++bq) {
                if (2 * p + bq < nm) {
                    const int j = __builtin_amdgcn_readfirstlane((int)jl[2 * p + bq]);
                    const LAS unsigned char* buf = lds + (p & 1) * 65536 + bq * 32768;
                    bool act[2], selq[2];
#pragma unroll
                    for (int c = 0; c < 2; ++c) { act[c] = (__builtin_amdgcn_readfirstlane(wun[(wave * 2 + c) * 8 + (j >> 5)]) >> (j & 31)) & 1u; selq[c] = (mk[(wave * 8 + 4 * c + qi) * 8 + (j >> 5)] >> (j & 31)) & 1u; }
                    if (act[0]) nsa_slc_fast<0>(ct, buf, selq[0], i16, g4);
                    if (act[1]) nsa_slc_fast<1>(ct, buf, selq[1], i16, g4);
                }
            }
        }
        NSA_WAITV(0); NSA_BAR();
        { const int j = Tq; const LAS unsigned char* buf = lds + (np & 1) * 65536;
          bool act[2], selq[2];
#pragma unroll
          for (int c = 0; c < 2; ++c) { act[c] = (__builtin_amdgcn_readfirstlane(wun[(wave * 2 + c) * 8 + (j >> 5)]) >> (j & 31)) & 1u; selq[c] = (mk[(wave * 8 + 4 * c + qi) * 8 + (j >> 5)] >> (j & 31)) & 1u; }
          if (act[0]) nsa_slc_tile<1>(ct, buf, selq, myq, j, i16, g4);
          if (act[1]) nsa_slc_tile<2>(ct, buf, selq, myq, j, i16, g4); }
    }
    }
#pragma unroll
    for (int c = 0; c < 2; ++c) { int ln = lane; asm volatile("" : "+v"(ln)); const int hd_ = grp * 4 + (ln & 3), mq_ = q0 + 4 * c + ((ln & 15) >> 2), g4_ = ln >> 4;
        const float l = ct_lsum2(ct[c]); const float gt = gates[(size_t)mq_ * 48 + 1 * 16 + hd_] * (l > 0.f ? 1.0f / l : 0.f); float* pp = part + (size_t)mq_ * 2048 + hd_ * 128 + 4 * g4_;
#pragma unroll
        for (int d = 0; d < 8; ++d) *(f32x4*)(pp + 16 * d) = *(const f32x4*)(pp + 16 * d) + ct[c].o[d] * gt; }
    {
    ct_init(ct[0]); ct_init(ct[1]);
    VM_WAIT(); NSA_BAR();
    { const int kb0 = (Tq >= 8 ? Tq - 8 : 0), nw = Tq - kb0 + 1;
#pragma unroll
      for (int p = 0; p < 3; ++p) if (p < nw) { const int tp = kb0 + p; nsa_stage(lds + p * 32768, kw + (size_t)(64 * tp) * 512, 10, vwt + 64 * tp, 15, true, wave, SL); }
      auto wstep = [&](const int st, auto MK) { constexpr bool MASKED = decltype(MK)::value;
          if (st + 2 < nw) NSA_WAITV(8); else if (st + 1 < nw) NSA_WAITV(4); else NSA_WAITV(0);
          NSA_BAR();
          if (st + 3 < nw) { const int tp = kb0 + st + 3; nsa_stage(lds + ((st + 3) & 3) * 32768, kw + (size_t)(64 * tp) * 512, 10, vwt + 64 * tp, 15, true, wave, SL); }
          const LAS unsigned char* buf = lds + (st & 3) * 32768;
#pragma unroll
          for (int h = 0; h < 2; ++h) { f32x4 s[2][2]; nsa_scores(ct, buf, h, act2, i16, g4, s);
              bf16x8 pb[2];
#pragma unroll
              for (int c = 0; c < 2; ++c) { bool valid[8];
#pragma unroll
                  for (int e = 0; e < 8; ++e) { const int key = 64 * (kb0 + st) + 32 * h + 8 * g4 + e; valid[e] = MASKED ? ((key <= myq[c]) & (key > myq[c] - 512)) : true; }
                  pb[c] = nsa_softmax<true>(ct[c], s[c], valid); }
              nsa_pv(ct, buf, h, act2, pb, i16, g4); } };
      wstep(0, std::true_type{});
      for (int st = 1; st + 1 < nw; ++st) wstep(st, std::false_type{});
      if (nw > 1) wstep(nw - 1, std::true_type{});
    }
    }
#pragma unroll
    for (int c = 0; c < 2; ++c) { int ln = lane; asm volatile("" : "+v"(ln)); const int hd_ = grp * 4 + (ln & 3), mq_ = q0 + 4 * c + ((ln & 15) >> 2), g4_ = ln >> 4;
        const float l = ct_lsum2(ct[c]); const float gt = gates[(size_t)mq_ * 48 + 2 * 16 + hd_] * (l > 0.f ? 1.0f / l : 0.f); const float* pp = part + (size_t)mq_ * 2048 + hd_ * 128 + 4 * g4_;
        unsigned char* po = ob + (size_t)mq_ * 2048 + hd_ * 128 + 4 * g4_;
#pragma unroll
        for (int d = 0; d < 8; ++d) {
            const f32x4 o = (*(const f32x4*)(pp + 16 * d) + ct[c].o[d] * gt) * 64.f;
            *(unsigned*)(po + 16 * d) = pk4_fp8(o.x, o.y, o.z, o.w); } }
}

#undef kc
#undef vct
#undef ks
#undef vst
#undef kw
#undef vwt
__device__ __forceinline__ void memattn_wave(const unsigned char* ws, int layer, int wu, int lane) {
    const int hd = wu & 3, qb0 = (wu >> 2) * 32; const int col = lane & 15, g4 = lane >> 4;
    const bf16_t* qm = (const bf16_t*)(ws + WS_QM); bf16_t* om = (bf16_t*)(ws + WS_OM);
    const bf16_t* km = (const bf16_t*)(ws + WS_KM) + (size_t)layer * 256 * 512 + hd * 128; const bf16_t* vmt = (const bf16_t*)(ws + WS_VMT) + (size_t)layer * 512 * 256 + (size_t)hd * 128 * 256;
    CT ct[2];
#pragma unroll
    for (int c = 0; c < 2; ++c) { ct_init(ct[c]);
#pragma unroll
        for (int ksx = 0; ksx < 4; ++ksx) ct[c].q[ksx] = *(const bf16x8*)(qm + (size_t)(qb0 + 16 * c + col) * 512 + hd * 128 + 32 * ksx + 8 * g4); }
    const bf16_t* k0 = km + (size_t)(8 * (col >> 2) + (col & 3)) * 512 + 8 * g4;
    const bf16_t* v0 = vmt + (size_t)col * 256 + 8 * g4;
    bf16x8 kf[8];
#pragma unroll
    for (int ks = 0; ks < 4; ++ks) { kf[2 * ks] = *(const bf16x8*)(k0 + 32 * ks); kf[2 * ks + 1] = *(const bf16x8*)(k0 + 4 * 512 + 32 * ks); }
#pragma unroll 1
    for (int st = 0; st < 8; ++st) {
        bf16x8 vf[8];
#pragma unroll
        for (int d = 0; d < 8; ++d) vf[d] = *(const bf16x8*)(v0 + (size_t)(16 * d) * 256 + 32 * st);
        PIN8(kf);
        f32x4 s[2][2];
#pragma unroll
        for (int c = 0; c < 2; ++c) { s[c][0] = (f32x4){0.f, 0.f, 0.f, 0.f}; s[c][1] = (f32x4){0.f, 0.f, 0.f, 0.f}; }
#pragma unroll
        for (int ks = 0; ks < 4; ++ks) {
#pragma unroll
            for (int c = 0; c < 2; ++c) { s[c][0] = mfma16(kf[2 * ks], ct[c].q[ks], s[c][0]); s[c][1] = mfma16(kf[2 * ks + 1], ct[c].q[ks], s[c][1]); } }
        if (st < 7) {
#pragma unroll
            for (int ks = 0; ks < 4; ++ks) { kf[2 * ks] = *(const bf16x8*)(k0 + (size_t)(32 * (st + 1)) * 512 + 32 * ks); kf[2 * ks + 1] = *(const bf16x8*)(k0 + (size_t)(32 * (st + 1) + 4) * 512 + 32 * ks); } }
        bf16x8 pb[2]; const bool valid[8] = {true, true, true, true, true, true, true, true};
#pragma unroll
        for (int c = 0; c < 2; ++c) pb[c] = nsa_softmax<true>(ct[c], s[c], valid);
        PIN8(vf);
#pragma unroll
        for (int d = 0; d < 8; ++d) {
#pragma unroll
            for (int c = 0; c < 2; ++c) ct[c].o[d] = mfma16(vf[d], pb[c], ct[c].o[d]); }
    }
#pragma unroll
    for (int c = 0; c < 2; ++c) { const float li = 1.0f / ct_lsum2(ct[c]);
#pragma unroll
        for (int d = 0; d < 8; ++d) { const f32x4 o = ct[c].o[d] * li; u32x2 w; w.x = cvt_pk_bf16(o.x, o.y); w.y = cvt_pk_bf16(o.z, o.w);
            *(u32x2*)(om + (size_t)(qb0 + 16 * c + col) * 512 + hd * 128 + 16 * d + 4 * g4) = w; } }
}

__device__ __forceinline__ void memattn_block(const unsigned char* ws, int layer, LAS unsigned char* lds, int blk, int G, int wave, int lane_in) {
    int lane = lane_in; asm volatile("" : "+v"(lane));
    const int hd = blk & 3, slot = blk >> 2, nb = G >> 2; const int col = lane & 15, g4 = lane >> 4;
    const bf16_t* qm = (const bf16_t*)(ws + WS_QM); bf16_t* om = (bf16_t*)(ws + WS_OM);
    const bf16_t* km = (const bf16_t*)(ws + WS_KM) + (size_t)layer * 256 * 512 + hd * 128; const bf16_t* vmt = (const bf16_t*)(ws + WS_VMT) + (size_t)layer * 512 * 256 + (size_t)hd * 128 * 256;
    const StageLane SL = stage_lane(wave, lane);
#pragma unroll
    for (int t = 0; t < 4; ++t) nsa_stage(lds + t * 32768, km + (size_t)(64 * t) * 512, 10, vmt + 64 * t, 9, true, wave, SL);
    const bool act2[2] = {true, true}; const bool valid[8] = {true, true, true, true, true, true, true, true};
    bool first = true;
    for (int tq = slot * NWAVES + wave; tq < T / 32; tq += nb * NWAVES) {
        const int qb0 = tq * 32;
        CT ct[2];
#pragma unroll
        for (int c = 0; c < 2; ++c) { ct_init(ct[c]);
#pragma unroll
            for (int ksx = 0; ksx < 4; ++ksx) ct[c].q[ksx] = *(const bf16x8*)(qm + (size_t)(qb0 + 16 * c + col) * 512 + hd * 128 + 32 * ksx + 8 * g4); }
        if (first) { VM_WAIT(); NSA_BAR(); first = false; }
#pragma unroll 1
        for (int t = 0; t < 4; ++t) { const LAS unsigned char* buf = lds + t * 32768;
#pragma unroll
            for (int h = 0; h < 2; ++h) { f32x4 s[2][2]; nsa_scores(ct, buf, h, act2, col, g4, s);
                bf16x8 pb[2];
#pragma unroll
                for (int c = 0; c < 2; ++c) pb[c] = nsa_softmax<true>(ct[c], s[c], valid);
                nsa_pv(ct, buf, h, act2, pb, col, g4); } }
#pragma unroll
        for (int c = 0; c < 2; ++c) { const float li = 1.0f / ct_lsum2(ct[c]);
#pragma unroll
            for (int d = 0; d < 8; ++d) { const f32x4 o = ct[c].o[d] * li; u32x2 w; w.x = cvt_pk_bf16(o.x, o.y); w.y = cvt_pk_bf16(o.z, o.w);
                *(u32x2*)(om + (size_t)(qb0 + 16 * c + col) * 512 + hd * 128 + 16 * d + 4 * g4) = w; } }
    }
    if (first) { VM_WAIT(); NSA_BAR(); }
}

__device__ __forceinline__ void pool_body(const int W, const float* __restrict__ h, const float* __restrict__ gain, bf16_t* __restrict__ dbuf, const LAS float* rs, int t0, int tid) {
    const int c0 = 4 * tid; const f32x4 g = *(const f32x4*)(gain + c0);
    f32x4 sum = (f32x4){0.f, 0.f, 0.f, 0.f};
    for (int i = 1; i < W; ++i) { const int t = t0 - i; if (t >= 0) sum += (*(const f32x4*)(h + (size_t)t * D + c0) * rs[15 - i]) * g; }
    for (int tc = 0; tc < 64; tc += 8) {
        f32x4 un[8], uo[8];
#pragma unroll
        for (int k = 0; k < 8; ++k) { const int t = t0 + tc + k, told = t - W + 1;
            un[k] = *(const f32x4*)(h + (size_t)t * D + c0); uo[k] = *(const f32x4*)(h + (size_t)(told >= 0 ? told : 0) * D + c0); }
#pragma unroll
        for (int k = 0; k < 8; ++k) { const int tt = tc + k, t = t0 + tt, told = t - W + 1; const f32x4 u = (un[k] * rs[15 + tt]) * g; sum += u;
            const float inv = 1.0f / (float)((t + 1 < W) ? (t + 1) : W); const f32x4 d = sum * inv - u;
            u32x2 w; w.x = cvt_pk_bf16(d.x, d.y); w.y = cvt_pk_bf16(d.z, d.w); *(u32x2*)(dbuf + (size_t)t * D + c0) = w;
            if (told >= 0) sum -= (uo[k] * rs[15 + tt - W + 1]) * g; }
    }
}

#define IN(k) (lo <= (k) && (k) < hi)
#define PH(k) ((((PHASE_MASK) >> (k)) & 1u) && IN(k))
#define SEAM(k) do { if ((((PHASE_MASK) >> ((k) + 1)) & 1u) && IN((k) + 1)) xcd_barrier(bar); } while (0)
template <int layer>
__device__ __forceinline__ void mem_layer(const Args& a, LAS unsigned char* lds, const XcdBarrier& bar, int lo, int hi, int G, int blk, int gw, int ngw, int lane) {
    using namespace gm;
    unsigned char* ws = a.ws;
    bf16_t* APA = (bf16_t*)(ws + WS_APA); bf16_t* APB = (bf16_t*)(ws + WS_APB); float* H = (float*)(ws + WS_H); float* SSQ = (float*)(ws + WS_SSQ);
        const int pq = layer ? 13 : 6;
        bf16_t* apin = layer ? APA : APB;
        if (PH(pq)) {
            Sched S; S.o.init(T / 256, 2, G, blk); S.A = (const char*)apin; S.B = (const char*)(ws + WS_MWQ) + (size_t)layer * 512 * D; S.a_tile = 256ull * D; S.b_tile = 256ull * D; S.pn_shift = 30; S.a_pn_bytes = 0; S.tile_e = nullptr; S.b_exp = 0;
            EpiMemQ E{(bf16_t*)(ws + WS_QM), SSQ};
            gemm_phase<EpiMemQ, Sched, false, true, 121, 125>(lds, D / 128, D, D, S, E, nullptr);
            {
                const int wave = __builtin_amdgcn_readfirstlane((int)threadIdx.x >> 6); const int r0 = layer ? TR_D2 : TR_D1, r1 = layer ? TR_D3 : TR_D2;
                if (G > 128) { if (blk >= 128) tr_moe_range(a, (LAS float*)(lds + wave * 8448), r0, r1, (blk - 128) * NWAVES + wave, (G - 128) * NWAVES, lane); }
                else { __syncthreads(); tr_moe_range(a, (LAS float*)(lds + wave * 8448), r0, r1, gw, ngw, lane); } }
#if (REPEAT_MASK & 64u)
            xcd_barrier(bar); gemm_phase<EpiMemQ, Sched, false>(lds, D / 64, D, D, S, E, nullptr);
#endif
            SEAM(pq);
        }
        if (PH(pq + 1)) {
            if ((G & 3) == 0) memattn_block(ws, layer, lds, blk, G, __builtin_amdgcn_readfirstlane((int)threadIdx.x >> 6), lane);
            else for (int wu = gw; wu < 2048; wu += ngw) memattn_wave(ws, layer, wu, lane);
            SEAM(pq + 1);
        }
        if (PH(pq + 2)) {
            Sched S; S.o.init(T / 256, 8, G, blk); S.A = (const char*)(ws + WS_OM); S.B = (const char*)(ws + WS_MWO) + (size_t)layer * D * 512 * 2; S.a_tile = 256ull * 512 * 2; S.b_tile = 256ull * 512 * 2; S.pn_shift = 30; S.a_pn_bytes = 0; S.tile_e = nullptr; S.b_exp = 0;
            if (layer == 0) { EpiRes<true, true, false> E{H, H, APA, a.in[5], SSQ, nullptr, nullptr}; gemm_phase<EpiRes<true, true, false>, Sched, false>(lds, 512 / 64, 512, 512, S, E, nullptr); }
            else { EpiRes<false, false, false> E{H, H, nullptr, nullptr, nullptr, nullptr, nullptr}; gemm_phase<EpiRes<false, false, false>, Sched, false>(lds, 512 / 64, 512, 512, S, E, nullptr); }
            SEAM(pq + 2);
        }
}
#undef IN
#undef PH
#undef SEAM
constexpr int NPHASE = 21;
__global__ void __launch_bounds__(NTHREADS, 2) mega_fwd(Args a) {
    extern __shared__ __attribute__((aligned(16))) unsigned char lds_raw[];
    LAS unsigned char* lds = (LAS unsigned char*)lds_raw;
    const int tid = threadIdx.x, lane = tid & 63, wave = __builtin_amdgcn_readfirstlane(tid >> 6);
    const int G = gridDim.x, blk = blockIdx.x, gw = blk * NWAVES + wave, ngw = G * NWAVES;
    unsigned char* ws = a.ws;
    volatile LAS unsigned* MISC = (volatile LAS unsigned*)(lds + MISC_OFF);
    if (tid < 64) MISC[tid] = 0u;
    __syncthreads();
    XcdBarrier bar = xcd_barrier_post((unsigned*)(ws + WS_CTL) + CW_BAR, MISC + 8);
    const int lo = a.ph_lo, hi = a.ph_hi;
#define IN(k) (lo <= (k) && (k) < hi)
#define PH(k) ((((PHASE_MASK) >> (k)) & 1u) && IN(k))
#define SEAM(k) do { if ((((PHASE_MASK) >> ((k) + 1)) & 1u) && IN((k) + 1)) xcd_barrier(bar); } while (0)
    using namespace gm;
    bf16_t* APA = (bf16_t*)(ws + WS_APA); bf16_t* APB = (bf16_t*)(ws + WS_APB); float* H = (float*)(ws + WS_H); float* SSQ = (float*)(ws + WS_SSQ);
    unsigned char* r1 = ws + WS_R1;

    if (PH(0)) {
#if (REPEAT_MASK & 1u)
        phase_prologue(a, lds, gw, ngw, wave, lane); xcd_barrier(bar);
#endif
        phase_prologue(a, lds, gw, ngw, wave, lane); SEAM(0); }

    if (PH(1)) {
        Sched S; S.o.init(T / 256, 20, G, blk); S.A = (const char*)APA; S.B = (const char*)(ws + WS_WIN); S.a_tile = 256ull * D; S.b_tile = 256ull * D; S.pn_shift = 30; S.a_pn_bytes = 0; S.tile_e = nullptr; S.b_exp = 0;
        EpiInProj E{(bf16_t*)(r1 + R_Q), (bf16_t*)(r1 + R_BLKK), (bf16_t*)(r1 + R_BLKV), (bf16_t*)(r1 + R_KS), (bf16_t*)(r1 + R_VS), (bf16_t*)(r1 + R_KW), (bf16_t*)(r1 + R_VW), (const float*)(ws + WS_ROPE)};
        gemm_phase<EpiInProj, Sched, false, true, 121, 125>(lds, D / 128, D, D, S, E, nullptr);
#if (REPEAT_MASK & 2u)
        xcd_barrier(bar); gemm_phase<EpiInProj, Sched, false>(lds, D / 64, D, D, S, E, nullptr);
#endif
        SEAM(1);
    }
    if (PH(2)) {
        if (blk < 32) { const int kv = blk >> 4, pm = blk & 15;
            OneUnit S; S.on = true; S.u.pm = pm; S.u.pn = 0; S.u.x0 = kv; S.u.x1 = 0; S.u.A = (const char*)(r1 + (kv ? R_BLKV : R_BLKK)) + (size_t)pm * 256 * 4096; S.u.B = (const char*)(ws + WS_C1) + (size_t)kv * 256 * 4096;
            EpiCmp1 E{(bf16_t*)(r1 + R_HID), (const float*)(ws + WS_B1)};
            gemm_phase<EpiCmp1, OneUnit, false, true, 121, 125>(lds, 4096 / 128, 4096, 4096, S, E, nullptr);
            VM_WAIT(); __syncthreads();
            OneUnit S2; S2.on = true; S2.u.pm = pm; S2.u.pn = 0; S2.u.x0 = kv; S2.u.x1 = 0; S2.u.A = (const char*)(r1 + R_HID) + ((size_t)kv * 4096 + pm * 256) * 256 * 2; S2.u.B = (const char*)(ws + WS_C2) + (size_t)kv * 256 * 256 * 2;
            EpiCmp2 E2{(bf16_t*)(r1 + R_KC), (bf16_t*)(r1 + R_VCT), (const float*)(ws + WS_ROPE)};
            gemm_phase<EpiCmp2, OneUnit, false>(lds, 256 / 64, 256, 256, S2, E2, nullptr);
        } else if (blk < 96) { const int pm = blk - 32;
            OneUnit S; S.on = true; S.u.pm = pm; S.u.pn = 0; S.u.x0 = 0; S.u.x1 = 0; S.u.A = (const char*)APA + (size_t)pm * 256 * D; S.u.B = (const char*)(ws + WS_WG);
            EpiGates E{(float*)(ws + WS_GATES), a.in[8]};
            gemm_phase<EpiGates, OneUnit, false, true, 121, 125>(lds, D / 128, D, D, S, E, nullptr);
        } else if (blk < 104) { const int l = (blk - 96) >> 2, pn = (blk - 96) & 3;
            OneUnit S; S.on = true; S.u.pm = 0; S.u.pn = pn; S.u.x0 = l; S.u.x1 = 0; S.u.A = (const char*)(ws + WS_MEMN) + (size_t)l * 256 * D * 2; S.u.B = (const char*)(ws + WS_MWKV) + ((size_t)l * 1024 + pn * 256) * D * 2;
            EpiMemKV E{(bf16_t*)(ws + WS_KM), (bf16_t*)(ws + WS_VMT)};
            gemm_phase<EpiMemKV, OneUnit, false>(lds, D / 64, D, D, S, E, nullptr);
        } else {
            LAS bf16_t* scr = (LAS bf16_t*)(lds + wave * 18432);
            const int w0 = (blk - 104) * NWAVES + wave, nw = (G - 104) * NWAVES;
            for (int it = w0; it < 2048; it += nw) { const int which = it >> 10, g = (it >> 8) & 3, tb = it & 255;
                vtrans_item((const bf16_t*)(r1 + (which ? R_VW : R_VS)) + (size_t)(tb * 64) * 512 + g * 128, (bf16_t*)(r1 + (which ? R_VWT : R_VST)) + (size_t)(g * 128) * T + tb * 64, scr, lane); }
            tr_moe_range(a, (LAS float*)(lds + wave * 18432), TR_D0, TR_D1, w0, nw, lane);
        }
        SEAM(2);
    }
    if (PH(4)) {
        unsigned* nsaq = (unsigned*)(ws + WS_CTL) + CW_NSAQ;
        for (;;) {
            if (tid == 0) MISC[16] = __hip_atomic_fetch_add(nsaq, 1u, __ATOMIC_RELAXED, __HIP_MEMORY_SCOPE_AGENT);
            __syncthreads();
            const unsigned u = MISC[16];
            if (u >= 1024u) break;
            nsa_unit(ws, 255 - (int)(u >> 2), (int)(u & 3u), lds, wave, lane);
            __syncthreads();
            { const int n0 = (int)u * TR_PER_UNIT, n1 = n0 + TR_PER_UNIT < TRN_TOTAL ? n0 + TR_PER_UNIT : TRN_TOTAL; tr_run<true>(a, (LAS float*)(lds + wave * 8448), n0, n1, wave, NWAVES, lane); }
        }
        VM_WAIT(); __syncthreads();
        SEAM(4);
    }
    if (PH(5)) {
        Sched S; S.o.init(T / 256, 8, G, blk); S.A = (const char*)(r1 + R_BLKK); S.B = (const char*)(ws + WS_WOUT); S.a_tile = 256ull * D; S.b_tile = 256ull * D; S.pn_shift = 30; S.a_pn_bytes = 0; S.tile_e = nullptr; S.b_exp = 0;
        EpiRes<true, true, false, true> E{a.in[0], H, APB, a.in[3], SSQ, nullptr, nullptr};
        gemm_phase<EpiRes<true, true, false, true>, Sched, false, true, 121, 121>(lds, D / 128, D, D, S, E, nullptr);
        SEAM(5);
    }
    mem_layer<0>(a, lds, bar, lo, hi, G, blk, gw, ngw, lane);
        if (PH(9)) {
            Sched S; S.o.init(T / 256, 44, G, blk); S.A = (const char*)APA; S.B = (const char*)(ws + WS_FGU); S.a_tile = 256ull * D * 2; S.b_tile = 256ull * D * 2; S.pn_shift = 30; S.a_pn_bytes = 0; S.tile_e = nullptr; S.b_exp = 0;
            EpiSwiglu<true, true> E{(bf16_t*)r1, SSQ};
            gemm_phase<EpiSwiglu<true, true>, Sched, false>(lds, D / 64, D, D, S, E, nullptr);
#if (REPEAT_MASK & 512u)
            xcd_barrier(bar); gemm_phase<EpiSwiglu<true>, Sched, false>(lds, D / 64, D, D, S, E, nullptr);
#endif
            SEAM(9);
        }
        if (PH(10)) {
            Sched S; S.o.init(T / 256, 8, G, blk); S.A = (const char*)r1; S.B = (const char*)(ws + WS_FD); S.a_tile = 256ull * DFF; S.b_tile = 256ull * DFF; S.pn_shift = 30; S.a_pn_bytes = 0; S.tile_e = nullptr; S.b_exp = 0;
            EpiRes<false, true, false> E{H, H, nullptr, nullptr, SSQ, nullptr, nullptr};
            gemm_phase<EpiRes<false, true, false>, Sched, false, true, 120, 123>(lds, DFF / 128, DFF, DFF, S, E, nullptr);
            SEAM(10);
        }
        if (PH(11)) {
            LAS float* rs = (LAS float*)lds;
            for (int rep = 0; rep < ((PROBE_SMALL & 2) ? 3 : 1); ++rep) for (int tb = blk; tb < T / 64; tb += G) {
                const int t0 = tb * 64;
                if (tid < 79) { const int t = t0 - 15 + tid; float v = 0.f;
                    if (t >= 0) { const f32x4* sp = (const f32x4*)(SSQ + (size_t)t * 32); f32x4 s4 = sp[0];
#pragma unroll
                        for (int j = 1; j < 8; ++j) s4 += sp[j];
                        v = __builtin_amdgcn_rsqf(((s4.x + s4.y) + (s4.z + s4.w)) * (1.0f / D) + EPS); }
                    rs[tid] = v; }
                __syncthreads();
                const float* gain = a.in[2] + D;
                const int grp = tid >> 7;
                pool_body(2 << grp, H, gain, APB, rs, t0, tid);
                __syncthreads();
            }
            SEAM(11);
        }
        if (PH(12)) {
            Sched S; S.o.init(T / 256, 8, G, blk); S.A = (const char*)APB; S.B = (const char*)(ws + WS_PW); S.a_tile = 256ull * D * 2; S.b_tile = 256ull * 512 * 2; S.pn_shift = 1; S.a_pn_bytes = 512 * 2; S.tile_e = nullptr; S.b_exp = 0;
            EpiRes<true, true, true, true> E{H, H, APA, a.in[3] + D, SSQ, a.in[17], a.in[18]};
            gemm_phase<EpiRes<true, true, true, true>, Sched, false>(lds, 512 / 64, D, 512, S, E, nullptr);
            SEAM(12);
        }
    mem_layer<1>(a, lds, bar, lo, hi, G, blk, gw, ngw, lane);
    int* moi = (int*)(ws + WS_MOE); float* mof = (float*)(ws + WS_MOE);
    if (PH(16)) {
        int lane = threadIdx.x; asm volatile("" : "+v"(lane)); lane &= 63;
        LAS float* rl = (LAS float*)lds; LAS int* cnt = (LAS int*)(lds + 512 * 144);
        const float* router = a.in[26];
        for (int idx = tid; idx < 2048 * 8; idx += NTHREADS) { const int k = idx >> 3, e = idx & 7; rl[(k >> 2) * 36 + (k & 3) * 8 + e] = router[idx]; }
        for (int rep = 0; rep < ((PROBE_SMALL & 4) ? 3 : 1); ++rep) for (int tb = blk; tb < T / 64; tb += G) {
            if (tid < 8) cnt[tid] = 0;
            __syncthreads();
            const f32x4* gr = (const f32x4*)(a.in[5] + D) + lane;
            for (int i = 0; i < 8; ++i) {
                const int t = tb * 64 + wave * 8 + i;
                const f32x4* xr = (const f32x4*)(H + (size_t)t * D) + lane; f32x4 v[8]; float s = 0.f;
#pragma unroll
                for (int j = 0; j < 8; ++j) { v[j] = xr[64 * j]; s += (v[j].x * v[j].x + v[j].y * v[j].y) + (v[j].z * v[j].z + v[j].w * v[j].w); }
                const float r = __builtin_amdgcn_rsqf(wave_sum(s) * (1.0f / D) + EPS);
                float lg[8];
#pragma unroll
                for (int e = 0; e < 8; ++e) lg[e] = 0.f;
                unsigned* o8 = (unsigned*)((unsigned char*)APA + (size_t)t * D) + lane;
#pragma unroll
                for (int j = 0; j < 8; ++j) { const f32x4 u = (v[j] * r) * gr[64 * j]; o8[64 * j] = pk4_fp8(4.f * u.x, 4.f * u.y, 4.f * u.z, 4.f * u.w);
                    const LAS float* base = rl + (lane + 64 * j) * 36;
#pragma unroll
                    for (int rr = 0; rr < 4; ++rr) { const f32x4 w0 = *(const LAS f32x4*)(base + rr * 8), w1 = *(const LAS f32x4*)(base + rr * 8 + 4); const float uv = u[rr];
                        lg[0] += uv * w0.x; lg[1] += uv * w0.y; lg[2] += uv * w0.z; lg[3] += uv * w0.w; lg[4] += uv * w1.x; lg[5] += uv * w1.y; lg[6] += uv * w1.z; lg[7] += uv * w1.w; } }
#pragma unroll
                for (int e = 0; e < 8; ++e) lg[e] = wave_sum(lg[e]);
                int e0 = 0; float v0 = lg[0];
#pragma unroll
                for (int e = 1; e < 8; ++e) if (lg[e] > v0) { v0 = lg[e]; e0 = e; }
                int e1 = -1; float v1 = -3.0e38f;
#pragma unroll
                for (int e = 0; e < 8; ++e) if (e != e0 && lg[e] > v1) { v1 = lg[e]; e1 = e; }
                if (e1 < 0) { e1 = (e0 + 1) & 7; v1 = v0; }
                if (lane == 0) { const float w0 = 1.0f / (1.0f + __expf(v1 - v0)); moi[MO_TOPI + 2 * t] = e0; moi[MO_TOPI + 2 * t + 1] = e1; mof[MO_TOPW + 2 * t] = w0; mof[MO_TOPW + 2 * t + 1] = 1.0f - w0;
                    (void)__hip_atomic_fetch_add(cnt + e0, 1, __ATOMIC_RELAXED, __HIP_MEMORY_SCOPE_WORKGROUP); (void)__hip_atomic_fetch_add(cnt + e1, 1, __ATOMIC_RELAXED, __HIP_MEMORY_SCOPE_WORKGROUP); }
            }
            __syncthreads();
            if (tid < 8) moi[MO_CNTB + tb * 8 + tid] = cnt[tid];
            __syncthreads();
        }
        SEAM(16);
    }
    if (PH(17)) {
        LAS int* li = (LAS int*)lds;
        for (int tb = blk; tb < T / 64; tb += G) {
            if (tid < 8) { int tot = 0, pre = 0; for (int b = 0; b < T / 64; ++b) { const int c = moi[MO_CNTB + b * 8 + tid]; tot += c; if (b < tb) pre += c; } li[tid] = tot; li[16 + tid] = pre; }
            if (tid >= 64 && tid < 192) li[32 + tid - 64] = moi[MO_TOPI + tb * 128 + (tid - 64)];
            __syncthreads();
            if (tid == 0) { int p = 0; for (int e = 0; e < 8; ++e) { li[8 + e] = p; p += (li[e] + 255) / 256 * 256; } li[24] = p; }
            __syncthreads();
            if (tid < 128) { const int e = li[32 + tid]; int rank = 0; for (int m2 = 0; m2 < tid; ++m2) rank += (li[32 + m2] == e) ? 1 : 0;
                const int slot = li[8 + e] + li[16 + e] + rank, pairi = tb * 128 + tid;
                moi[MO_TOKS + slot] = pairi >> 1; moi[MO_PAIR + slot] = pairi; mof[MO_GATE + slot] = mof[MO_TOPW + pairi]; moi[MO_SLOT + pairi] = slot; }
            if (tb == 0) {
                for (int e = 0; e < 8; ++e) { const int beg = li[8 + e] + li[e], end = li[8 + e] + (li[e] + 255) / 256 * 256;
                    for (int s = beg + tid; s < end; s += NTHREADS) { moi[MO_TOKS + s] = 0; moi[MO_PAIR + s] = -1; mof[MO_GATE + s] = 0.f; }
                    const int t0 = li[8 + e] / 256, t1 = end / 256; for (int tt = t0 + tid; tt < t1; tt += NTHREADS) moi[MO_TILEE + tt] = e; }
                if (tid == 0) moi[MO_NT] = li[24] / 256;
            }
            __syncthreads();
        }
        SEAM(17);
    }
    if (PH(18)) {
        const int ntile = __builtin_amdgcn_readfirstlane(moi[MO_NT]);
        Sched S; S.o.init(ntile, 44, G, blk); S.A = (const char*)APA; S.B = (const char*)(ws + WS_MGU); S.a_tile = 0; S.b_tile = 256ull * D; S.pn_shift = 30; S.a_pn_bytes = 0; S.tile_e = moi + MO_TILEE; S.b_exp = 11264ull * D;
        EpiSwiglu<false, true> E{(bf16_t*)r1, nullptr};
        gemm_phase<EpiSwiglu<false, true>, Sched, true, true, 121, 125>(lds, D / 128, D, D, S, E, moi + MO_TOKS);
        SEAM(18);
    }
    if (PH(19)) {
        const int ntile = __builtin_amdgcn_readfirstlane(moi[MO_NT]);
        const MoeSplit ms = moe_split(ntile, G);
        SchedSK S; S.o.init(ms.F, 8, G, blk); S.A = (const char*)r1; S.B = (const char*)(ws + WS_MD); S.a_tile = 256ull * DFF; S.b_tile = 256ull * DFF; S.tile_e = moi + MO_TILEE; S.b_exp = 2048ull * DFF; S.F = ms.F; S.R = ms.R; S.sk = ms.sk; S.G = G; S.c = blk;
        EpiMoeDown E{APA, moi + MO_PAIR, mof + MO_GATE, (float*)(ws + WS_PART), ms.F * 256, ms.R * 256};
        gemm_phase<EpiMoeDown, SchedSK, false, true, 120, 123, true>(lds, DFF / 128, DFF, DFF, S, E, nullptr);
        SEAM(19);
    }
    if (PH(20)) {
        int lane = threadIdx.x; asm volatile("" : "+v"(lane)); lane &= 63;
        const MoeSplit ms = moe_split(__builtin_amdgcn_readfirstlane(moi[MO_NT]), G); const int tail0 = ms.sk > 1 ? ms.F * 256 : 0x7fffffff; const float* part = (const float*)(ws + WS_PART);
        int sl0 = 0, sl1 = 0;
        if (gw < T) { sl0 = __builtin_amdgcn_readfirstlane(moi[MO_SLOT + 2 * gw]); sl1 = __builtin_amdgcn_readfirstlane(moi[MO_SLOT + 2 * gw + 1]); }
        for (int rep = 0; rep < ((PROBE_SMALL & 8) ? 3 : 1); ++rep) for (int t = gw; t < T; t += ngw) {
            const f32x4* xr = (const f32x4*)(H + (size_t)t * D) + lane;
            f32x4 v[8];
            const int c0 = sl0, c1 = sl1; const int tn = t + ngw < T ? t + ngw : t;
            sl0 = __builtin_amdgcn_readfirstlane(moi[MO_SLOT + 2 * tn]); sl1 = __builtin_amdgcn_readfirstlane(moi[MO_SLOT + 2 * tn + 1]);
            if (c0 < tail0 && c1 < tail0) {
                const u32x2* y0 = (const u32x2*)(APA + (size_t)(2 * t) * D) + lane; const u32x2* y1 = (const u32x2*)(APA + (size_t)(2 * t + 1) * D) + lane;
#pragma unroll
                for (int j = 0; j < 8; ++j) { const u32x2 p0 = y0[64 * j], p1 = y1[64 * j];
                    f32x4 x = xr[64 * j];
                    x.x += __uint_as_float(p0.x << 16) + __uint_as_float(p1.x << 16); x.y += __uint_as_float(p0.x & 0xffff0000u) + __uint_as_float(p1.x & 0xffff0000u);
                    x.z += __uint_as_float(p0.y << 16) + __uint_as_float(p1.y << 16); x.w += __uint_as_float(p0.y & 0xffff0000u) + __uint_as_float(p1.y & 0xffff0000u);
                    v[j] = x; }
            } else {
#pragma unroll
                for (int j = 0; j < 8; ++j) v[j] = xr[64 * j];
#pragma unroll
                for (int k = 0; k < 2; ++k) {
                    const int slot = k ? c1 : c0;
                    if (slot < tail0) { const u32x2* y = (const u32x2*)(APA + (size_t)(2 * t + k) * D) + lane;
#pragma unroll
                        for (int j = 0; j < 8; ++j) { const u32x2 p0 = y[64 * j];
                            v[j].x += __uint_as_float(p0.x << 16); v[j].y += __uint_as_float(p0.x & 0xffff0000u); v[j].z += __uint_as_float(p0.y << 16); v[j].w += __uint_as_float(p0.y & 0xffff0000u); } }
                    else {
                        f32x4 ys[8];
                        for (int ks = 0; ks < ms.sk; ++ks) { const f32x4* pr = (const f32x4*)(part + ((size_t)ks * (ms.R * 256) + (slot - tail0)) * D) + lane;
#pragma unroll
                            for (int j = 0; j < 8; ++j) { const f32x4 q = pr[64 * j]; ys[j] = ks ? ys[j] + q : q; } }
#pragma unroll
                        for (int j = 0; j < 8; ++j) v[j] += ys[j]; }
                }
            }
            float s = 0.f;
#pragma unroll
            for (int j = 0; j < 8; ++j) { const f32x4 x = v[j]; s += (x.x * x.x + x.y * x.y) + (x.z * x.z + x.w * x.w); }
            const float r = __builtin_amdgcn_rsqf(wave_sum(s) * (1.0f / D) + EPS);
            const f32x4* gr = (const f32x4*)a.in[6] + lane; f32x4* orow = (f32x4*)(a.out + (size_t)t * D) + lane;
#pragma unroll
            for (int j = 0; j < 8; ++j) orow[64 * j] = (v[j] * r) * gr[64 * j];
        }
    }
#undef IN
#undef PH
#undef SEAM
}

extern "C" void kernel_launch(void* const* d_in, const int* in_sizes, int n_in, void* d_out, int out_size, void* d_ws, size_t ws_size, hipStream_t stream) {
    static int grid = 0;
    if (grid == 0) {
        if (n_in != 30 || out_size != T * D || ws_size < WS_END) { fprintf(stderr, "kernel_launch: unexpected shapes (n_in %d, out %d, ws %zu < %zu)\n", n_in, out_size, ws_size, (size_t)WS_END); grid = -1; return; }
        int dev = 0, cus = 0, per_cu = 0;
        if (hipGetDevice(&dev) != hipSuccess || hipDeviceGetAttribute(&cus, hipDeviceAttributeMultiprocessorCount, dev) != hipSuccess) { grid = -1; return; }
        if (hipFuncSetAttribute((const void*)mega_fwd, hipFuncAttributeMaxDynamicSharedMemorySize, LDS_BYTES) != hipSuccess) { fprintf(stderr, "kernel_launch: hipFuncSetAttribute failed\n"); grid = -1; return; }
        if (hipOccupancyMaxActiveBlocksPerMultiprocessor(&per_cu, (const void*)mega_fwd, NTHREADS, LDS_BYTES) != hipSuccess || per_cu < 1) { fprintf(stderr, "kernel_launch: occupancy query says %d\n", per_cu); (void)hipGetLastError(); grid = -1; return; }
        grid = cus;
    }
    if (grid < 0) return;
    (void)hipMemsetAsync((char*)d_ws + WS_CTL, 0, 1 * MiB, stream);
    Args a{};
    for (int i = 0; i < 30; ++i) a.in[i] = (const float*)d_in[i];
    a.out = (float*)d_out; a.ws = (unsigned char*)d_ws;
#if N_LAUNCH_MODE == 1
    a.ph_lo = 0; a.ph_hi = NPHASE;
    hipLaunchKernelGGL(mega_fwd, dim3(grid), dim3(NTHREADS), LDS_BYTES, stream, a);
#else
    for (int p = 0; p < NPHASE; ++p) { a.ph_lo = p; a.ph_hi = p + 1; hipLaunchKernelGGL(mega_fwd, dim3(grid), dim3(NTHREADS), LDS_BYTES, stream, a); }
#endif
}
```

```cpp
#include <hip/hip_runtime.h>
#include <type_traits>
#include <cstdio>
#include <cstdint>

#ifndef PROBE_SMALL
#define PROBE_SMALL 0
#endif
#ifndef NSA_PROBE
#define NSA_PROBE 0
#endif
#ifndef REPEAT_MASK
#define REPEAT_MASK 0u
#endif
#ifndef PHASE_MASK
#define PHASE_MASK 0xffffffffu
#endif
#ifndef N_LAUNCH_MODE
#define N_LAUNCH_MODE 1
#endif

#define LAS __attribute__((address_space(3)))
#define GAS __attribute__((address_space(1)))
typedef unsigned short bf16_t;
typedef short bf16x8 __attribute__((ext_vector_type(8)));
typedef float f32x4 __attribute__((ext_vector_type(4)));
typedef float f32x2 __attribute__((ext_vector_type(2)));
typedef unsigned u32x4 __attribute__((ext_vector_type(4)));
typedef unsigned u32x2 __attribute__((ext_vector_type(2)));
typedef int v4i_t __attribute__((ext_vector_type(4)));
typedef int v8i_t __attribute__((ext_vector_type(8)));

constexpr int T = 16384, D = 2048, NHEAD = 16, HD = 128, NGRP = 4;
constexpr int NSA_W = 5168;
constexpr int DFF = 5632, NEXP = 8;
constexpr int MEML = 256, MEMW = 512;
constexpr int NCMP = 1023;
constexpr float EPS = 1e-6f, NEGF = -1e30f, L2E = 1.4426950408889634f, QSCALE = 0.08838834764831845f;
constexpr int NWAVES = 8, NTHREADS = 512;

constexpr size_t MiB = 1ull << 20;
constexpr size_t alm(size_t x) { return (x + MiB - 1) / MiB * MiB; }
constexpr size_t WS_CTL = 0;
constexpr size_t WS_WIN = 1 * MiB;
constexpr size_t WS_WG = WS_WIN + alm(5120ull * 2048 * 2);
constexpr size_t WS_WOUT = WS_WG + alm(256ull * 2048 * 2);
constexpr size_t WS_MWQ = WS_WOUT + alm(2048ull * 2048 * 2);
constexpr size_t WS_MWKV = WS_MWQ + alm(2ull * 512 * 2048 * 2);
constexpr size_t WS_MWO = WS_MWKV + alm(2ull * 1024 * 2048 * 2);
constexpr size_t WS_FGU = WS_MWO + alm(2ull * 2048 * 512 * 2);
constexpr size_t WS_FD = WS_FGU + alm(11264ull * 2048 * 2);
constexpr size_t WS_MGU = WS_FD + alm(2048ull * 5632 * 2);
constexpr size_t WS_MD = WS_MGU + alm(8ull * 11264 * 2048 * 2);
constexpr size_t WS_PW = WS_MD + alm(8ull * 2048 * 5632 * 2);
constexpr size_t WS_C1 = WS_PW + alm(2048ull * 512 * 2);
constexpr size_t WS_C2 = WS_C1 + alm(2ull * 256 * 4096 * 2);
constexpr size_t WS_ROPE = WS_C2 + alm(2ull * 256 * 256 * 2);
constexpr size_t WS_H = WS_ROPE + alm((size_t)T * 64 * 8);
constexpr size_t WS_APA = WS_H + alm((size_t)T * D * 4);
constexpr size_t WS_APB = WS_APA + alm((size_t)T * D * 2);
constexpr size_t WS_MISC = WS_APB + alm((size_t)T * D * 2);
constexpr size_t WS_QM = WS_MISC;
constexpr size_t WS_OM = WS_QM + alm((size_t)T * 512 * 2);
constexpr size_t WS_MEMN = WS_OM + alm((size_t)T * 512 * 2);
constexpr size_t WS_KM = WS_MEMN + alm(2ull * 256 * 2048 * 2);
constexpr size_t WS_VMT = WS_KM + alm(2ull * 256 * 512 * 2);
constexpr size_t WS_SSQ = WS_VMT + alm(2ull * 512 * 256 * 2);
constexpr size_t WS_GATES = WS_SSQ + alm((size_t)T * 32 * 4);
constexpr size_t WS_B1 = WS_GATES + alm((size_t)T * 48 * 4);
constexpr size_t WS_MOE = WS_B1 + MiB;
constexpr size_t WS_IMP = WS_MOE + 2 * MiB;
constexpr size_t WS_R1 = WS_IMP + 32 * MiB;
constexpr int MAXSLOT = 34816;
constexpr size_t R1_BYTES = alm((size_t)MAXSLOT * DFF * 2);
constexpr size_t WS_END = WS_R1 + R1_BYTES;
constexpr size_t R_Q = 0;
constexpr size_t R_BLKK = R_Q + alm((size_t)T * 2048 * 2);
constexpr size_t R_BLKV = R_BLKK + alm(4096ull * 4096 * 2);
constexpr size_t R_KS = R_BLKV + alm(4096ull * 4096 * 2);
constexpr size_t R_VS = R_KS + alm((size_t)T * 512 * 2);
constexpr size_t R_KW = R_VS + alm((size_t)T * 512 * 2);
constexpr size_t R_VW = R_KW + alm((size_t)T * 512 * 2);
constexpr size_t R_VST = R_VW + alm((size_t)T * 512 * 2);
constexpr size_t R_VWT = R_VST + alm((size_t)T * 512 * 2);
constexpr size_t R_KC = R_VWT + alm((size_t)T * 512 * 2);
constexpr size_t R_VCT = R_KC + alm(4ull * 1024 * 128 * 2);
constexpr size_t R_HID = R_VCT + alm(4ull * 128 * 1024 * 2);
constexpr size_t R_O = R_HID + alm(2ull * 4096 * 256 * 2);
constexpr size_t R_NSA_END = R_O + alm((size_t)T * 2048 * 4);
static_assert(R_NSA_END <= R1_BYTES, "NSA overlay");
static_assert(WS_END <= 1476395008ull, "workspace");
constexpr int MO_TOPI = 0;
constexpr int MO_TOPW = MO_TOPI + T * 2;
constexpr int MO_CNTB = MO_TOPW + T * 2;
constexpr int MO_TOKS = MO_CNTB + 256 * 8;
constexpr int MO_PAIR = MO_TOKS + MAXSLOT;
constexpr int MO_GATE = MO_PAIR + MAXSLOT;
constexpr int MO_TILEE = MO_GATE + MAXSLOT;
constexpr int MO_NT = MO_TILEE + 160;
constexpr int MO_SLOT = MO_NT + 1;
static_assert((MO_SLOT + 2 * T) * 4 <= 2 * (int)MiB, "moe tables");
constexpr size_t WS_PART = WS_MGU + 8ull * 11264 * 2048;
struct MoeSplit { int F, R, sk; };
__device__ __forceinline__ MoeSplit moe_split(int ntile, int G) {
    MoeSplit m; m.F = ntile; m.R = 0; m.sk = 1;
    if (G == 256) { m.F = ntile & ~31; m.R = ntile - m.F; m.sk = m.R == 0 ? 1 : m.R <= 8 ? 4 : m.R <= 16 ? 2 : 1; if (m.sk == 1) { m.F = ntile; m.R = 0; } }
    return m;
}

constexpr int CW_BAR = 4096, CW_NSAQ = 8192;

constexpr int LDS_BYTES = 155648;
constexpr int MISC_OFF = LDS_BYTES - 256;

__device__ __forceinline__ unsigned cvt_pk_bf16(float lo, float hi) { unsigned r; asm("v_cvt_pk_bf16_f32 %0, %1, %2" : "=v"(r) : "v"(lo), "v"(hi)); return r; }
__device__ __forceinline__ bf16_t f2bf(float f) { return (bf16_t)(cvt_pk_bf16(f, 0.f) & 0xffffu); }
__device__ __forceinline__ float clamp448(float x) { return fminf(fmaxf(x, -448.f), 448.f); }
__device__ __forceinline__ unsigned pk4_fp8(float a, float b, float c, float d) {
    unsigned r = 0; r = __builtin_amdgcn_cvt_pk_fp8_f32(clamp448(a), clamp448(b), r, false); r = __builtin_amdgcn_cvt_pk_fp8_f32(clamp448(c), clamp448(d), r, true); return r; }
__device__ __forceinline__ float wave_sum(float v) {
#pragma unroll
    for (int o = 32; o >= 1; o >>= 1) v += __shfl_xor(v, o);
    return v;
}
__device__ __forceinline__ float fast_rcp(float x) { return __builtin_amdgcn_rcpf(x); }
__device__ __forceinline__ float fast_exp(float x) { return __builtin_amdgcn_exp2f(x * L2E); }
__device__ __forceinline__ float sigmoidf_(float x) { return fast_rcp(1.f + fast_exp(-x)); }
__device__ __forceinline__ float gelu_tanh(float x) { const float y = 0.7978845608028654f * (x + 0.044715f * x * x * x); const float t = 1.f - 2.f * fast_rcp(1.f + fast_exp(2.f * y)); return 0.5f * x * (1.f + t); }
#define LDS_WAIT() asm volatile("s_waitcnt lgkmcnt(0)" ::: "memory")
#define VM_WAIT() asm volatile("s_waitcnt vmcnt(0)" ::: "memory")

#define XB_TMO      128
#define XB_XCNT(j)  (256  + 64 * (j))
#define XB_XSUB(j)  (1280 + 64 * (j))
#define XB_XGEN(j)  (2304 + 64 * (j))
#define XB_TOP      3328
#define XB_TOPGEN   3392
#define XCD_BAR_WORDS 3456
#define XB_SPIN_CAP (1u << 18)
__device__ __forceinline__ unsigned xb_ld(unsigned* p)              { return __hip_atomic_load(p, __ATOMIC_RELAXED, __HIP_MEMORY_SCOPE_AGENT); }
__device__ __forceinline__ unsigned xb_add(unsigned* p, unsigned v) { return __hip_atomic_fetch_add(p, v, __ATOMIC_RELAXED, __HIP_MEMORY_SCOPE_AGENT); }
__device__ __forceinline__ unsigned xb_xcc_id() { return (unsigned)__builtin_amdgcn_s_getreg((3 << 11) | 20) & 0xFu; }
#define XB_SPIN(cond, bar) do { unsigned _sp = 0; while (cond) { __builtin_amdgcn_s_sleep(1); \
    if ((++_sp & 255u) == 0u) { if (xb_ld(&(bar)[XB_TMO])) break; if (_sp > XB_SPIN_CAP) { atomicAdd(&(bar)[XB_TMO], 1u); break; } } } } while (0)
struct XcdBarrier { unsigned* bar; unsigned x; volatile LAS unsigned* st; };
__device__ __forceinline__ XcdBarrier xcd_barrier_post(unsigned* bar, volatile LAS unsigned* st) {
    XcdBarrier b; b.bar = bar; b.x = xb_xcc_id(); b.st = st;
    if (threadIdx.x == 0) (void)xb_add(&bar[XB_XCNT(b.x)], 1u);
    return b;
}
__device__ __forceinline__ void xcd_barrier_complete(unsigned* bar, unsigned x, unsigned& nloc, unsigned& nx) {
    const unsigned G = gridDim.x * gridDim.y * gridDim.z;
    unsigned sum, cnt, mine, sp = 0u;
    for (;;) {
        sum = 0u; cnt = 0u; mine = 0u;
#pragma unroll
        for (unsigned j = 0; j < 16; ++j) { const unsigned c = xb_ld(&bar[XB_XCNT(j)]); sum += c; cnt += (c > 0u) ? 1u : 0u; mine = (j == x) ? c : mine; }
        if (sum == G) break;
        __builtin_amdgcn_s_sleep(1);
        if ((++sp & 255u) == 0u) { if (xb_ld(&bar[XB_TMO])) break; if (sp > XB_SPIN_CAP) { atomicAdd(&bar[XB_TMO], 1u); break; } }
    }
    nloc = mine > 0u ? mine : 1u; nx = cnt > 0u ? cnt : 1u;
}
__device__ __forceinline__ void xcd_barrier(const XcdBarrier& b) {
    asm volatile("s_waitcnt vmcnt(0)" ::: "memory");
    __syncthreads();
    if (threadIdx.x == 0) {
        unsigned* bar = b.bar;
        __builtin_amdgcn_s_waitcnt(0);
        unsigned nloc = b.st[0], nx = b.st[1];
        if (nloc == 0u) { xcd_barrier_complete(bar, b.x, nloc, nx); b.st[0] = nloc; b.st[1] = nx; }
        const unsigned old = xb_add(&bar[XB_XSUB(b.x)], 1u);
        const unsigned gen = old / nloc;
        if (old + 1u == (gen + 1u) * nloc) {
            __builtin_amdgcn_fence(__ATOMIC_RELEASE, "agent");
            asm volatile("s_waitcnt vmcnt(0)" ::: "memory");
            const unsigned og = xb_add(&bar[XB_TOP], 1u);
            const unsigned tg = og / nx;
            if (og + 1u == (tg + 1u) * nx) xb_add(&bar[XB_TOPGEN], 1u);
            else XB_SPIN(xb_ld(&bar[XB_TOPGEN]) == tg, bar);
            __builtin_amdgcn_fence(__ATOMIC_ACQUIRE, "agent");
            xb_add(&bar[XB_XGEN(b.x)], 1u);
            asm volatile("s_waitcnt vmcnt(0)" ::: "memory");
        } else {
            XB_SPIN(xb_ld(&bar[XB_XGEN(b.x)]) == gen, bar);
            __builtin_amdgcn_fence(__ATOMIC_ACQUIRE, "agent");
            asm volatile("s_waitcnt vmcnt(0)" ::: "memory");
        }
    }
    __syncthreads();
}

namespace gm {
constexpr int BM = 256, BK = 64, HALF = 128, HTB = HALF * BK * 2, STAGE_BYTES = 8 * HTB, NXCD = 8, WGM = 8;
__device__ __forceinline__ int lds_byte(int r, int c) { const int st = (r >> 4) * 2 + (c >> 5), rr = r & 15, cc = c & 31, ob = rr * 64 + cc * 2; return st * 1024 + (ob ^ (((ob >> 9) & 1) << 5)); }
__device__ __forceinline__ void stage_rc(int b, int& R, int& C) { const int st = b / 1024, sb = b % 1024, swz = sb ^ (((sb >> 9) & 1) << 5); R = (st >> 1) * 16 + swz / 64; C = (st & 1) * 32 + (swz % 64) / 2; }
__device__ __forceinline__ int perm32(int rho) { const int n = rho >> 4, i = rho & 15; return 8 * (i >> 2) + 4 * n + (i & 3); }

struct GUnit { const char* A; const char* B; int pm, pn, x0, x1; };

struct TileOrder {
    int nM, nN, nwg, G, c;
    __device__ __forceinline__ void init(int nM_, int nN_, int G_, int c_) { nM = nM_; nN = nN_; nwg = nM * nN; G = G_; c = c_; }
    __device__ __forceinline__ bool map(int i, int& pm, int& pn) const {
        const long L = (long)i * G + c; if (L >= nwg) return false;
        int wgid = (int)L; { const int q = nwg / NXCD, r = nwg % NXCD, xcd = wgid % NXCD, off = wgid / NXCD; wgid = (xcd < r ? xcd * (q + 1) : r * (q + 1) + (xcd - r) * q) + off; }
        const int nig = WGM * nN, gid = wgid / nig, fm = gid * WGM, gsz = (nM - fm) < WGM ? (nM - fm) : WGM;
        pm = fm + ((wgid % nig) % gsz); pn = (wgid % nig) / gsz; return true;
    }
};
struct Sched {
    TileOrder o; const char* A; const char* B; size_t a_tile, b_tile; int pn_shift; size_t a_pn_bytes; const int* tile_e; size_t b_exp;
    __device__ __forceinline__ bool next(int i, GUnit& u) const {
        int pm, pn; if (!o.map(i, pm, pn)) return false;
        u.pm = pm; u.pn = pn; u.x0 = 0; u.x1 = 0;
        u.A = A + (size_t)pm * a_tile + (size_t)(pn >> pn_shift) * a_pn_bytes;
        size_t bo = (size_t)pn * b_tile;
        if (tile_e) { const int e = __builtin_amdgcn_readfirstlane(tile_e[pm]); bo += (size_t)e * b_exp; u.x0 = e; }
        u.B = B + bo; return true;
    }
};
struct SchedSK { TileOrder o; const char* A; const char* B; size_t a_tile, b_tile; const int* tile_e; size_t b_exp; int F, R, sk, G, c;
    __device__ __forceinline__ bool next(int i, GUnit& u) const {
        const int L = i * G + c; int pm, pn, kt0 = 0, ntk = 44, ks1 = 0;
        if (L < F * 8) { if (!o.map(i, pm, pn)) return false; }
        else { const int Lt = L - F * 8; if (Lt >= R * 8 * sk) return false;
            pm = F + Lt / (8 * sk); pn = (Lt / sk) & 7; const int ks = Lt % sk; ks1 = ks + 1;
            if (sk == 4) { kt0 = 11 * ks + (ks & 1); ntk = 12 - 2 * (ks & 1); } else { kt0 = 22 * ks; ntk = 22; } }
        u.pm = pm; u.pn = pn; u.x1 = ntk | (ks1 << 8);
        const int e = __builtin_amdgcn_readfirstlane(tile_e[pm]); u.x0 = e;
        u.A = A + (size_t)pm * a_tile + (size_t)kt0 * 128; u.B = B + (size_t)pn * b_tile + (size_t)e * b_exp + (size_t)kt0 * 128; return true;
    }
};
struct OneUnit { GUnit u; bool on; __device__ __forceinline__ bool next(int i, GUnit& o) const { if (i || !on) return false; o = u; return true; } };

template <class Epi, class Sched_, bool GATHER, bool F8 = false, int SCW = 127, int SCA = 127, bool VARNT = false>
__device__ __forceinline__ void gemm_phase(LAS unsigned char* lds, const int nt_, const int lda, const int ldb, const Sched_& S, const Epi& E, const int* __restrict__ rowtab) {
    constexpr int EB = F8 ? 1 : 2;
    const int tid = threadIdx.x, wid = __builtin_amdgcn_readfirstlane(tid >> 6), lane = tid & 63, wr = wid >> 2, wc = wid & 3, fr = lane & 15, fq = lane >> 4;
    int Rr[2], Cc[2]; unsigned voffB[2];
#pragma unroll
    for (int i = 0; i < 2; ++i) { stage_rc(tid * 16 + i * 8192, Rr[i], Cc[i]); const int Rb = Epi::PERM ? ((Rr[i] & ~31) + perm32(Rr[i] & 31)) : Rr[i]; voffB[i] = (unsigned)(Rb * ldb * EB + Cc[i] * 2); }
    unsigned oA[2][2], oN[2][2];
    const size_t kstep = (size_t)(BK * 2);
    const size_t hstepB = (size_t)HALF * ldb * EB;
    const unsigned ldsw = (unsigned)wid * 1024u;
    const int aoff = lds_byte(wr * 64 + fr, fq * 8), boff = lds_byte(wc * 32 + fr, fq * 8);
#define G_SA(b, h) (((b) * 2 + (h)) * HTB)
#define G_SB(b, h) ((4 + (b) * 2 + (h)) * HTB)
#define G_STAGE(bufoff, gbase, voff) do { _Pragma("unroll") for (int _i = 0; _i < 2; ++_i) \
        __builtin_amdgcn_global_load_lds((const unsigned*)((const char*)(gbase) + (voff)[_i]), (LAS unsigned*)(lds + (bufoff) + ldsw + _i * 8192), 16, 0, 0); } while (0)
#define G_LD8(p) __builtin_shufflevector(*(const LAS v4i_t*)(p), *(const LAS v4i_t*)((p) + 1024), 0, 1, 2, 3, 4, 5, 6, 7)
#define G_LDA(dst, b, h) do { if constexpr (F8) { _Pragma("unroll") for (int m = 0; m < 4; ++m) dst##8[m] = G_LD8(lds + G_SA(b, h) + aoff + m * 2048); } \
        else { _Pragma("unroll") for (int m = 0; m < 4; ++m) _Pragma("unroll") for (int k = 0; k < 2; ++k) dst[m][k] = *(const LAS bf16x8*)(lds + G_SA(b, h) + aoff + m * 2048 + k * 1024); } } while (0)
#define G_LDB(dst, b, h) do { if constexpr (F8) { _Pragma("unroll") for (int n = 0; n < 2; ++n) dst##8[n] = G_LD8(lds + G_SB(b, h) + boff + n * 2048); } \
        else { _Pragma("unroll") for (int n = 0; n < 2; ++n) _Pragma("unroll") for (int k = 0; k < 2; ++k) dst[n][k] = *(const LAS bf16x8*)(lds + G_SB(b, h) + boff + n * 2048 + k * 1024); } } while (0)
#define G_MMA(ai, bj, At, Bt) do { __builtin_amdgcn_s_setprio(1); \
        if constexpr (F8) { _Pragma("unroll") for (int m = 0; m < 4; ++m) _Pragma("unroll") for (int n = 0; n < 2; ++n) \
            asm volatile("v_mfma_scale_f32_16x16x128_f8f6f4 %0, %1, %2, %0, %3, %4 op_sel_hi:[0,0,0]" : "+v"(acc[ai][bj][m][n]) : "v"(Bt##8[n]), "v"(At##8[m]), "v"(scw_reg), "v"(sca_reg)); } \
        else { _Pragma("unroll") for (int m = 0; m < 4; ++m) _Pragma("unroll") for (int n = 0; n < 2; ++n) _Pragma("unroll") for (int k = 0; k < 2; ++k) \
            acc[ai][bj][m][n] = __builtin_amdgcn_mfma_f32_16x16x32_bf16(Bt[n][k], At[m][k], acc[ai][bj][m][n], 0, 0, 0); } \
        __builtin_amdgcn_s_setprio(0); } while (0)
#define G_WAIT_V(n) asm volatile("s_waitcnt vmcnt(" #n ")" ::: "memory")
#define G_WAIT_L(n) asm volatile("s_waitcnt lgkmcnt(" #n ")" ::: "memory")
#define G_BAR __builtin_amdgcn_s_barrier()
#define G_SCHED __builtin_amdgcn_sched_barrier(0)
#define G_SETOFF(dst, U) do { _Pragma("unroll") for (int _h = 0; _h < 2; ++_h) _Pragma("unroll") for (int _i = 0; _i < 2; ++_i) { \
        if constexpr (GATHER) dst[_h][_i] = (unsigned)rowtab[(U).pm * 256 + _h * 128 + Rr[_i]] * (unsigned)(lda * EB) + (unsigned)(Cc[_i] * 2); \
        else dst[_h][_i] = (unsigned)((_h * 128 + Rr[_i]) * lda * EB + Cc[_i] * 2); } } while (0)
    GUnit cur, nxt; int ui = 0;
    if (!S.next(0, cur)) return;
    G_SETOFF(oA, cur);
    f32x4 acc[2][2][4][2];
#pragma unroll
    for (int a = 0; a < 2; ++a)
#pragma unroll
        for (int b = 0; b < 2; ++b)
#pragma unroll
            for (int m = 0; m < 4; ++m)
#pragma unroll
                for (int n = 0; n < 2; ++n) acc[a][b][m][n] = (f32x4){0.f, 0.f, 0.f, 0.f};
    bf16x8 At[4][2], B0[2][2], B1[2][2]; v8i_t At8[4], B08[2], B18[2]; const int scw_reg = SCW * 0x01010101, sca_reg = SCA * 0x01010101;
    const char* cA = cur.A; const char* cB = cur.B;
    G_STAGE(G_SB(0, 0), cB, voffB); G_STAGE(G_SB(0, 1), cB + hstepB, voffB); G_STAGE(G_SA(0, 0), cA, oA[0]); G_STAGE(G_SA(0, 1), cA, oA[1]);
    if (wr == 1) G_BAR;
    G_WAIT_V(2); G_BAR;
    G_STAGE(G_SB(1, 0), cB + kstep, voffB); G_STAGE(G_SA(1, 0), cA + kstep, oA[0]); G_STAGE(G_SB(1, 1), cB + hstepB + kstep, voffB);
    G_WAIT_V(6); G_BAR;
    for (;;) {
        const bool has_next = S.next(ui + 1, nxt);
        const char* nA = has_next ? nxt.A : cA; const char* nB = has_next ? nxt.B : cB;
        if constexpr (GATHER) {
            if (has_next) { G_SETOFF(oN, nxt); }
            else {
#pragma unroll
                for (int h = 0; h < 2; ++h)
#pragma unroll
                    for (int i = 0; i < 2; ++i) oN[h][i] = oA[h][i]; }
            asm volatile("" : "+v"(oN[0][0]), "+v"(oN[0][1]), "+v"(oN[1][0]), "+v"(oN[1][1]));
        }
        const int nt = VARNT ? __builtin_amdgcn_readfirstlane(cur.x1 & 255) : nt_;
        for (int t = 0; t < nt; t += 2) {
            const bool last = (t == nt - 2);
            const char* a1 = cA + (size_t)(t + 1) * kstep;
            const char* a2 = last ? nA : cA + (size_t)(t + 2) * kstep; const char* b2 = last ? nB : cB + (size_t)(t + 2) * kstep;
            const char* a3 = a2 + kstep; const char* b3 = b2 + kstep;
            G_LDB(B0, 0, 0); G_LDB(B1, 0, 1); G_SCHED; G_LDA(At, 0, 0); G_STAGE(G_SA(1, 1), a1, oA[1]);
            G_WAIT_V(8); G_WAIT_L(0); G_BAR; G_MMA(0, 0, At, B0); G_MMA(0, 1, At, B1); G_BAR; G_SCHED;
            if constexpr (GATHER) { if (last) {
#pragma unroll
                for (int h = 0; h < 2; ++h)
#pragma unroll
                    for (int i = 0; i < 2; ++i) oA[h][i] = oN[h][i]; } }
            G_LDA(At, 0, 1); G_STAGE(G_SB(0, 0), b2, voffB); G_STAGE(G_SB(0, 1), b2 + hstepB, voffB); G_STAGE(G_SA(0, 0), a2, oA[0]);
            G_WAIT_V(8); G_WAIT_L(0); G_BAR; G_MMA(1, 0, At, B0); G_MMA(1, 1, At, B1); G_BAR; G_SCHED;
            G_LDB(B0, 1, 0); G_LDB(B1, 1, 1); G_SCHED; G_LDA(At, 1, 0); G_STAGE(G_SA(0, 1), a2, oA[1]);
            G_WAIT_V(8); G_WAIT_L(0); G_BAR; G_MMA(0, 0, At, B0); G_MMA(0, 1, At, B1); G_BAR; G_SCHED;
            G_LDA(At, 1, 1); G_STAGE(G_SB(1, 0), b3, voffB); G_STAGE(G_SB(1, 1), b3 + hstepB, voffB); G_STAGE(G_SA(1, 0), a3, oA[0]);
            G_WAIT_V(8); G_WAIT_L(0); G_BAR; G_MMA(1, 0, At, B0); G_MMA(1, 1, At, B1); G_BAR; G_SCHED;
        }
        if constexpr (F8) asm volatile("s_nop 15\n\ts_nop 15" ::: "memory");
        if (wr == 0) G_BAR;
        E(acc, cur, wr, wc, fr, fq);
        if (!has_next) break;
#pragma unroll
        for (int a = 0; a < 2; ++a)
#pragma unroll
            for (int b = 0; b < 2; ++b)
#pragma unroll
                for (int m = 0; m < 4; ++m)
#pragma unroll
                    for (int n = 0; n < 2; ++n) acc[a][b][m][n] = (f32x4){0.f, 0.f, 0.f, 0.f};
        cur = nxt; cA = nA; cB = nB; ++ui;
        if (wr == 1) G_BAR;
    }
    G_WAIT_V(0);
    G_BAR;
#undef G_SA
#undef G_SB
#undef G_STAGE
#undef G_LDA
#undef G_LDB
#undef G_MMA
#undef G_LD8
#undef G_WAIT_V
#undef G_WAIT_L
#undef G_BAR
#undef G_SCHED
#undef G_SETOFF
}

typedef f32x4 Acc[2][2][4][2];

__device__ __forceinline__ float row_rstd(const float* ssqp, int row, int fq) {
    const f32x4* p = (const f32x4*)(ssqp + (size_t)row * 32 + 8 * fq); const f32x4 a = p[0], b = p[1];
    float s = (a.x + a.y) + (a.z + a.w) + (b.x + b.y) + (b.z + b.w);
    s += __shfl_xor(s, 16); s += __shfl_xor(s, 32);
    return __builtin_amdgcn_rsqf(s * (1.0f / 2048.0f) + EPS);
}

struct EpiInProj {
    static constexpr bool PERM = true;
    bf16_t* q; bf16_t* blkK; bf16_t* blkV; bf16_t* ks; bf16_t* vs; bf16_t* kw; bf16_t* vw; const float* rope;
    __device__ __forceinline__ void operator()(const Acc& acc, const GUnit& u, int wr, int wc, int fr, int fq) const {
        const int hh = wc >> 1, i0 = (wc & 1) * 32 + 8 * fq, H = 2 * u.pn + hh;
        const int seg = (H - 16) >> 2, gi = (H - 16) & 3;
        const bool isq = H < 16, rope_on = isq || seg == 2 || seg == 4;
        const float sc = isq ? QSCALE : 1.0f;
        const int row0 = u.pm * 256 + wr * 64 + fr;
        f32x4 csn[4];
        if (rope_on) { const f32x4* cs = (const f32x4*)(rope + ((size_t)row0 * 64 + i0) * 2);
#pragma unroll
            for (int p = 0; p < 4; ++p) csn[p] = cs[p]; }
#pragma unroll
        for (int ai = 0; ai < 2; ++ai)
#pragma unroll
            for (int m = 0; m < 4; ++m) {
                const int row = row0 + ai * 128 + m * 16;
                float x1[8], x2[8];
#pragma unroll
                for (int n = 0; n < 2; ++n)
#pragma unroll
                    for (int j = 0; j < 4; ++j) { x1[4 * n + j] = acc[ai][0][m][n][j]; x2[4 * n + j] = acc[ai][1][m][n][j]; }
                if (rope_on) {
                    f32x4 csv[4];
#pragma unroll
                    for (int p = 0; p < 4; ++p) csv[p] = csn[p];
                    if (ai * 4 + m < 7) { const int rown = row0 + ((ai * 4 + m + 1) >> 2) * 128 + ((ai * 4 + m + 1) & 3) * 16; const f32x4* cs = (const f32x4*)(rope + ((size_t)rown * 64 + i0) * 2);
#pragma unroll
                        for (int p = 0; p < 4; ++p) csn[p] = cs[p]; }
#pragma unroll
                    for (int p = 0; p < 4; ++p) { const f32x4 c = csv[p];
                        const float a0 = x1[2 * p], b0 = x2[2 * p], a1 = x1[2 * p + 1], b1 = x2[2 * p + 1];
                        x1[2 * p] = a0 * c.x - b0 * c.y; x2[2 * p] = b0 * c.x + a0 * c.y;
                        x1[2 * p + 1] = a1 * c.z - b1 * c.w; x2[2 * p + 1] = b1 * c.z + a1 * c.w; }
                }
                u32x4 w1, w2;
                w1.x = cvt_pk_bf16(x1[0] * sc, x1[1] * sc); w1.y = cvt_pk_bf16(x1[2] * sc, x1[3] * sc); w1.z = cvt_pk_bf16(x1[4] * sc, x1[5] * sc); w1.w = cvt_pk_bf16(x1[6] * sc, x1[7] * sc);
                w2.x = cvt_pk_bf16(x2[0] * sc, x2[1] * sc); w2.y = cvt_pk_bf16(x2[2] * sc, x2[3] * sc); w2.z = cvt_pk_bf16(x2[4] * sc, x2[5] * sc); w2.w = cvt_pk_bf16(x2[6] * sc, x2[7] * sc);
                if (isq) { bf16_t* d = q + (size_t)row * 2048 + H * 128 + i0; *(u32x4*)d = w1; *(u32x4*)(d + 64) = w2; }
                else if (seg < 2) {
                    unsigned char* blk = (unsigned char*)(seg == 0 ? blkK : blkV); const int c1 = row >> 4, i1 = row & 15;
                    u32x2 f1, f2; f1.x = pk4_fp8(4.f * x1[0], 4.f * x1[1], 4.f * x1[2], 4.f * x1[3]); f1.y = pk4_fp8(4.f * x1[4], 4.f * x1[5], 4.f * x1[6], 4.f * x1[7]);
                    f2.x = pk4_fp8(4.f * x2[0], 4.f * x2[1], 4.f * x2[2], 4.f * x2[3]); f2.y = pk4_fp8(4.f * x2[4], 4.f * x2[5], 4.f * x2[6], 4.f * x2[7]);
                    if (c1 < NCMP) { unsigned char* d = blk + (size_t)(c1 * 4 + gi) * 4096 + i1 * 128 + i0; *(u32x2*)d = f1; *(u32x2*)(d + 64) = f2; }
                    if (c1 >= 1) { unsigned char* d = blk + (size_t)((c1 - 1) * 4 + gi) * 4096 + (i1 + 16) * 128 + i0; *(u32x2*)d = f1; *(u32x2*)(d + 64) = f2; }
                } else {
                    bf16_t* buf = seg == 2 ? ks : seg == 3 ? vs : seg == 4 ? kw : vw;
                    bf16_t* d = buf + (size_t)row * 512 + gi * 128 + i0; *(u32x4*)d = w1; *(u32x4*)(d + 64) = w2;
                }
            }
    }
};
struct EpiCmp1 {
    static constexpr bool PERM = true;
    bf16_t* hid; const float* b1;
    __device__ __forceinline__ void operator()(const Acc& acc, const GUnit& u, int wr, int wc, int fr, int fq) const {
        const int row0 = u.pm * 256 + wr * 64 + fr, col0 = wc * 32 + 8 * fq; const float* bb = b1 + u.x0 * 16 * 256; bf16_t* hb = hid + (size_t)u.x0 * 4096 * 256;
#pragma unroll
        for (int bj = 0; bj < 2; ++bj) {
            f32x4 bv0 = (f32x4){0.f, 0.f, 0.f, 0.f}, bv1 = bv0;
#pragma unroll 2
            for (int kc = 0; kc < 16; ++kc) { bv0 += *(const f32x4*)(bb + kc * 256 + bj * 128 + col0); bv1 += *(const f32x4*)(bb + kc * 256 + bj * 128 + col0 + 4); }
#pragma unroll
            for (int ai = 0; ai < 2; ++ai)
#pragma unroll
                for (int m = 0; m < 4; ++m) { const int row = row0 + ai * 128 + m * 16;
                    const f32x4 v0 = acc[ai][bj][m][0] + bv0, v1 = acc[ai][bj][m][1] + bv1; u32x4 w;
                    w.x = cvt_pk_bf16(gelu_tanh(v0.x), gelu_tanh(v0.y)); w.y = cvt_pk_bf16(gelu_tanh(v0.z), gelu_tanh(v0.w));
                    w.z = cvt_pk_bf16(gelu_tanh(v1.x), gelu_tanh(v1.y)); w.w = cvt_pk_bf16(gelu_tanh(v1.z), gelu_tanh(v1.w));
                    *(u32x4*)(hb + (size_t)row * 256 + bj * 128 + col0) = w; }
        }
    }
};
struct EpiCmp2 {
    static constexpr bool PERM = true;
    bf16_t* kc; bf16_t* vct; const float* rope;
    __device__ __forceinline__ void operator()(const Acc& acc, const GUnit& u, int wr, int wc, int fr, int fq) const {
        if (wc >= 2) return;
        const int i0 = wc * 32 + 8 * fq, row0 = u.pm * 256 + wr * 64 + fr;
#pragma unroll
        for (int ai = 0; ai < 2; ++ai)
#pragma unroll
            for (int m = 0; m < 4; ++m) {
                const int row = row0 + ai * 128 + m * 16, c = row >> 2, g = row & 3; const bool ok = c < NCMP;
                float x1[8], x2[8];
#pragma unroll
                for (int n = 0; n < 2; ++n)
#pragma unroll
                    for (int j = 0; j < 4; ++j) { x1[4 * n + j] = ok ? acc[ai][0][m][n][j] : 0.f; x2[4 * n + j] = ok ? acc[ai][1][m][n][j] : 0.f; }
                if (u.x0 == 0) {
                    if (ok) { const f32x4* cs = (const f32x4*)(rope + ((size_t)(16 * c + 31) * 64 + i0) * 2);
#pragma unroll
                        for (int p = 0; p < 4; ++p) { const f32x4 cc = cs[p];
                            const float a0 = x1[2 * p], b0 = x2[2 * p], a1 = x1[2 * p + 1], b1 = x2[2 * p + 1];
                            x1[2 * p] = a0 * cc.x - b0 * cc.y; x2[2 * p] = b0 * cc.x + a0 * cc.y;
                            x1[2 * p + 1] = a1 * cc.z - b1 * cc.w; x2[2 * p + 1] = b1 * cc.z + a1 * cc.w; } }
                    u32x4 w1, w2;
                    w1.x = cvt_pk_bf16(x1[0], x1[1]); w1.y = cvt_pk_bf16(x1[2], x1[3]); w1.z = cvt_pk_bf16(x1[4], x1[5]); w1.w = cvt_pk_bf16(x1[6], x1[7]);
                    w2.x = cvt_pk_bf16(x2[0], x2[1]); w2.y = cvt_pk_bf16(x2[2], x2[3]); w2.z = cvt_pk_bf16(x2[4], x2[5]); w2.w = cvt_pk_bf16(x2[6], x2[7]);
                    bf16_t* d = kc + ((size_t)g * 1024 + c) * 128 + i0; *(u32x4*)d = w1; *(u32x4*)(d + 64) = w2;
                } else {
#pragma unroll
                    for (int j = 0; j < 8; ++j) { vct[((size_t)g * 128 + i0 + j) * 1024 + c] = f2bf(x1[j]); vct[((size_t)g * 128 + 64 + i0 + j) * 1024 + c] = f2bf(x2[j]); }
                }
            }
    }
};
struct EpiGates {
    static constexpr bool PERM = false;
    float* gates; const float* gb;
    __device__ __forceinline__ void operator()(const Acc& acc, const GUnit& u, int wr, int wc, int fr, int fq) const {
        if (wc >= 2) return;
        const int row0 = u.pm * 256 + wr * 64 + fr;
#pragma unroll
        for (int n = 0; n < 2; ++n) {
            if (wc == 1 && n == 1) continue;
            const int c = 32 * wc + 16 * n + 4 * fq; const f32x4 bv = *(const f32x4*)(gb + c);
#pragma unroll
            for (int ai = 0; ai < 2; ++ai)
#pragma unroll
                for (int m = 0; m < 4; ++m) { const int row = row0 + ai * 128 + m * 16; const f32x4 v = acc[ai][0][m][n] + bv;
                    *(f32x4*)(gates + (size_t)row * 48 + c) = (f32x4){sigmoidf_(v.x), sigmoidf_(v.y), sigmoidf_(v.z), sigmoidf_(v.w)}; }
        }
    }
};
struct EpiMemKV {
    static constexpr bool PERM = true;
    bf16_t* km; bf16_t* vmt;
    __device__ __forceinline__ void operator()(const Acc& acc, const GUnit& u, int wr, int wc, int fr, int fq) const {
        const int row0 = wr * 64 + fr, l = u.x0;
#pragma unroll
        for (int ai = 0; ai < 2; ++ai)
#pragma unroll
            for (int m = 0; m < 4; ++m) { const int row = row0 + ai * 128 + m * 16;
#pragma unroll
                for (int bj = 0; bj < 2; ++bj) { const f32x4 v0 = acc[ai][bj][m][0], v1 = acc[ai][bj][m][1];
                    if (u.pn < 2) { u32x4 w; w.x = cvt_pk_bf16(v0.x, v0.y); w.y = cvt_pk_bf16(v0.z, v0.w); w.z = cvt_pk_bf16(v1.x, v1.y); w.w = cvt_pk_bf16(v1.z, v1.w);
                        *(u32x4*)(km + ((size_t)l * 256 + row) * 512 + u.pn * 256 + bj * 128 + wc * 32 + 8 * fq) = w; }
                    else { const int d0 = (u.pn - 2) * 256 + bj * 128 + wc * 32 + 8 * fq; bf16_t* vb = vmt + (size_t)l * 512 * 256;
#pragma unroll
                        for (int j = 0; j < 4; ++j) { vb[(size_t)(d0 + j) * 256 + row] = f2bf(v0[j]); vb[(size_t)(d0 + 4 + j) * 256 + row] = f2bf(v1[j]); } }
                }
            }
    }
};
template <bool HAS_AP, bool HAS_SSQ, bool POOL, bool AP8 = false>
struct EpiRes {
    static constexpr bool PERM = false;
    const float* hin; float* hout; bf16_t* ap; const float* gain; float* ssqp; const float* bias; const float* scale;
    __device__ __forceinline__ void operator()(const Acc& acc, const GUnit& u, int wr, int wc, int fr, int fq) const {
        const int row0 = u.pm * 256 + wr * 64 + fr, col0 = u.pn * 256 + wc * 32 + 4 * fq;
        f32x4 gv[2][2], bv[2][2], sv[2][2];
#pragma unroll
        for (int bj = 0; bj < 2; ++bj)
#pragma unroll
            for (int n = 0; n < 2; ++n) { const int c = col0 + bj * 128 + n * 16;
                if (HAS_AP) gv[bj][n] = *(const f32x4*)(gain + c);
                if (POOL) { bv[bj][n] = *(const f32x4*)(bias + c); sv[bj][n] = *(const f32x4*)(scale + c); } }
        f32x4 hnx[2][2];
#pragma unroll
        for (int bj = 0; bj < 2; ++bj)
#pragma unroll
            for (int n = 0; n < 2; ++n) hnx[bj][n] = *(const f32x4*)(hin + (size_t)row0 * D + col0 + bj * 128 + n * 16);
#pragma unroll
        for (int ai = 0; ai < 2; ++ai)
#pragma unroll
            for (int m = 0; m < 4; ++m) { const int row = row0 + ai * 128 + m * 16; const size_t off = (size_t)row * D + col0; float ss = 0.f;
                f32x4 hcur[2][2];
#pragma unroll
                for (int bj = 0; bj < 2; ++bj)
#pragma unroll
                    for (int n = 0; n < 2; ++n) hcur[bj][n] = hnx[bj][n];
                if (ai * 4 + m < 7) { const int rown = row0 + ((ai * 4 + m + 1) >> 2) * 128 + ((ai * 4 + m + 1) & 3) * 16;
#pragma unroll
                    for (int bj = 0; bj < 2; ++bj)
#pragma unroll
                        for (int n = 0; n < 2; ++n) hnx[bj][n] = *(const f32x4*)(hin + (size_t)rown * D + col0 + bj * 128 + n * 16); }
#pragma unroll
                for (int bj = 0; bj < 2; ++bj)
#pragma unroll
                    for (int n = 0; n < 2; ++n) { const f32x4 hv = hcur[bj][n]; f32x4 v = acc[ai][bj][m][n];
                        if (POOL) v = (v + bv[bj][n]) * sv[bj][n];
                        const f32x4 o = hv + v; *(f32x4*)(hout + off + bj * 128 + n * 16) = o;
                        if (HAS_SSQ) ss += (o.x * o.x + o.y * o.y) + (o.z * o.z + o.w * o.w);
                        if (HAS_AP) { const f32x4 z = o * gv[bj][n];
                            if (AP8) *(unsigned*)((unsigned char*)ap + off + bj * 128 + n * 16) = pk4_fp8(4.f * z.x, 4.f * z.y, 4.f * z.z, 4.f * z.w);
                            else { u32x2 w; w.x = cvt_pk_bf16(z.x, z.y); w.y = cvt_pk_bf16(z.z, z.w); *(u32x2*)(ap + off + bj * 128 + n * 16) = w; } } }
                if (HAS_SSQ) { ss += __shfl_xor(ss, 16); ss += __shfl_xor(ss, 32); if (fq == 0) ssqp[(size_t)row * 32 + u.pn * 4 + wc] = ss; }
            }
    }
};
struct EpiMemQ {
    static constexpr bool PERM = true;
    bf16_t* qm; const float* ssqp;
    __device__ __forceinline__ void operator()(const Acc& acc, const GUnit& u, int wr, int wc, int fr, int fq) const {
        const int row0 = u.pm * 256 + wr * 64 + fr, col0 = u.pn * 256 + wc * 32 + 8 * fq;
        float rr[2][4];
#pragma unroll
        for (int ai = 0; ai < 2; ++ai)
#pragma unroll
            for (int m = 0; m < 4; ++m) rr[ai][m] = row_rstd(ssqp, row0 + ai * 128 + m * 16, fq) * QSCALE;
#pragma unroll
        for (int ai = 0; ai < 2; ++ai)
#pragma unroll
            for (int m = 0; m < 4; ++m) { const int row = row0 + ai * 128 + m * 16; const float r = rr[ai][m];
#pragma unroll
                for (int bj = 0; bj < 2; ++bj) { const f32x4 v0 = acc[ai][bj][m][0] * r, v1 = acc[ai][bj][m][1] * r; u32x4 w;
                    w.x = cvt_pk_bf16(v0.x, v0.y); w.y = cvt_pk_bf16(v0.z, v0.w); w.z = cvt_pk_bf16(v1.x, v1.y); w.w = cvt_pk_bf16(v1.z, v1.w);
                    *(u32x4*)(qm + (size_t)row * 512 + col0 + bj * 128) = w; } }
    }
};
template <bool RSTD, bool F8OUT = false>
struct EpiSwiglu {
    static constexpr bool PERM = true;
    bf16_t* act; const float* ssqp;
    __device__ __forceinline__ void operator()(const Acc& acc, const GUnit& u, int wr, int wc, int fr, int fq) const {
        const int row0 = u.pm * 256 + wr * 64 + fr, col0 = u.pn * 128 + wc * 32 + 8 * fq;
        float rr[2][4];
#pragma unroll
        for (int ai = 0; ai < 2; ++ai)
#pragma unroll
            for (int m = 0; m < 4; ++m) rr[ai][m] = RSTD ? row_rstd(ssqp, row0 + ai * 128 + m * 16, fq) : 1.f;
#pragma unroll
        for (int ai = 0; ai < 2; ++ai)
#pragma unroll
            for (int m = 0; m < 4; ++m) { const int row = row0 + ai * 128 + m * 16; const float r = rr[ai][m];
                float o[8];
#pragma unroll
                for (int n = 0; n < 2; ++n)
#pragma unroll
                    for (int j = 0; j < 4; ++j) { const float g = acc[ai][0][m][n][j] * r, uu = acc[ai][1][m][n][j] * r; o[4 * n + j] = g * sigmoidf_(g) * uu; }
                if constexpr (F8OUT) { u32x2 w; w.x = pk4_fp8(16.f * o[0], 16.f * o[1], 16.f * o[2], 16.f * o[3]); w.y = pk4_fp8(16.f * o[4], 16.f * o[5], 16.f * o[6], 16.f * o[7]);
                    *(u32x2*)((unsigned char*)act + (size_t)row * DFF + col0) = w; }
                else { u32x4 w; w.x = cvt_pk_bf16(o[0], o[1]); w.y = cvt_pk_bf16(o[2], o[3]); w.z = cvt_pk_bf16(o[4], o[5]); w.w = cvt_pk_bf16(o[6], o[7]);
                    *(u32x4*)(act + (size_t)row * DFF + col0) = w; } }
    }
};
struct EpiMoeDown {
    static constexpr bool PERM = true;
    bf16_t* ybuf; const int* pair; const float* gate; float* part; int tail_row0, part_rows;
    __device__ __forceinline__ void operator()(const Acc& acc, const GUnit& u, int wr, int wc, int fr, int fq) const {
        const int row0 = u.pm * 256 + wr * 64 + fr, col0 = u.pn * 256 + wc * 32 + 8 * fq;
        int prs[2][4]; float gs[2][4];
#pragma unroll
        for (int ai = 0; ai < 2; ++ai)
#pragma unroll
            for (int m = 0; m < 4; ++m) { prs[ai][m] = pair[row0 + ai * 128 + m * 16]; gs[ai][m] = gate[row0 + ai * 128 + m * 16]; }
        const int ks1 = __builtin_amdgcn_readfirstlane(u.x1 >> 8);
        if (ks1) {
            float* pb = part + ((size_t)(ks1 - 1) * part_rows + (row0 - tail_row0)) * D + col0;
#pragma unroll
            for (int ai = 0; ai < 2; ++ai)
#pragma unroll
                for (int m = 0; m < 4; ++m) { const float g = gs[ai][m];
                    if (prs[ai][m] >= 0) {
#pragma unroll
                        for (int bj = 0; bj < 2; ++bj) { float* q = pb + (size_t)(ai * 128 + m * 16) * D + bj * 128; *(f32x4*)q = acc[ai][bj][m][0] * g; *(f32x4*)(q + 4) = acc[ai][bj][m][1] * g; } } }
            return;
        }
#pragma unroll
        for (int ai = 0; ai < 2; ++ai)
#pragma unroll
            for (int m = 0; m < 4; ++m) { const int pr = prs[ai][m]; const float g = gs[ai][m];
                if (pr >= 0) {
#pragma unroll
                    for (int bj = 0; bj < 2; ++bj) { const f32x4 v0 = acc[ai][bj][m][0] * g, v1 = acc[ai][bj][m][1] * g; u32x4 w;
                        w.x = cvt_pk_bf16(v0.x, v0.y); w.y = cvt_pk_bf16(v0.z, v0.w); w.z = cvt_pk_bf16(v1.x, v1.y); w.w = cvt_pk_bf16(v1.z, v1.w);
                        *(u32x4*)(ybuf + (size_t)pr * D + col0 + bj * 128) = w; } } }
    }
};
}

struct CT { bf16x8 q[4]; f32x4 o[8]; float m, l; };
__device__ __forceinline__ f32x4 mfma16(bf16x8 a, bf16x8 b, f32x4 c) { return __builtin_amdgcn_mfma_f32_16x16x32_bf16(a, b, c, 0, 0, 0); }
__device__ __forceinline__ void ct_init(CT& c) {
#pragma unroll
    for (int d = 0; d < 8; ++d) c.o[d] = (f32x4){0.f, 0.f, 0.f, 0.f};
    c.m = NEGF; c.l = 0.f;
}
template <int NCT>
__device__ __forceinline__ void att_scores(const CT (&ct)[NCT], const bf16_t* Kp, int kstr, int lane, f32x4 (&s)[NCT][2]) {
    const int i = lane & 15, g = lane >> 4;
    const bf16_t* k0 = Kp + (size_t)(8 * (i >> 2) + (i & 3)) * kstr + 8 * g;
#pragma unroll
    for (int c = 0; c < NCT; ++c) { s[c][0] = (f32x4){0.f, 0.f, 0.f, 0.f}; s[c][1] = (f32x4){0.f, 0.f, 0.f, 0.f}; }
#pragma unroll
    for (int ks = 0; ks < 4; ++ks) {
        const bf16x8 ka = *(const bf16x8*)(k0 + 32 * ks), kb = *(const bf16x8*)(k0 + (size_t)4 * kstr + 32 * ks);
#pragma unroll
        for (int c = 0; c < NCT; ++c) { s[c][0] = mfma16(ka, ct[c].q[ks], s[c][0]); s[c][1] = mfma16(kb, ct[c].q[ks], s[c][1]); }
    }
}
__device__ __forceinline__ bf16x8 att_softmax(CT& c, const f32x4 (&s)[2], const bool (&valid)[8], bool do_pv) {
    float sv[8];
#pragma unroll
    for (int e = 0; e < 8; ++e) sv[e] = valid[e] ? s[e >> 2][e & 3] : NEGF;
    float mx = fmaxf(fmaxf(fmaxf(sv[0], sv[1]), fmaxf(sv[2], sv[3])), fmaxf(fmaxf(sv[4], sv[5]), fmaxf(sv[6], sv[7])));
    mx = fmaxf(mx, __shfl_xor(mx, 16)); mx = fmaxf(mx, __shfl_xor(mx, 32));
    const float mnew = fmaxf(c.m, mx), alpha = __builtin_amdgcn_exp2f((c.m - mnew) * L2E);
    float p[8], ps = 0.f;
#pragma unroll
    for (int e = 0; e < 8; ++e) { p[e] = valid[e] ? __builtin_amdgcn_exp2f((sv[e] - mnew) * L2E) : 0.f; ps += p[e]; }
    c.l = c.l * alpha + ps; c.m = mnew;
    if (do_pv) {
#pragma unroll
        for (int d = 0; d < 8; ++d) c.o[d] = c.o[d] * alpha;
    }
    u32x4 w; w.x = cvt_pk_bf16(p[0], p[1]); w.y = cvt_pk_bf16(p[2], p[3]); w.z = cvt_pk_bf16(p[4], p[5]); w.w = cvt_pk_bf16(p[6], p[7]);
    return __builtin_bit_cast(bf16x8, w);
}
template <int NCT>
__device__ __forceinline__ void att_pv(CT (&ct)[NCT], const bf16x8 (&pb)[NCT], const bf16_t* Vp, int vstr, int lane) {
    const int i = lane & 15, g = lane >> 4;
    const bf16_t* v0 = Vp + (size_t)i * vstr + 8 * g;
#pragma unroll
    for (int d = 0; d < 8; ++d) { const bf16x8 vf = *(const bf16x8*)(v0 + (size_t)(16 * d) * vstr);
#pragma unroll
        for (int c = 0; c < NCT; ++c) ct[c].o[d] = mfma16(vf, pb[c], ct[c].o[d]); }
}
__device__ __forceinline__ float ct_lsum(const CT& c) { float l = c.l; l += __shfl_xor(l, 16); l += __shfl_xor(l, 32); return l; }

struct Args { const float* in[30]; float* out; unsigned char* ws; int ph_lo, ph_hi; };

struct TrDesc { const float* src; unsigned char* dst; int ldw, ldt, nvalid; float scale; };
__device__ __forceinline__ void tr_load(const TrDesc& d, float (&v)[32], int lane) {
    const int nn = lane & 31, kh = lane >> 5; const bool ok = nn < d.nvalid; const float* W = d.src + (size_t)kh * d.ldw + (ok ? nn : 0);
#pragma unroll
    for (int i = 0; i < 32; ++i) v[i] = W[(size_t)(2 * i) * d.ldw];
}
__device__ __forceinline__ void tr_store(const TrDesc& d, const float (&v)[32], LAS float* scr, int lane) {
    const int nn = lane & 31, kh = lane >> 5; const bool ok = nn < d.nvalid;
#pragma unroll
    for (int i = 0; i < 32; ++i) scr[(2 * i + kh) * 33 + nn] = ok ? v[i] : 0.f;
    LDS_WAIT(); asm volatile("" ::: "memory");
    if (d.scale != 0.f) {
        const int c = lane & 3; const float sc = d.scale;
#pragma unroll
        for (int j = 0; j < 2; ++j) { const int n = (lane >> 2) + 16 * j; const LAS float* s = scr + (16 * c) * 33 + n;
            u32x4 o; o.x = pk4_fp8(sc * s[0 * 33], sc * s[1 * 33], sc * s[2 * 33], sc * s[3 * 33]); o.y = pk4_fp8(sc * s[4 * 33], sc * s[5 * 33], sc * s[6 * 33], sc * s[7 * 33]);
            o.z = pk4_fp8(sc * s[8 * 33], sc * s[9 * 33], sc * s[10 * 33], sc * s[11 * 33]); o.w = pk4_fp8(sc * s[12 * 33], sc * s[13 * 33], sc * s[14 * 33], sc * s[15 * 33]);
            *(u32x4*)(d.dst + (size_t)n * d.ldt + 16 * c) = o; }
    } else {
        const int c = lane & 7; bf16_t* WT = (bf16_t*)d.dst;
#pragma unroll
        for (int j = 0; j < 4; ++j) { const int n = (lane >> 3) + 8 * j; const LAS float* s = scr + (8 * c) * 33 + n;
            u32x4 o; o.x = cvt_pk_bf16(s[0 * 33], s[1 * 33]); o.y = cvt_pk_bf16(s[2 * 33], s[3 * 33]); o.z = cvt_pk_bf16(s[4 * 33], s[5 * 33]); o.w = cvt_pk_bf16(s[6 * 33], s[7 * 33]);
            *(u32x4*)(WT + (size_t)n * d.ldt + 8 * c) = o; }
    }
    LDS_WAIT(); asm volatile("" ::: "memory");
}
__device__ __forceinline__ int map_in(int n0) { const int H = n0 >> 7, d = n0 & 127; return 256 * (H >> 1) + 128 * (d >> 6) + 64 * (H & 1) + (d & 63); }
__device__ __forceinline__ int map_gu(int c, int up) { return 256 * (c >> 7) + 128 * up + (c & 127); }
__device__ __forceinline__ int map_c2(int d) { return 128 * (d >> 6) + (d & 63); }
__device__ __forceinline__ void rms_row_bf16(const float* xrow, const float* gain, bf16_t* orow, int lane) {
    const f32x4* xr = (const f32x4*)xrow + lane; f32x4 v[8]; float s = 0.f;
#pragma unroll
    for (int j = 0; j < 8; ++j) { v[j] = xr[64 * j]; s += (v[j].x * v[j].x + v[j].y * v[j].y) + (v[j].z * v[j].z + v[j].w * v[j].w); }
    const float r = __builtin_amdgcn_rsqf(wave_sum(s) * (1.0f / D) + EPS);
    const f32x4* gr = (const f32x4*)gain + lane; u32x2* o8 = (u32x2*)orow + lane;
#pragma unroll
    for (int j = 0; j < 8; ++j) { const f32x4 g = gr[64 * j]; const f32x4 z = (v[j] * r) * g; u32x2 w; w.x = cvt_pk_bf16(z.x, z.y); w.y = cvt_pk_bf16(z.z, z.w); o8[64 * j] = w; }
}
__device__ __forceinline__ void rms_row_f8(const float* xrow, const float* gain, unsigned char* orow, int lane) {
    const f32x4* xr = (const f32x4*)xrow + lane; f32x4 v[8]; float s = 0.f;
#pragma unroll
    for (int j = 0; j < 8; ++j) { v[j] = xr[64 * j]; s += (v[j].x * v[j].x + v[j].y * v[j].y) + (v[j].z * v[j].z + v[j].w * v[j].w); }
    const float r = __builtin_amdgcn_rsqf(wave_sum(s) * (1.0f / D) + EPS) * 4.0f;
    const f32x4* gr = (const f32x4*)gain + lane; unsigned* o4 = (unsigned*)orow + lane;
#pragma unroll
    for (int j = 0; j < 8; ++j) { const f32x4 g = gr[64 * j]; const f32x4 z = (v[j] * r) * g; o4[64 * j] = pk4_fp8(z.x, z.y, z.z, z.w); }
}
__device__ __forceinline__ void tr_decode(const Args& a, int it, TrDesc& dd) {
    unsigned char* ws = a.ws;
    constexpr int I_MOE = 45056, I_F = 5632, I_IN = 5120, I_ING = 64, I_OUT = 2048, I_M4 = 1024, I_PW = 512, I_C1 = 512, I_C2 = 16;
        const float* src; int ldw, nvalid = 32, ldt; unsigned char* dst; float scale = 0.f;
        int r = it;
        if (r < 3 * I_MOE) { const int which = r / I_MOE, rr = r % I_MOE, e = rr / 5632, q = rr % 5632;
            if (which < 2) { const int kb = q / 176, nb = q % 176;
                src = a.in[27 + which] + (size_t)e * 2048 * 5632 + (size_t)(kb * 64) * 5632 + nb * 32; ldw = 5632; scale = 64.f; dst = ws + WS_MGU + ((size_t)e * 11264 + map_gu(nb * 32, which)) * 2048 + kb * 64; ldt = 2048; }
            else { const int kb = q / 64, nb = q % 64;
                src = a.in[29] + (size_t)e * 5632 * 2048 + (size_t)(kb * 64) * 2048 + nb * 32; ldw = 2048; scale = 128.f; dst = ws + WS_MD + ((size_t)e * 2048 + nb * 32) * 5632 + kb * 64; ldt = 5632; } }
        else if ((r -= 3 * I_MOE) < 2 * I_F) { const int which = r / I_F, q = r % I_F, kb = q / 176, nb = q % 176;
            src = a.in[23 + which] + (size_t)(kb * 64) * 5632 + nb * 32; ldw = 5632; dst = ws + WS_FGU + ((size_t)map_gu(nb * 32, which) * 2048 + kb * 64) * 2; ldt = 2048; }
        else if ((r -= 2 * I_F) < I_F) { const int kb = r / 64, nb = r % 64;
            src = a.in[25] + (size_t)(kb * 64) * 2048 + nb * 32; ldw = 2048; scale = 128.f; dst = ws + WS_FD + (size_t)(nb * 32) * 5632 + kb * 64; ldt = 5632; }
        else if ((r -= I_F) < I_IN) { const int kb = r / 160, nb = r % 160;
            src = a.in[7] + (size_t)(kb * 64) * NSA_W + nb * 32; ldw = NSA_W; scale = 64.f; dst = ws + WS_WIN + (size_t)map_in(nb * 32) * 2048 + kb * 64; ldt = 2048; }
        else if ((r -= I_IN) < I_ING) { const int kb = r / 2, nb = r % 2;
            src = a.in[7] + (size_t)(kb * 64) * NSA_W + 5120 + nb * 32; ldw = NSA_W; nvalid = 48 - 32 * nb; scale = 64.f; dst = ws + WS_WG + (size_t)(nb * 32) * 2048 + kb * 64; ldt = 2048; }
        else if ((r -= I_ING) < I_OUT) { const int kb = r / 64, nb = r % 64;
            src = a.in[15] + (size_t)(kb * 64) * 2048 + nb * 32; ldw = 2048; scale = 64.f; dst = ws + WS_WOUT + (size_t)(nb * 32) * 2048 + kb * 64; ldt = 2048; }
        else if ((r -= I_OUT) < I_M4) { const int l = r / 512, q = r % 512, kb = q / 16, nb = q % 16;
            src = a.in[19] + (size_t)l * 2048 * 512 + (size_t)(kb * 64) * 512 + nb * 32; ldw = 512; scale = 64.f; dst = ws + WS_MWQ + ((size_t)l * 512 + nb * 32) * 2048 + kb * 64; ldt = 2048; }
        else if ((r -= I_M4) < 2 * I_M4) { const int which = r / I_M4, rr = r % I_M4, l = rr / 512, q = rr % 512, kb = q / 16, nb = q % 16;
            src = a.in[20 + which] + (size_t)l * 2048 * 512 + (size_t)(kb * 64) * 512 + nb * 32; ldw = 512; dst = ws + WS_MWKV + (((size_t)l * 1024 + which * 512 + nb * 32) * 2048 + kb * 64) * 2; ldt = 2048; }
        else if ((r -= 2 * I_M4) < I_M4) { const int l = r / 512, q = r % 512, kb = q / 64, nb = q % 64;
            src = a.in[22] + (size_t)l * 512 * 2048 + (size_t)(kb * 64) * 2048 + nb * 32; ldw = 2048; dst = ws + WS_MWO + (((size_t)l * 2048 + nb * 32) * 512 + kb * 64) * 2; ldt = 512; }
        else if ((r -= I_M4) < I_PW) { const int g = r / 128, q = r % 128, kb = q / 16, nb = q % 16;
            src = a.in[16] + (size_t)g * 512 * 512 + (size_t)(kb * 64) * 512 + nb * 32; ldw = 512; dst = ws + WS_PW + (((size_t)g * 512 + nb * 32) * 512 + kb * 64) * 2; ldt = 512; }
        else if ((r -= I_PW) < 2 * I_C1) { const int kv = r / I_C1, q = r % I_C1, kb = q / 8, nb = q % 8;
            src = a.in[kv ? 13 : 11] + (size_t)(kb * 64) * 256 + nb * 32; ldw = 256; scale = 64.f; dst = ws + WS_C1 + ((size_t)kv * 256 + nb * 32) * 4096 + kb * 64; ldt = 4096; }
        else { r -= 2 * I_C1; const int kv = r / I_C2, q = r % I_C2, kb = q / 4, nb = q % 4;
            src = a.in[kv ? 14 : 12] + (size_t)(kb * 64) * 128 + nb * 32; ldw = 128; dst = ws + WS_C2 + (((size_t)kv * 256 + map_c2(nb * 32)) * 256 + kb * 64) * 2; ldt = 256; }
        dd.src = src; dd.dst = dst; dd.ldw = ldw; dd.ldt = ldt; dd.nvalid = nvalid; dd.scale = scale;
}
constexpr int TRN_MOE = 90112 + 29056;
constexpr int TRN_TOTAL = TRN_MOE + 16896 + 2048 + 1024 + 1024 + 512, TRP0_TOTAL = 5184 + 2048 + 1056;
__device__ __forceinline__ int tr_map_nsa(int n) { n -= TRN_MOE; return n < 0 ? n + TRN_MOE : n < 16896 ? 135168 + n : n < 18944 ? 157248 + (n - 16896) : n < 19968 ? 159296 + (n - 18944) : n < 20992 ? 162368 + (n - 19968) : 163392 + (n - 20992); }
__device__ __forceinline__ int tr_map_p0(int v) { return v < 5184 ? 152064 + v : v < 7232 ? 160320 + (v - 5184) : 163904 + (v - 7232); }
template <bool NSAMAP>
__device__ __forceinline__ void tr_run(const Args& a, LAS float* scr, int n0, int n1, int w, int nw, int lane) {
    auto imap = [&](int n) { return NSAMAP ? tr_map_nsa(n) : tr_map_p0(n); };
    int it = n0 + w; if (it >= n1) return;
    TrDesc dA, dB; float vA[32], vB[32];
    tr_decode(a, imap(it), dA); tr_load(dA, vA, lane);
    for (;;) {
        const int i1 = it + nw;
        if (i1 < n1) { tr_decode(a, imap(i1), dB); tr_load(dB, vB, lane); }
        tr_store(dA, vA, scr, lane);
        if (i1 >= n1) break;
        const int i2 = i1 + nw;
        if (i2 < n1) { tr_decode(a, imap(i2), dA); tr_load(dA, vA, lane); }
        tr_store(dB, vB, scr, lane);
        if (i2 >= n1) break;
        it = i2;
    }
}
constexpr int TR_NDEF = 45056 - 29056, TR_D0 = 3 * 45056 - TR_NDEF, TR_D1 = TR_D0, TR_D2 = TR_D1 + 8000, TR_D3 = 3 * 45056;
constexpr int TR_PER_UNIT = 144;
static_assert(1024 * TR_PER_UNIT >= TRN_TOTAL, "deferred ranges");
__device__ __forceinline__ void tr_moe_range(const Args& a, LAS float* scr, int r0, int r1, int w, int nw, int lane) {
    auto decode = [&](int r, TrDesc& dd) { const int which = r / 45056, rr = r % 45056, e = rr / 5632, q = rr % 5632; dd.nvalid = 32;
        if (which < 2) { const int kb = q / 176, nb = q % 176;
            dd.src = a.in[27 + which] + (size_t)e * 2048 * 5632 + (size_t)(kb * 64) * 5632 + nb * 32; dd.ldw = 5632; dd.scale = 64.f; dd.dst = a.ws + WS_MGU + ((size_t)e * 11264 + map_gu(nb * 32, which)) * 2048 + kb * 64; dd.ldt = 2048; }
        else { const int kb = q / 64, nb = q % 64;
            dd.src = a.in[29] + (size_t)e * 5632 * 2048 + (size_t)(kb * 64) * 2048 + nb * 32; dd.ldw = 2048; dd.scale = 128.f; dd.dst = a.ws + WS_MD + ((size_t)e * 2048 + nb * 32) * 5632 + kb * 64; dd.ldt = 5632; } };
    int it = r0 + w; TrDesc dc; float vc[32];
    if (it < r1) { decode(it, dc); tr_load(dc, vc, lane); }
    while (it < r1) {
        const int itn = it + nw; TrDesc dn = dc; float vn[32];
        if (itn < r1) { decode(itn, dn); tr_load(dn, vn, lane); }
        else {
#pragma unroll
            for (int i = 0; i < 32; ++i) vn[i] = 0.f; }
        tr_store(dc, vc, scr, lane);
        dc = dn;
#pragma unroll
        for (int i = 0; i < 32; ++i) vc[i] = vn[i];
        it = itn;
    }
}
__device__ __forceinline__ void phase_prologue(const Args& a, LAS unsigned char* lds, int gw, int ngw, int wave, int lane) {
    unsigned char* ws = a.ws;
    LAS float* scr = (LAS float*)(lds + wave * 8448);
    constexpr int I_MOE = 45056, I_F = 5632, I_IN = 5120, I_ING = 64, I_OUT = 2048, I_M4 = 1024, I_PW = 512, I_C1 = 512, I_C2 = 16;
    constexpr int NITEMS = 3 * I_MOE + 3 * I_F + I_IN + I_ING + I_OUT + 4 * I_M4 + I_PW + 2 * I_C1 + 2 * I_C2;
    auto decode = [&](int it, TrDesc& dd) { tr_decode(a, it, dd); };
    tr_run<false>(a, scr, 0, TRP0_TOTAL, gw, ngw, lane);
    for (int m = gw; m < T; m += ngw) rms_row_f8(a.in[0] + (size_t)m * D, a.in[2], ws + WS_APA + (size_t)m * D, lane);
    for (int m = gw; m < 2 * MEML; m += ngw) { const int l = m >> 8, r = m & 255; rms_row_bf16(a.in[1] + (size_t)r * D, a.in[4] + l * D, (bf16_t*)(ws + WS_MEMN) + (size_t)m * D, lane); }
    { float* rope = (float*)(ws + WS_ROPE);
      for (int idx = gw * 64 + lane; idx < T * 64; idx += ngw * 64) { const int pos = idx >> 6, i = idx & 63;
          const float inv = (float)exp(-(double)i * (9.210340371976184 / 64.0)); const float ang = (float)pos * inv; double sn, cs; sincos((double)ang, &sn, &cs);
          *(f32x2*)(rope + (size_t)idx * 2) = (f32x2){(float)cs, (float)sn}; } }
    if (gw < 32) { const int kv = gw >> 4, kc = gw & 15; const float* pe = a.in[kv ? 10 : 9] + kc * 256; const float* w1 = a.in[kv ? 13 : 11] + (size_t)kc * 256 * 256; f32x4 s = (f32x4){0.f, 0.f, 0.f, 0.f};
#pragma unroll 8
        for (int k = 0; k < 256; ++k) s += pe[k] * *(const f32x4*)(w1 + (size_t)k * 256 + 4 * lane);
        *(f32x4*)((float*)(ws + WS_B1) + (kv * 16 + kc) * 256 + 4 * lane) = s; }
}

__device__ __forceinline__ void vtrans_item(const bf16_t* __restrict__ src, bf16_t* __restrict__ dst, LAS bf16_t* scr, int lane) {
    const int ch = lane & 15, tr = lane >> 4;
    u32x4 v[16];
#pragma unroll
    for (int it = 0; it < 16; ++it) v[it] = *(const u32x4*)(src + (size_t)(tr + 4 * it) * 512 + ch * 8);
#pragma unroll
    for (int it = 0; it < 16; ++it) { const int t = tr + 4 * it; const unsigned w[4] = {v[it].x, v[it].y, v[it].z, v[it].w};
#pragma unroll
        for (int j = 0; j < 4; ++j) { scr[(ch * 8 + 2 * j) * 72 + t] = (bf16_t)(w[j] & 0xffffu); scr[(ch * 8 + 2 * j + 1) * 72 + t] = (bf16_t)(w[j] >> 16); } }
    LDS_WAIT(); asm volatile("" ::: "memory");
    const int c8 = lane & 7, dr = lane >> 3;
#pragma unroll
    for (int rr = 0; rr < 16; ++rr) { const int d = rr * 8 + dr; const u32x4 o = *(const LAS u32x4*)(scr + d * 72 + c8 * 8); *(u32x4*)(dst + (size_t)d * T + c8 * 8) = o; }
    LDS_WAIT(); asm volatile("" ::: "memory");
}

constexpr int NSA_MK = 131072, NSA_WUN = 133120, NSA_BUN = 133632, NSA_JL = 133696, NSA_NJ = 133952;
__device__ __forceinline__ float red16_max(float m) { auto rr = __builtin_amdgcn_permlane16_swap(__float_as_uint(m), __float_as_uint(m), false, false); return fmaxf(__uint_as_float(rr[0]), __uint_as_float(rr[1])); }
__device__ __forceinline__ float red32_max(float m) { auto rr = __builtin_amdgcn_permlane32_swap(__float_as_uint(m), __float_as_uint(m), false, false); return fmaxf(__uint_as_float(rr[0]), __uint_as_float(rr[1])); }
__device__ __forceinline__ float red16_sum(float m) { auto rr = __builtin_amdgcn_permlane16_swap(__float_as_uint(m), __float_as_uint(m), false, false); return __uint_as_float(rr[0]) + __uint_as_float(rr[1]); }
__device__ __forceinline__ float red32_sum(float m) { auto rr = __builtin_amdgcn_permlane32_swap(__float_as_uint(m), __float_as_uint(m), false, false); return __uint_as_float(rr[0]) + __uint_as_float(rr[1]); }
#define DPP_I(x, ctrl) __builtin_amdgcn_mov_dpp((x), (ctrl), 0xF, 0xF, true)
__device__ __forceinline__ float wave_max_dpp(float v) {
    v = fmaxf(v, __builtin_bit_cast(float, DPP_I(__builtin_bit_cast(int, v), 0xB1)));
    v = fmaxf(v, __builtin_bit_cast(float, DPP_I(__builtin_bit_cast(int, v), 0x4E)));
    v = fmaxf(v, __builtin_bit_cast(float, DPP_I(__builtin_bit_cast(int, v), 0x141)));
    v = fmaxf(v, __builtin_bit_cast(float, DPP_I(__builtin_bit_cast(int, v), 0x140)));
    return red32_max(red16_max(v));
}
__device__ __forceinline__ unsigned umin_(unsigned a, unsigned b) { return a < b ? a : b; }
__device__ __forceinline__ unsigned wave_min_dpp(unsigned v) {
    v = umin_(v, (unsigned)DPP_I((int)v, 0xB1)); v = umin_(v, (unsigned)DPP_I((int)v, 0x4E)); v = umin_(v, (unsigned)DPP_I((int)v, 0x141)); v = umin_(v, (unsigned)DPP_I((int)v, 0x140));
    { auto rr = __builtin_amdgcn_permlane16_swap(v, v, false, false); v = umin_(rr[0], rr[1]); }
    { auto rr = __builtin_amdgcn_permlane32_swap(v, v, false, false); v = umin_(rr[0], rr[1]); }
    return v;
}
__device__ __forceinline__ float quad_sum(float v) {
    int x = __builtin_bit_cast(int, v);
    float a = v + __builtin_bit_cast(float, __builtin_amdgcn_mov_dpp(x, 0xB1, 0xF, 0xF, true));
    int y = __builtin_bit_cast(int, a);
    return a + __builtin_bit_cast(float, __builtin_amdgcn_mov_dpp(y, 0x4E, 0xF, 0xF, true));
}
struct StageLane { unsigned kp[2], vp[2]; };
__device__ __forceinline__ StageLane stage_lane(int wave, int lane) {
    StageLane L;
#pragma unroll
    for (int k = 0; k < 2; ++k) { const int rho = 4 * (2 * wave + k) + (lane >> 4), pos = lane & 15, i = rho & 15, c = pos ^ i, key = 32 * (rho >> 5) + 8 * (i >> 2) + (i & 3) + 4 * ((rho >> 4) & 1);
        L.kp[k] = (unsigned)key | ((unsigned)c << 8);
        const int r = 8 * (2 * wave + k) + (lane >> 3), pv = lane & 7, cv = pv ^ ((r >> 1) & 7); L.vp[k] = (unsigned)r | ((unsigned)cv << 8); }
    return L;
}
__device__ __forceinline__ void nsa_stage(LAS unsigned char* buf, const bf16_t* Kp, int kshift, const bf16_t* Vp, int vshift, bool doV, int wave, const StageLane& L) {
#pragma unroll
    for (int k = 0; k < 2; ++k) { const unsigned off = ((L.kp[k] & 255u) << kshift) + ((L.kp[k] >> 8) << 4);
        __builtin_amdgcn_global_load_lds((const unsigned*)((const char*)Kp + off), (LAS unsigned*)(buf + (2 * wave + k) * 1024), 16, 0, 0); }
    if (doV) {
#pragma unroll
        for (int k = 0; k < 2; ++k) { const unsigned off = ((L.vp[k] & 255u) << vshift) + ((L.vp[k] >> 8) << 4);
            __builtin_amdgcn_global_load_lds((const unsigned*)((const char*)Vp + off), (LAS unsigned*)(buf + 16384 + (2 * wave + k) * 1024), 16, 0, 0); } }
}
__device__ __forceinline__ bf16x8 lds_k(const LAS unsigned char* buf, int h, int tt, int ks, int i, int g) { return *(const LAS bf16x8*)(buf + (16 * (2 * h + tt) + i) * 256 + (((4 * ks + g) ^ i) << 4)); }
__device__ __forceinline__ bf16x8 lds_v(const LAS unsigned char* buf, int h, int dt, int i, int g) { return *(const LAS bf16x8*)(buf + 16384 + (16 * dt + i) * 128 + (((4 * h + g) ^ (i >> 1)) << 4)); }
__device__ __forceinline__ void nsa_scores(const CT (&ct)[2], const LAS unsigned char* buf, int h, const bool (&act)[2], int i, int g, f32x4 (&s)[2][2]) {
#pragma unroll
    for (int c = 0; c < 2; ++c) { s[c][0] = (f32x4){0.f, 0.f, 0.f, 0.f}; s[c][1] = (f32x4){0.f, 0.f, 0.f, 0.f}; }
#pragma unroll
    for (int ks = 0; ks < 4; ++ks) { const bf16x8 ka = lds_k(buf, h, 0, ks, i, g), kb = lds_k(buf, h, 1, ks, i, g);
#pragma unroll
        for (int c = 0; c < 2; ++c) if (act[c]) { s[c][0] = mfma16(ka, ct[c].q[ks], s[c][0]); s[c][1] = mfma16(kb, ct[c].q[ks], s[c][1]); } }
}
template <bool DO_PV>
__device__ __forceinline__ bf16x8 nsa_softmax(CT& c, const f32x4 (&s)[2], const bool (&valid)[8]) {
    float sv[8];
#pragma unroll
    for (int e = 0; e < 8; ++e) sv[e] = valid[e] ? s[e >> 2][e & 3] : NEGF;
    float mx = fmaxf(fmaxf(fmaxf(sv[0], sv[1]), fmaxf(sv[2], sv[3])), fmaxf(fmaxf(sv[4], sv[5]), fmaxf(sv[6], sv[7])));
    mx = red16_max(mx); mx = red32_max(mx);
    const float mnew = fmaxf(c.m, mx), alpha = __builtin_amdgcn_exp2f((c.m - mnew) * L2E);
    float p[8], ps = 0.f;
#pragma unroll
    for (int e = 0; e < 8; ++e) { p[e] = valid[e] ? __builtin_amdgcn_exp2f((sv[e] - mnew) * L2E) : 0.f; ps += p[e]; }
    c.l = c.l * alpha + ps; c.m = mnew;
    if (DO_PV) {
#pragma unroll
        for (int d = 0; d < 8; ++d) c.o[d] = c.o[d] * alpha;
    }
    u32x4 w; w.x = cvt_pk_bf16(p[0], p[1]); w.y = cvt_pk_bf16(p[2], p[3]); w.z = cvt_pk_bf16(p[4], p[5]); w.w = cvt_pk_bf16(p[6], p[7]);
    return __builtin_bit_cast(bf16x8, w);
}
__device__ __forceinline__ void nsa_pv(CT (&ct)[2], const LAS unsigned char* buf, int h, const bool (&act)[2], const bf16x8 (&pb)[2], int i, int g) {
#pragma unroll
    for (int d = 0; d < 8; ++d) { const bf16x8 vf = lds_v(buf, h, d, i, g);
#pragma unroll
        for (int c = 0; c < 2; ++c) if (act[c]) ct[c].o[d] = mfma16(vf, pb[c], ct[c].o[d]); }
}
__device__ __forceinline__ float ct_lsum2(const CT& c) { return red32_sum(red16_sum(c.l)); }

template <int MASK>
__device__ __forceinline__ void nsa_slc_tile(CT (&ct)[2], const LAS unsigned char* buf, const bool (&selq)[2], const int (&myq)[2], const int j, const int i16, const int g4) {
    const bool act[2] = {(MASK & 1) != 0, (MASK & 2) != 0};
#pragma unroll
    for (int h = 0; h < 2; ++h) { f32x4 s[2][2]; nsa_scores(ct, buf, h, act, i16, g4, s);
        bf16x8 pb[2];
#pragma unroll
        for (int c = 0; c < 2; ++c) if (act[c]) { bool valid[8];
#pragma unroll
            for (int e = 0; e < 8; ++e) valid[e] = selq[c] && (64 * j + 32 * h + 8 * g4 + e <= myq[c]);
            pb[c] = nsa_softmax<true>(ct[c], s[c], valid); }
        nsa_pv(ct, buf, h, act, pb, i16, g4); }
}
#define PIN8(x) asm volatile("" : "+v"((x)[0]), "+v"((x)[1]), "+v"((x)[2]), "+v"((x)[3]), "+v"((x)[4]), "+v"((x)[5]), "+v"((x)[6]), "+v"((x)[7]))
template <int C>
__device__ __forceinline__ void nsa_slc_fast(CT (&ct)[2], const LAS unsigned char* buf, const bool selq, const int i16, const int g4) {
    CT& c = ct[C];
    f32x4 s[2][2];
#pragma unroll
    for (int h = 0; h < 2; ++h) { s[h][0] = (f32x4){0.f, 0.f, 0.f, 0.f}; s[h][1] = (f32x4){0.f, 0.f, 0.f, 0.f};
        bf16x8 kf[8];
#pragma unroll
        for (int ks = 0; ks < 4; ++ks) { kf[2 * ks] = lds_k(buf, h, 0, ks, i16, g4); kf[2 * ks + 1] = lds_k(buf, h, 1, ks, i16, g4); }
        PIN8(kf);
#pragma unroll
        for (int ks = 0; ks < 4; ++ks) { s[h][0] = mfma16(kf[2 * ks], c.q[ks], s[h][0]); s[h][1] = mfma16(kf[2 * ks + 1], c.q[ks], s[h][1]); } }
    bf16x8 vf[8];
#pragma unroll
    for (int d = 0; d < 8; ++d) vf[d] = lds_v(buf, 0, d, i16, g4);
    float mx = fmaxf(fmaxf(fmaxf(s[0][0].x, s[0][0].y), fmaxf(s[0][0].z, s[0][0].w)), fmaxf(fmaxf(s[0][1].x, s[0][1].y), fmaxf(s[0][1].z, s[0][1].w)));
    mx = fmaxf(mx, fmaxf(fmaxf(fmaxf(s[1][0].x, s[1][0].y), fmaxf(s[1][0].z, s[1][0].w)), fmaxf(fmaxf(s[1][1].x, s[1][1].y), fmaxf(s[1][1].z, s[1][1].w))));
    mx = selq ? mx : NEGF;
    mx = red16_max(mx); mx = red32_max(mx);
    const float mnew = fmaxf(c.m, mx), nb = -mnew * L2E;
    if (__builtin_amdgcn_ballot_w64(mnew != c.m) != 0ull) {
        const float alpha = __builtin_amdgcn_exp2f((c.m - mnew) * L2E); c.l *= alpha; c.m = mnew;
#pragma unroll
        for (int d = 0; d < 8; ++d) c.o[d] = c.o[d] * alpha;
    }
    const unsigned keep = selq ? 0xffffffffu : 0u; float ps = 0.f;
    bf16x8 pb[2];
#pragma unroll
    for (int h = 0; h < 2; ++h) { float p[8];
#pragma unroll
        for (int e = 0; e < 8; ++e) { p[e] = __builtin_amdgcn_exp2f(__builtin_fmaf(s[h][e >> 2][e & 3], L2E, nb)); ps += p[e]; }
        u32x4 w; w.x = cvt_pk_bf16(p[0], p[1]) & keep; w.y = cvt_pk_bf16(p[2], p[3]) & keep; w.z = cvt_pk_bf16(p[4], p[5]) & keep; w.w = cvt_pk_bf16(p[6], p[7]) & keep;
        pb[h] = __builtin_bit_cast(bf16x8, w); }
    c.l += selq ? ps : 0.f;
    PIN8(vf);
#pragma unroll
    for (int d = 0; d < 8; ++d) c.o[d] = mfma16(vf[d], pb[0], c.o[d]);
#pragma unroll
    for (int d = 0; d < 8; ++d) vf[d] = lds_v(buf, 1, d, i16, g4);
    PIN8(vf);
#pragma unroll
    for (int d = 0; d < 8; ++d) c.o[d] = mfma16(vf[d], pb[1], c.o[d]);
}
#define NSA_WAITV(n) asm volatile("s_waitcnt vmcnt(" #n ")" ::: "memory")
#define NSA_BAR() do { asm volatile("" ::: "memory"); __builtin_amdgcn_s_barrier(); asm volatile("" ::: "memory"); } while (0)
__device__ __forceinline__ void nsa_unit(const unsigned char* ws, const int Tq, const int grp, LAS unsigned char* lds, const int wave, const int lane_in) {
    int lane = lane_in; asm volatile("" : "+v"(lane));
    const unsigned char* r1 = ws + WS_R1;
    const bf16_t* qb = (const bf16_t*)(r1 + R_Q);
#define kc ((const bf16_t*)(r1 + R_KC) + (size_t)grp * 1024 * 128)
#define vct ((const bf16_t*)(r1 + R_VCT) + (size_t)grp * 128 * 1024)
#define ks ((const bf16_t*)(r1 + R_KS) + grp * 128)
#define vst ((const bf16_t*)(r1 + R_VST) + (size_t)grp * 128 * T)
#define kw ((const bf16_t*)(r1 + R_KW) + grp * 128)
#define vwt ((const bf16_t*)(r1 + R_VWT) + (size_t)grp * 128 * T)
    const float* gates = (const float*)(ws + WS_GATES); unsigned char* ob = (unsigned char*)(ws + WS_R1 + R_BLKK); float* part = (float*)(ws + WS_R1 + R_O);
    float* imp_own = (float*)(ws + WS_IMP) + (size_t)blockIdx.x * 32768 + wave * 8 * 256;
    LAS unsigned* mk = (LAS unsigned*)(lds + NSA_MK);
    LAS unsigned* wun = (LAS unsigned*)(lds + NSA_WUN);
    LAS unsigned* bun = (LAS unsigned*)(lds + NSA_BUN);
    LAS unsigned char* jl = (LAS unsigned char*)(lds + NSA_JL);
    LAS int* njp = (LAS int*)(lds + NSA_NJ);
    const int i16 = lane & 15, g4 = lane >> 4, qi = i16 >> 2, hd = grp * 4 + (i16 & 3);
    const int q0 = Tq * 64 + wave * 8;
    const StageLane SL = stage_lane(wave, lane);
    int myq[2]; CT ct[2];
#pragma unroll
    for (int c = 0; c < 2; ++c) { myq[c] = q0 + 4 * c + qi;
#pragma unroll
        for (int ksx = 0; ksx < 4; ++ksx) ct[c].q[ksx] = *(const bf16x8*)(qb + (size_t)myq[c] * 2048 + hd * 128 + 32 * ksx + 8 * g4); }
    const bool act2[2] = {true, true};
    VM_WAIT(); NSA_BAR();
    if (threadIdx.x < 8) bun[threadIdx.x] = 0u;
    const int nst = (4 * Tq + 3 + 63) >> 6;
    {
    ct_init(ct[0]); ct_init(ct[1]);
#pragma unroll
    for (int p = 0; p < 3; ++p) if (p < nst) nsa_stage(lds + p * 32768, kc + (size_t)(64 * p) * 128, 8, vct, 11, false, wave, SL);
    const int nfull = nst > 2 ? nst - 2 : 0;
    auto p1step = [&](const int st, auto MK) { constexpr bool MASKED = decltype(MK)::value;
        if (st + 2 < nst) NSA_WAITV(4); else if (st + 1 < nst) NSA_WAITV(2); else NSA_WAITV(0);
        NSA_BAR();
        if (st + 3 < nst) nsa_stage(lds + ((st + 3) & 3) * 32768, kc + (size_t)(64 * (st + 3)) * 128, 8, vct, 11, false, wave, SL);
        const LAS unsigned char* buf = lds + (st & 3) * 32768;
#pragma unroll
        for (int h = 0; h < 2; ++h) { f32x4 s[2][2]; nsa_scores(ct, buf, h, act2, i16, g4, s);
#pragma unroll
            for (int c = 0; c < 2; ++c) { bool valid[8];
#pragma unroll
                for (int e = 0; e < 8; ++e) { const int cidx = 64 * st + 32 * h + 8 * g4 + e; valid[e] = MASKED ? (16 * cidx + 31 <= myq[c]) : true; }
                (void)nsa_softmax<false>(ct[c], s[c], valid); } } };
    for (int st = 0; st < nfull; ++st) p1step(st, std::false_type{});
    for (int st = nfull; st < nst; ++st) p1step(st, std::true_type{});
    float mfin[2], linv[2];
#pragma unroll
    for (int c = 0; c < 2; ++c) { const float l = ct_lsum2(ct[c]); mfin[c] = ct[c].m; linv[c] = l > 0.f ? 1.0f / l : 0.f; }
    VM_WAIT(); NSA_BAR();
#pragma unroll
    for (int p = 0; p < 3; ++p) if (p < nst) nsa_stage(lds + p * 32768, kc + (size_t)(64 * p) * 128, 8, vct + 64 * p, 11, true, wave, SL);
    auto p2step = [&](const int st, auto MK) { constexpr bool MASKED = decltype(MK)::value;
        if (st + 2 < nst) NSA_WAITV(8); else if (st + 1 < nst) NSA_WAITV(4); else NSA_WAITV(0);
        NSA_BAR();
        if (st + 3 < nst) nsa_stage(lds + ((st + 3) & 3) * 32768, kc + (size_t)(64 * (st + 3)) * 128, 8, vct + 64 * (st + 3), 11, true, wave, SL);
        const LAS unsigned char* buf = lds + (st & 3) * 32768;
#pragma unroll
        for (int h = 0; h < 2; ++h) { f32x4 s[2][2]; nsa_scores(ct, buf, h, act2, i16, g4, s);
            bf16x8 pb[2];
#pragma unroll
            for (int c = 0; c < 2; ++c) { float p[8];
#pragma unroll
                for (int e = 0; e < 8; ++e) { const int cidx = 64 * st + 32 * h + 8 * g4 + e; const bool valid = MASKED ? (16 * cidx + 31 <= myq[c]) : true;
                    p[e] = valid ? __builtin_amdgcn_exp2f((s[c][e >> 2][e & 3] - mfin[c]) * L2E) * linv[c] : 0.f; }
                u32x4 w; w.x = cvt_pk_bf16(p[0], p[1]); w.y = cvt_pk_bf16(p[2], p[3]); w.z = cvt_pk_bf16(p[4], p[5]); w.w = cvt_pk_bf16(p[6], p[7]);
                pb[c] = __builtin_bit_cast(bf16x8, w);
#pragma unroll
                for (int e = 0; e < 8; ++e) p[e] = quad_sum(p[e]);
                if ((lane & 3) == 0) { float* row = imp_own + (4 * c + qi) * 256;
#pragma unroll
                    for (int tt = 0; tt < 2; ++tt) { const int j = 16 * st + 8 * h + 2 * g4 + tt;
                        row[j] = 2.f * (p[4 * tt] + p[4 * tt + 1] + p[4 * tt + 2]) + p[4 * tt + 3];
                        if (j + 1 < 256) row[16384 + j + 1] = p[4 * tt + 3]; } }
            }
            nsa_pv(ct, buf, h, act2, pb, i16, g4);
        } };
    for (int st = 0; st < nfull; ++st) p2step(st, std::false_type{});
    for (int st = nfull; st < nst; ++st) p2step(st, std::true_type{});
    }
#pragma unroll
    for (int c = 0; c < 2; ++c) { int ln = lane; asm volatile("" : "+v"(ln)); const int hd_ = grp * 4 + (ln & 3), mq_ = q0 + 4 * c + ((ln & 15) >> 2), g4_ = ln >> 4;
        const float gt = gates[(size_t)mq_ * 48 + 0 * 16 + hd_]; float* pp = part + (size_t)mq_ * 2048 + hd_ * 128 + 4 * g4_;
#pragma unroll
        for (int d = 0; d < 8; ++d) *(f32x4*)(pp + 16 * d) = ct[c].o[d] * gt; }
    VM_WAIT();
    const int curT = q0 >> 6;
    float vall[8][4];
#pragma unroll
    for (int qq = 0; qq < 8; ++qq)
#pragma unroll
        for (int k = 0; k < 4; ++k) { const int j = lane + 64 * k; const bool cand = (curT + 1 > 16) & (j >= 1) & (j <= curT - 2); const int jj = cand ? j : 1;
            const float v = __hip_atomic_load(imp_own + qq * 256 + jj, __ATOMIC_RELAXED, __HIP_MEMORY_SCOPE_AGENT) + __hip_atomic_load(imp_own + 16384 + qq * 256 + jj, __ATOMIC_RELAXED, __HIP_MEMORY_SCOPE_AGENT);
            vall[qq][k] = cand ? v : -1.f; }
#pragma unroll
    for (int qq = 0; qq < 8; ++qq) {
        const int cur = curT; bool sel[4]; float val[4];
#pragma unroll
        for (int k = 0; k < 4; ++k) { const int j = lane + 64 * k;
            if (cur + 1 <= 16) { sel[k] = (j <= cur); val[k] = -1.f; }
            else { sel[k] = (j == 0) | (j == cur) | (j == cur - 1); val[k] = vall[qq][k]; } }
        if (cur + 1 > 16) {
            int key[4];
#pragma unroll
            for (int k = 0; k < 4; ++k) key[k] = __float_as_int(val[k]);
            auto count_ge = [&](const int cand) { int cnt = 0;
#pragma unroll
                for (int k = 0; k < 4; ++k) cnt += __builtin_popcountll(__ballot(key[k] >= cand));
                return cnt; };
            int thr = count_ge(1 << 30) >= 13 ? (1 << 30) : 0;
            for (int b = 28; b >= 0; b -= 2) {
                const int c1 = thr | (1 << b), c2 = thr | (2 << b), c3 = thr | (3 << b);
                const int n1 = count_ge(c1), n2 = count_ge(c2), n3 = count_ge(c3);
                thr = n3 >= 13 ? c3 : (n2 >= 13 ? c2 : (n1 >= 13 ? c1 : thr)); }
            int above = 0;
#pragma unroll
            for (int k = 0; k < 4; ++k) above += __builtin_popcountll(__ballot(key[k] > thr));
            int rem = 13 - above;
#pragma unroll
            for (int k = 0; k < 4; ++k) { const bool eq = (key[k] == thr); const unsigned long long E = __ballot(eq);
                const int rank = (int)__builtin_amdgcn_mbcnt_hi((unsigned)(E >> 32), __builtin_amdgcn_mbcnt_lo((unsigned)E, 0u));
                sel[k] = sel[k] | (key[k] > thr) | (eq & (rank < rem)); rem -= __builtin_popcountll(E); }
        }
#pragma unroll
        for (int k = 0; k < 4; ++k) { const unsigned long long bb = __ballot(sel[k]); if (lane == 0) { mk[(wave * 8 + qq) * 8 + 2 * k] = (unsigned)bb; mk[(wave * 8 + qq) * 8 + 2 * k + 1] = (unsigned)(bb >> 32); } }
    }
    LDS_WAIT(); asm volatile("" ::: "memory");
    if (lane < 16) { const int c = lane >> 3, w8 = lane & 7; const LAS unsigned* m0 = mk + (wave * 8 + 4 * c) * 8 + w8; const unsigned u = m0[0] | m0[8] | m0[16] | m0[24];
        wun[(wave * 2 + c) * 8 + w8] = u; (void)__hip_atomic_fetch_or(bun + w8, u, __ATOMIC_RELAXED, __HIP_MEMORY_SCOPE_WORKGROUP); }
    LDS_WAIT(); NSA_BAR();
    if (threadIdx.x < 256) { const int j = threadIdx.x; unsigned below = 0;
#pragma unroll
        for (int w8 = 0; w8 < 8; ++w8) { const unsigned u = bun[w8]; below += (w8 < (j >> 5)) ? __builtin_popcount(u) : 0; if (j == 255 && w8 == 7) {} }
        const unsigned uw = bun[j >> 5]; if ((uw >> (j & 31)) & 1u) jl[below + __builtin_popcount(uw & ((1u << (j & 31)) - 1u))] = (unsigned char)j;
        if (j == 0) { int n = 0;
#pragma unroll
            for (int w8 = 0; w8 < 8; ++w8) n += __builtin_popcount(bun[w8]); njp[0] = n; } }
    LDS_WAIT(); NSA_BAR();
    {
    ct_init(ct[0]); ct_init(ct[1]);
    {
        const int nj = __builtin_amdgcn_readfirstlane(njp[0]);
        const int nm = nj - 1, np = (nm + 1) >> 1;
        if (nm > 0) { const int j0 = __builtin_amdgcn_readfirstlane((int)jl[0]); nsa_stage(lds, ks + (size_t)(64 * j0) * 512, 10, vst + 64 * j0, 15, true, wave, SL);
          if (1 < nm) { const int j1 = __builtin_amdgcn_readfirstlane((int)jl[1]); nsa_stage(lds + 32768, ks + (size_t)(64 * j1) * 512, 10, vst + 64 * j1, 15, true, wave, SL); } }
        else nsa_stage(lds, ks + (size_t)(64 * Tq) * 512, 10, vst + 64 * Tq, 15, true, wave, SL);
        for (int p = 0; p < np; ++p) {
            NSA_WAITV(0); NSA_BAR();
            { LAS unsigned char* nb = lds + ((p + 1) & 1) * 65536;
              if (p + 1 < np) {
                const int j0 = __builtin_amdgcn_readfirstlane((int)jl[2 * p + 2]); nsa_stage(nb, ks + (size_t)(64 * j0) * 512, 10, vst + 64 * j0, 15, true, wave, SL);
                if (2 * p + 3 < nm) { const int j1 = __builtin_amdgcn_readfirstlane((int)jl[2 * p + 3]); nsa_stage(nb + 32768, ks + (size_t)(64 * j1) * 512, 10, vst + 64 * j1, 15, true, wave, SL); } }
              else nsa_stage(nb, ks + (size_t)(64 * Tq) * 512, 10, vst + 64 * Tq, 15, true, wave, SL); }
#pragma unroll
            for (int bq = 0; bq < 2; ++bq) {
                if (2 * p + bq < nm) {
                    const int j = __builtin_amdgcn_readfirstlane((int)jl[2 * p + bq]);
                    const LAS unsigned char* buf = lds + (p & 1) * 65536 + bq * 32768;
                    bool act[2], selq[2];
#pragma unroll
                    for (int c = 0; c < 2; ++c) { act[c] = (__builtin_amdgcn_readfirstlane(wun[(wave * 2 + c) * 8 + (j >> 5)]) >> (j & 31)) & 1u; selq[c] = (mk[(wave * 8 + 4 * c + qi) * 8 + (j >> 5)] >> (j & 31)) & 1u; }
                    if (act[0]) nsa_slc_fast<0>(ct, buf, selq[0], i16, g4);
                    if (act[1]) nsa_slc_fast<1>(ct, buf, selq[1], i16, g4);
                }
            }
        }
        NSA_WAITV(0); NSA_BAR();
        { const int j = Tq; const LAS unsigned char* buf = lds + (np & 1) * 65536;
          bool act[2], selq[2];
#pragma unroll
          for (int c = 0; c < 2; ++c) { act[c] = (__builtin_amdgcn_readfirstlane(wun[(wave * 2 + c) * 8 + (j >> 5)]) >> (j & 31)) & 1u; selq[c] = (mk[(wave * 8 + 4 * c + qi) * 8 + (j >> 5)] >> (j & 31)) & 1u; }
          if (act[0]) nsa_slc_tile<1>(ct, buf, selq, myq, j, i16, g4);
          if (act[1]) nsa_slc_tile<2>(ct, buf, selq, myq, j, i16, g4); }
    }
    }
#pragma unroll
    for (int c = 0; c < 2; ++c) { int ln = lane; asm volatile("" : "+v"(ln)); const int hd_ = grp * 4 + (ln & 3), mq_ = q0 + 4 * c + ((ln & 15) >> 2), g4_ = ln >> 4;
        const float l = ct_lsum2(ct[c]); const float gt = gates[(size_t)mq_ * 48 + 1 * 16 + hd_] * (l > 0.f ? 1.0f / l : 0.f); float* pp = part + (size_t)mq_ * 2048 + hd_ * 128 + 4 * g4_;
#pragma unroll
        for (int d = 0; d < 8; ++d) *(f32x4*)(pp + 16 * d) = *(const f32x4*)(pp + 16 * d) + ct[c].o[d] * gt; }
    {
    ct_init(ct[0]); ct_init(ct[1]);
    VM_WAIT(); NSA_BAR();
    { const int kb0 = (Tq >= 8 ? Tq - 8 : 0), nw = Tq - kb0 + 1;
#pragma unroll
      for (int p = 0; p < 3; ++p) if (p < nw) { const int tp = kb0 + p; nsa_stage(lds + p * 32768, kw + (size_t)(64 * tp) * 512, 10, vwt + 64 * tp, 15, true, wave, SL); }
      auto wstep = [&](const int st, auto MK) { constexpr bool MASKED = decltype(MK)::value;
          if (st + 2 < nw) NSA_WAITV(8); else if (st + 1 < nw) NSA_WAITV(4); else NSA_WAITV(0);
          NSA_BAR();
          if (st + 3 < nw) { const int tp = kb0 + st + 3; nsa_stage(lds + ((st + 3) & 3) * 32768, kw + (size_t)(64 * tp) * 512, 10, vwt + 64 * tp, 15, true, wave, SL); }
          const LAS unsigned char* buf = lds + (st & 3) * 32768;
#pragma unroll
          for (int h = 0; h < 2; ++h) { f32x4 s[2][2]; nsa_scores(ct, buf, h, act2, i16, g4, s);
              bf16x8 pb[2];
#pragma unroll
              for (int c = 0; c < 2; ++c) { bool valid[8];
#pragma unroll
                  for (int e = 0; e < 8; ++e) { const int key = 64 * (kb0 + st) + 32 * h + 8 * g4 + e; valid[e] = MASKED ? ((key <= myq[c]) & (key > myq[c] - 512)) : true; }
                  pb[c] = nsa_softmax<true>(ct[c], s[c], valid); }
              nsa_pv(ct, buf, h, act2, pb, i16, g4); } };
      wstep(0, std::true_type{});
      for (int st = 1; st + 1 < nw; ++st) wstep(st, std::false_type{});
      if (nw > 1) wstep(nw - 1, std::true_type{});
    }
    }
#pragma unroll
    for (int c = 0; c < 2; ++c) { int ln = lane; asm volatile("" : "+v"(ln)); const int hd_ = grp * 4 + (ln & 3), mq_ = q0 + 4 * c + ((ln & 15) >> 2), g4_ = ln >> 4;
        const float l = ct_lsum2(ct[c]); const float gt = gates[(size_t)mq_ * 48 + 2 * 16 + hd_] * (l > 0.f ? 1.0f / l : 0.f); const float* pp = part + (size_t)mq_ * 2048 + hd_ * 128 + 4 * g4_;
        unsigned char* po = ob + (size_t)mq_ * 2048 + hd_ * 128 + 4 * g4_;
#pragma unroll
        for (int d = 0; d < 8; ++d) {
            const f32x4 o = (*(const f32x4*)(pp + 16 * d) + ct[c].o[d] * gt) * 64.f;
            *(unsigned*)(po + 16 * d) = pk4_fp8(o.x, o.y, o.z, o.w); } }
}

#undef kc
#undef vct
#undef ks
#undef vst
#undef kw
#undef vwt
__device__ __forceinline__ void memattn_wave(const unsigned char* ws, int layer, int wu, int lane) {
    const int hd = wu & 3, qb0 = (wu >> 2) * 32; const int col = lane & 15, g4 = lane >> 4;
    const bf16_t* qm = (const bf16_t*)(ws + WS_QM); bf16_t* om = (bf16_t*)(ws + WS_OM);
    const bf16_t* km = (const bf16_t*)(ws + WS_KM) + (size_t)layer * 256 * 512 + hd * 128; const bf16_t* vmt = (const bf16_t*)(ws + WS_VMT) + (size_t)layer * 512 * 256 + (size_t)hd * 128 * 256;
    CT ct[2];
#pragma unroll
    for (int c = 0; c < 2; ++c) { ct_init(ct[c]);
#pragma unroll
        for (int ksx = 0; ksx < 4; ++ksx) ct[c].q[ksx] = *(const bf16x8*)(qm + (size_t)(qb0 + 16 * c + col) * 512 + hd * 128 + 32 * ksx + 8 * g4); }
    const bf16_t* k0 = km + (size_t)(8 * (col >> 2) + (col & 3)) * 512 + 8 * g4;
    const bf16_t* v0 = vmt + (size_t)col * 256 + 8 * g4;
    bf16x8 kf[8];
#pragma unroll
    for (int ks = 0; ks < 4; ++ks) { kf[2 * ks] = *(const bf16x8*)(k0 + 32 * ks); kf[2 * ks + 1] = *(const bf16x8*)(k0 + 4 * 512 + 32 * ks); }
#pragma unroll 1
    for (int st = 0; st < 8; ++st) {
        bf16x8 vf[8];
#pragma unroll
        for (int d = 0; d < 8; ++d) vf[d] = *(const bf16x8*)(v0 + (size_t)(16 * d) * 256 + 32 * st);
        PIN8(kf);
        f32x4 s[2][2];
#pragma unroll
        for (int c = 0; c < 2; ++c) { s[c][0] = (f32x4){0.f, 0.f, 0.f, 0.f}; s[c][1] = (f32x4){0.f, 0.f, 0.f, 0.f}; }
#pragma unroll
        for (int ks = 0; ks < 4; ++ks) {
#pragma unroll
            for (int c = 0; c < 2; ++c) { s[c][0] = mfma16(kf[2 * ks], ct[c].q[ks], s[c][0]); s[c][1] = mfma16(kf[2 * ks + 1], ct[c].q[ks], s[c][1]); } }
        if (st < 7) {
#pragma unroll
            for (int ks = 0; ks < 4; ++ks) { kf[2 * ks] = *(const bf16x8*)(k0 + (size_t)(32 * (st + 1)) * 512 + 32 * ks); kf[2 * ks + 1] = *(const bf16x8*)(k0 + (size_t)(32 * (st + 1) + 4) * 512 + 32 * ks); } }
        bf16x8 pb[2]; const bool valid[8] = {true, true, true, true, true, true, true, true};
#pragma unroll
        for (int c = 0; c < 2; ++c) pb[c] = nsa_softmax<true>(ct[c], s[c], valid);
        PIN8(vf);
#pragma unroll
        for (int d = 0; d < 8; ++d) {
#pragma unroll
            for (int c = 0; c < 2; ++c) ct[c].o[d] = mfma16(vf[d], pb[c], ct[c].o[d]); }
    }
#pragma unroll
    for (int c = 0; c < 2; ++c) { const float li = 1.0f / ct_lsum2(ct[c]);
#pragma unroll
        for (int d = 0; d < 8; ++d) { const f32x4 o = ct[c].o[d] * li; u32x2 w; w.x = cvt_pk_bf16(o.x, o.y); w.y = cvt_pk_bf16(o.z, o.w);
            *(u32x2*)(om + (size_t)(qb0 + 16 * c + col) * 512 + hd * 128 + 16 * d + 4 * g4) = w; } }
}

__device__ __forceinline__ void memattn_block(const unsigned char* ws, int layer, LAS unsigned char* lds, int blk, int G, int wave, int lane_in) {
    int lane = lane_in; asm volatile("" : "+v"(lane));
    const int hd = blk & 3, slot = blk >> 2, nb = G >> 2; const int col = lane & 15, g4 = lane >> 4;
    const bf16_t* qm = (const bf16_t*)(ws + WS_QM); bf16_t* om = (bf16_t*)(ws + WS_OM);
    const bf16_t* km = (const bf16_t*)(ws + WS_KM) + (size_t)layer * 256 * 512 + hd * 128; const bf16_t* vmt = (const bf16_t*)(ws + WS_VMT) + (size_t)layer * 512 * 256 + (size_t)hd * 128 * 256;
    const StageLane SL = stage_lane(wave, lane);
#pragma unroll
    for (int t = 0; t < 4; ++t) nsa_stage(lds + t * 32768, km + (size_t)(64 * t) * 512, 10, vmt + 64 * t, 9, true, wave, SL);
    const bool act2[2] = {true, true}; const bool valid[8] = {true, true, true, true, true, true, true, true};
    bool first = true;
    for (int tq = slot * NWAVES + wave; tq < T / 32; tq += nb * NWAVES) {
        const int qb0 = tq * 32;
        CT ct[2];
#pragma unroll
        for (int c = 0; c < 2; ++c) { ct_init(ct[c]);
#pragma unroll
            for (int ksx = 0; ksx < 4; ++ksx) ct[c].q[ksx] = *(const bf16x8*)(qm + (size_t)(qb0 + 16 * c + col) * 512 + hd * 128 + 32 * ksx + 8 * g4); }
        if (first) { VM_WAIT(); NSA_BAR(); first = false; }
#pragma unroll 1
        for (int t = 0; t < 4; ++t) { const LAS unsigned char* buf = lds + t * 32768;
#pragma unroll
            for (int h = 0; h < 2; ++h) { f32x4 s[2][2]; nsa_scores(ct, buf, h, act2, col, g4, s);
                bf16x8 pb[2];
#pragma unroll
                for (int c = 0; c < 2; ++c) pb[c] = nsa_softmax<true>(ct[c], s[c], valid);
                nsa_pv(ct, buf, h, act2, pb, col, g4); } }
#pragma unroll
        for (int c = 0; c < 2; ++c) { const float li = 1.0f / ct_lsum2(ct[c]);
#pragma unroll
            for (int d = 0; d < 8; ++d) { const f32x4 o = ct[c].o[d] * li; u32x2 w; w.x = cvt_pk_bf16(o.x, o.y); w.y = cvt_pk_bf16(o.z, o.w);
                *(u32x2*)(om + (size_t)(qb0 + 16 * c + col) * 512 + hd * 128 + 16 * d + 4 * g4) = w; } }
    }
    if (first) { VM_WAIT(); NSA_BAR(); }
}

__device__ __forceinline__ void pool_body(const int W, const float* __restrict__ h, const float* __restrict__ gain, bf16_t* __restrict__ dbuf, const LAS float* rs, int t0, int tid) {
    const int c0 = 4 * tid; const f32x4 g = *(const f32x4*)(gain + c0);
    f32x4 sum = (f32x4){0.f, 0.f, 0.f, 0.f};
    for (int i = 1; i < W; ++i) { const int t = t0 - i; if (t >= 0) sum += (*(const f32x4*)(h + (size_t)t * D + c0) * rs[15 - i]) * g; }
    for (int tc = 0; tc < 64; tc += 8) {
        f32x4 un[8], uo[8];
#pragma unroll
        for (int k = 0; k < 8; ++k) { const int t = t0 + tc + k, told = t - W + 1;
            un[k] = *(const f32x4*)(h + (size_t)t * D + c0); uo[k] = *(const f32x4*)(h + (size_t)(told >= 0 ? told : 0) * D + c0); }
#pragma unroll
        for (int k = 0; k < 8; ++k) { const int tt = tc + k, t = t0 + tt, told = t - W + 1; const f32x4 u = (un[k] * rs[15 + tt]) * g; sum += u;
            const float inv = 1.0f / (float)((t + 1 < W) ? (t + 1) : W); const f32x4 d = sum * inv - u;
            u32x2 w; w.x = cvt_pk_bf16(d.x, d.y); w.y = cvt_pk_bf16(d.z, d.w); *(u32x2*)(dbuf + (size_t)t * D + c0) = w;
            if (told >= 0) sum -= (uo[k] * rs[15 + tt - W + 1]) * g; }
    }
}

#define IN(k) (lo <= (k) && (k) < hi)
#define PH(k) ((((PHASE_MASK) >> (k)) & 1u) && IN(k))
#define SEAM(k) do { if ((((PHASE_MASK) >> ((k) + 1)) & 1u) && IN((k) + 1)) xcd_barrier(bar); } while (0)
template <int layer>
__device__ __forceinline__ void mem_layer(const Args& a, LAS unsigned char* lds, const XcdBarrier& bar, int lo, int hi, int G, int blk, int gw, int ngw, int lane) {
    using namespace gm;
    unsigned char* ws = a.ws;
    bf16_t* APA = (bf16_t*)(ws + WS_APA); bf16_t* APB = (bf16_t*)(ws + WS_APB); float* H = (float*)(ws + WS_H); float* SSQ = (float*)(ws + WS_SSQ);
        const int pq = layer ? 13 : 6;
        bf16_t* apin = layer ? APA : APB;
        if (PH(pq)) {
            Sched S; S.o.init(T / 256, 2, G, blk); S.A = (const char*)apin; S.B = (const char*)(ws + WS_MWQ) + (size_t)layer * 512 * D; S.a_tile = 256ull * D; S.b_tile = 256ull * D; S.pn_shift = 30; S.a_pn_bytes = 0; S.tile_e = nullptr; S.b_exp = 0;
            EpiMemQ E{(bf16_t*)(ws + WS_QM), SSQ};
            gemm_phase<EpiMemQ, Sched, false, true, 121, 125>(lds, D / 128, D, D, S, E, nullptr);
            {
                const int wave = __builtin_amdgcn_readfirstlane((int)threadIdx.x >> 6); const int r0 = layer ? TR_D2 : TR_D1, r1 = layer ? TR_D3 : TR_D2;
                if (G > 128) { if (blk >= 128) tr_moe_range(a, (LAS float*)(lds + wave * 8448), r0, r1, (blk - 128) * NWAVES + wave, (G - 128) * NWAVES, lane); }
                else { __syncthreads(); tr_moe_range(a, (LAS float*)(lds + wave * 8448), r0, r1, gw, ngw, lane); } }
#if (REPEAT_MASK & 64u)
            xcd_barrier(bar); gemm_phase<EpiMemQ, Sched, false>(lds, D / 64, D, D, S, E, nullptr);
#endif
            SEAM(pq);
        }
        if (PH(pq + 1)) {
            if ((G & 3) == 0) memattn_block(ws, layer, lds, blk, G, __builtin_amdgcn_readfirstlane((int)threadIdx.x >> 6), lane);
            else for (int wu = gw; wu < 2048; wu += ngw) memattn_wave(ws, layer, wu, lane);
            SEAM(pq + 1);
        }
        if (PH(pq + 2)) {
            Sched S; S.o.init(T / 256, 8, G, blk); S.A = (const char*)(ws + WS_OM); S.B = (const char*)(ws + WS_MWO) + (size_t)layer * D * 512 * 2; S.a_tile = 256ull * 512 * 2; S.b_tile = 256ull * 512 * 2; S.pn_shift = 30; S.a_pn_bytes = 0; S.tile_e = nullptr; S.b_exp = 0;
            if (layer == 0) { EpiRes<true, true, false> E{H, H, APA, a.in[5], SSQ, nullptr, nullptr}; gemm_phase<EpiRes<true, true, false>, Sched, false>(lds, 512 / 64, 512, 512, S, E, nullptr); }
            else { EpiRes<false, false, false> E{H, H, nullptr, nullptr, nullptr, nullptr, nullptr}; gemm_phase<EpiRes<false, false, false>, Sched, false>(lds, 512 / 64, 512, 512, S, E, nullptr); }
            SEAM(pq + 2);
        }
}
#undef IN
#undef PH
#undef SEAM
constexpr int NPHASE = 21;
__global__ void __launch_bounds__(NTHREADS, 2) mega_fwd(Args a) {
    extern __shared__ __attribute__((aligned(16))) unsigned char lds_raw[];
    LAS unsigned char* lds = (LAS unsigned char*)lds_raw;
    const int tid = threadIdx.x, lane = tid & 63, wave = __builtin_amdgcn_readfirstlane(tid >> 6);
    const int G = gridDim.x, blk = blockIdx.x, gw = blk * NWAVES + wave, ngw = G * NWAVES;
    unsigned char* ws = a.ws;
    volatile LAS unsigned* MISC = (volatile LAS unsigned*)(lds + MISC_OFF);
    if (tid < 64) MISC[tid] = 0u;
    __syncthreads();
    XcdBarrier bar = xcd_barrier_post((unsigned*)(ws + WS_CTL) + CW_BAR, MISC + 8);
    const int lo = a.ph_lo, hi = a.ph_hi;
#define IN(k) (lo <= (k) && (k) < hi)
#define PH(k) ((((PHASE_MASK) >> (k)) & 1u) && IN(k))
#define SEAM(k) do { if ((((PHASE_MASK) >> ((k) + 1)) & 1u) && IN((k) + 1)) xcd_barrier(bar); } while (0)
    using namespace gm;
    bf16_t* APA = (bf16_t*)(ws + WS_APA); bf16_t* APB = (bf16_t*)(ws + WS_APB); float* H = (float*)(ws + WS_H); float* SSQ = (float*)(ws + WS_SSQ);
    unsigned char* r1 = ws + WS_R1;

    if (PH(0)) {
#if (REPEAT_MASK & 1u)
        phase_prologue(a, lds, gw, ngw, wave, lane); xcd_barrier(bar);
#endif
        phase_prologue(a, lds, gw, ngw, wave, lane); SEAM(0); }

    if (PH(1)) {
        Sched S; S.o.init(T / 256, 20, G, blk); S.A = (const char*)APA; S.B = (const char*)(ws + WS_WIN); S.a_tile = 256ull * D; S.b_tile = 256ull * D; S.pn_shift = 30; S.a_pn_bytes = 0; S.tile_e = nullptr; S.b_exp = 0;
        EpiInProj E{(bf16_t*)(r1 + R_Q), (bf16_t*)(r1 + R_BLKK), (bf16_t*)(r1 + R_BLKV), (bf16_t*)(r1 + R_KS), (bf16_t*)(r1 + R_VS), (bf16_t*)(r1 + R_KW), (bf16_t*)(r1 + R_VW), (const float*)(ws + WS_ROPE)};
        gemm_phase<EpiInProj, Sched, false, true, 121, 125>(lds, D / 128, D, D, S, E, nullptr);
#if (REPEAT_MASK & 2u)
        xcd_barrier(bar); gemm_phase<EpiInProj, Sched, false>(lds, D / 64, D, D, S, E, nullptr);
#endif
        SEAM(1);
    }
    if (PH(2)) {
        if (blk < 32) { const int kv = blk >> 4, pm = blk & 15;
            OneUnit S; S.on = true; S.u.pm = pm; S.u.pn = 0; S.u.x0 = kv; S.u.x1 = 0; S.u.A = (const char*)(r1 + (kv ? R_BLKV : R_BLKK)) + (size_t)pm * 256 * 4096; S.u.B = (const char*)(ws + WS_C1) + (size_t)kv * 256 * 4096;
            EpiCmp1 E{(bf16_t*)(r1 + R_HID), (const float*)(ws + WS_B1)};
            gemm_phase<EpiCmp1, OneUnit, false, true, 121, 125>(lds, 4096 / 128, 4096, 4096, S, E, nullptr);
            VM_WAIT(); __syncthreads();
            OneUnit S2; S2.on = true; S2.u.pm = pm; S2.u.pn = 0; S2.u.x0 = kv; S2.u.x1 = 0; S2.u.A = (const char*)(r1 + R_HID) + ((size_t)kv * 4096 + pm * 256) * 256 * 2; S2.u.B = (const char*)(ws + WS_C2) + (size_t)kv * 256 * 256 * 2;
            EpiCmp2 E2{(bf16_t*)(r1 + R_KC), (bf16_t*)(r1 + R_VCT), (const float*)(ws + WS_ROPE)};
            gemm_phase<EpiCmp2, OneUnit, false>(lds, 256 / 64, 256, 256, S2, E2, nullptr);
        } else if (blk < 96) { const int pm = blk - 32;
            OneUnit S; S.on = true; S.u.pm = pm; S.u.pn = 0; S.u.x0 = 0; S.u.x1 = 0; S.u.A = (const char*)APA + (size_t)pm * 256 * D; S.u.B = (const char*)(ws + WS_WG);
            EpiGates E{(float*)(ws + WS_GATES), a.in[8]};
            gemm_phase<EpiGates, OneUnit, false, true, 121, 125>(lds, D / 128, D, D, S, E, nullptr);
        } else if (blk < 104) { const int l = (blk - 96) >> 2, pn = (blk - 96) & 3;
            OneUnit S; S.on = true; S.u.pm = 0; S.u.pn = pn; S.u.x0 = l; S.u.x1 = 0; S.u.A = (const char*)(ws + WS_MEMN) + (size_t)l * 256 * D * 2; S.u.B = (const char*)(ws + WS_MWKV) + ((size_t)l * 1024 + pn * 256) * D * 2;
            EpiMemKV E{(bf16_t*)(ws + WS_KM), (bf16_t*)(ws + WS_VMT)};
            gemm_phase<EpiMemKV, OneUnit, false>(lds, D / 64, D, D, S, E, nullptr);
        } else {
            LAS bf16_t* scr = (LAS bf16_t*)(lds + wave * 18432);
            const int w0 = (blk - 104) * NWAVES + wave, nw = (G - 104) * NWAVES;
            for (int it = w0; it < 2048; it += nw) { const int which = it >> 10, g = (it >> 8) & 3, tb = it & 255;
                vtrans_item((const bf16_t*)(r1 + (which ? R_VW : R_VS)) + (size_t)(tb * 64) * 512 + g * 128, (bf16_t*)(r1 + (which ? R_VWT : R_VST)) + (size_t)(g * 128) * T + tb * 64, scr, lane); }
            tr_moe_range(a, (LAS float*)(lds + wave * 18432), TR_D0, TR_D1, w0, nw, lane);
        }
        SEAM(2);
    }
    if (PH(4)) {
        unsigned* nsaq = (unsigned*)(ws + WS_CTL) + CW_NSAQ;
        for (;;) {
            if (tid == 0) MISC[16] = __hip_atomic_fetch_add(nsaq, 1u, __ATOMIC_RELAXED, __HIP_MEMORY_SCOPE_AGENT);
            __syncthreads();
            const unsigned u = MISC[16];
            if (u >= 1024u) break;
            nsa_unit(ws, 255 - (int)(u >> 2), (int)(u & 3u), lds, wave, lane);
            __syncthreads();
            { const int n0 = (int)u * TR_PER_UNIT, n1 = n0 + TR_PER_UNIT < TRN_TOTAL ? n0 + TR_PER_UNIT : TRN_TOTAL; tr_run<true>(a, (LAS float*)(lds + wave * 8448), n0, n1, wave, NWAVES, lane); }
        }
        VM_WAIT(); __syncthreads();
        SEAM(4);
    }
    if (PH(5)) {
        Sched S; S.o.init(T / 256, 8, G, blk); S.A = (const char*)(r1 + R_BLKK); S.B = (const char*)(ws + WS_WOUT); S.a_tile = 256ull * D; S.b_tile = 256ull * D; S.pn_shift = 30; S.a_pn_bytes = 0; S.tile_e = nullptr; S.b_exp = 0;
        EpiRes<true, true, false, true> E{a.in[0], H, APB, a.in[3], SSQ, nullptr, nullptr};
        gemm_phase<EpiRes<true, true, false, true>, Sched, false, true, 121, 121>(lds, D / 128, D, D, S, E, nullptr);
        SEAM(5);
    }
    mem_layer<0>(a, lds, bar, lo, hi, G, blk, gw, ngw, lane);
        if (PH(9)) {
            Sched S; S.o.init(T / 256, 44, G, blk); S.A = (const char*)APA; S.B = (const char*)(ws + WS_FGU); S.a_tile = 256ull * D * 2; S.b_tile = 256ull * D * 2; S.pn_shift = 30; S.a_pn_bytes = 0; S.tile_e = nullptr; S.b_exp = 0;
            EpiSwiglu<true, true> E{(bf16_t*)r1, SSQ};
            gemm_phase<EpiSwiglu<true, true>, Sched, false>(lds, D / 64, D, D, S, E, nullptr);
#if (REPEAT_MASK & 512u)
            xcd_barrier(bar); gemm_phase<EpiSwiglu<true>, Sched, false>(lds, D / 64, D, D, S, E, nullptr);
#endif
            SEAM(9);
        }
        if (PH(10)) {
            Sched S; S.o.init(T / 256, 8, G, blk); S.A = (const char*)r1; S.B = (const char*)(ws + WS_FD); S.a_tile = 256ull * DFF; S.b_tile = 256ull * DFF; S.pn_shift = 30; S.a_pn_bytes = 0; S.tile_e = nullptr; S.b_exp = 0;
            EpiRes<false, true, false> E{H, H, nullptr, nullptr, SSQ, nullptr, nullptr};
            gemm_phase<EpiRes<false, true, false>, Sched, false, true, 120, 123>(lds, DFF / 128, DFF, DFF, S, E, nullptr);
            SEAM(10);
        }
        if (PH(11)) {
            LAS float* rs = (LAS float*)lds;
            for (int rep = 0; rep < ((PROBE_SMALL & 2) ? 3 : 1); ++rep) for (int tb = blk; tb < T / 64; tb += G) {
                const int t0 = tb * 64;
                if (tid < 79) { const int t = t0 - 15 + tid; float v = 0.f;
                    if (t >= 0) { const f32x4* sp = (const f32x4*)(SSQ + (size_t)t * 32); f32x4 s4 = sp[0];
#pragma unroll
                        for (int j = 1; j < 8; ++j) s4 += sp[j];
                        v = __builtin_amdgcn_rsqf(((s4.x + s4.y) + (s4.z + s4.w)) * (1.0f / D) + EPS); }
                    rs[tid] = v; }
                __syncthreads();
                const float* gain = a.in[2] + D;
                const int grp = tid >> 7;
                pool_body(2 << grp, H, gain, APB, rs, t0, tid);
                __syncthreads();
            }
            SEAM(11);
        }
        if (PH(12)) {
            Sched S; S.o.init(T / 256, 8, G, blk); S.A = (const char*)APB; S.B = (const char*)(ws + WS_PW); S.a_tile = 256ull * D * 2; S.b_tile = 256ull * 512 * 2; S.pn_shift = 1; S.a_pn_bytes = 512 * 2; S.tile_e = nullptr; S.b_exp = 0;
            EpiRes<true, true, true, true> E{H, H, APA, a.in[3] + D, SSQ, a.in[17], a.in[18]};
            gemm_phase<EpiRes<true, true, true, true>, Sched, false>(lds, 512 / 64, D, 512, S, E, nullptr);
            SEAM(12);
        }
    mem_layer<1>(a, lds, bar, lo, hi, G, blk, gw, ngw, lane);
    int* moi = (int*)(ws + WS_MOE); float* mof = (float*)(ws + WS_MOE);
    if (PH(16)) {
        int lane = threadIdx.x; asm volatile("" : "+v"(lane)); lane &= 63;
        LAS float* rl = (LAS float*)lds; LAS int* cnt = (LAS int*)(lds + 512 * 144);
        const float* router = a.in[26];
        for (int idx = tid; idx < 2048 * 8; idx += NTHREADS) { const int k = idx >> 3, e = idx & 7; rl[(k >> 2) * 36 + (k & 3) * 8 + e] = router[idx]; }
        for (int rep = 0; rep < ((PROBE_SMALL & 4) ? 3 : 1); ++rep) for (int tb = blk; tb < T / 64; tb += G) {
            if (tid < 8) cnt[tid] = 0;
            __syncthreads();
            const f32x4* gr = (const f32x4*)(a.in[5] + D) + lane;
            for (int i = 0; i < 8; ++i) {
                const int t = tb * 64 + wave * 8 + i;
                const f32x4* xr = (const f32x4*)(H + (size_t)t * D) + lane; f32x4 v[8]; float s = 0.f;
#pragma unroll
                for (int j = 0; j < 8; ++j) { v[j] = xr[64 * j]; s += (v[j].x * v[j].x + v[j].y * v[j].y) + (v[j].z * v[j].z + v[j].w * v[j].w); }
                const float r = __builtin_amdgcn_rsqf(wave_sum(s) * (1.0f / D) + EPS);
                float lg[8];
#pragma unroll
                for (int e = 0; e < 8; ++e) lg[e] = 0.f;
                unsigned* o8 = (unsigned*)((unsigned char*)APA + (size_t)t * D) + lane;
#pragma unroll
                for (int j = 0; j < 8; ++j) { const f32x4 u = (v[j] * r) * gr[64 * j]; o8[64 * j] = pk4_fp8(4.f * u.x, 4.f * u.y, 4.f * u.z, 4.f * u.w);
                    const LAS float* base = rl + (lane + 64 * j) * 36;
#pragma unroll
                    for (int rr = 0; rr < 4; ++rr) { const f32x4 w0 = *(const LAS f32x4*)(base + rr * 8), w1 = *(const LAS f32x4*)(base + rr * 8 + 4); const float uv = u[rr];
                        lg[0] += uv * w0.x; lg[1] += uv * w0.y; lg[2] += uv * w0.z; lg[3] += uv * w0.w; lg[4] += uv * w1.x; lg[5] += uv * w1.y; lg[6] += uv * w1.z; lg[7] += uv * w1.w; } }
#pragma unroll
                for (int e = 0; e < 8; ++e) lg[e] = wave_sum(lg[e]);
                int e0 = 0; float v0 = lg[0];
#pragma unroll
                for (int e = 1; e < 8; ++e) if (lg[e] > v0) { v0 = lg[e]; e0 = e; }
                int e1 = -1; float v1 = -3.0e38f;
#pragma unroll
                for (int e = 0; e < 8; ++e) if (e != e0 && lg[e] > v1) { v1 = lg[e]; e1 = e; }
                if (e1 < 0) { e1 = (e0 + 1) & 7; v1 = v0; }
                if (lane == 0) { const float w0 = 1.0f / (1.0f + __expf(v1 - v0)); moi[MO_TOPI + 2 * t] = e0; moi[MO_TOPI + 2 * t + 1] = e1; mof[MO_TOPW + 2 * t] = w0; mof[MO_TOPW + 2 * t + 1] = 1.0f - w0;
                    (void)__hip_atomic_fetch_add(cnt + e0, 1, __ATOMIC_RELAXED, __HIP_MEMORY_SCOPE_WORKGROUP); (void)__hip_atomic_fetch_add(cnt + e1, 1, __ATOMIC_RELAXED, __HIP_MEMORY_SCOPE_WORKGROUP); }
            }
            __syncthreads();
            if (tid < 8) moi[MO_CNTB + tb * 8 + tid] = cnt[tid];
            __syncthreads();
        }
        SEAM(16);
    }
    if (PH(17)) {
        LAS int* li = (LAS int*)lds;
        for (int tb = blk; tb < T / 64; tb += G) {
            if (tid < 8) { int tot = 0, pre = 0; for (int b = 0; b < T / 64; ++b) { const int c = moi[MO_CNTB + b * 8 + tid]; tot += c; if (b < tb) pre += c; } li[tid] = tot; li[16 + tid] = pre; }
            if (tid >= 64 && tid < 192) li[32 + tid - 64] = moi[MO_TOPI + tb * 128 + (tid - 64)];
            __syncthreads();
            if (tid == 0) { int p = 0; for (int e = 0; e < 8; ++e) { li[8 + e] = p; p += (li[e] + 255) / 256 * 256; } li[24] = p; }
            __syncthreads();
            if (tid < 128) { const int e = li[32 + tid]; int rank = 0; for (int m2 = 0; m2 < tid; ++m2) rank += (li[32 + m2] == e) ? 1 : 0;
                const int slot = li[8 + e] + li[16 + e] + rank, pairi = tb * 128 + tid;
                moi[MO_TOKS + slot] = pairi >> 1; moi[MO_PAIR + slot] = pairi; mof[MO_GATE + slot] = mof[MO_TOPW + pairi]; moi[MO_SLOT + pairi] = slot; }
            if (tb == 0) {
                for (int e = 0; e < 8; ++e) { const int beg = li[8 + e] + li[e], end = li[8 + e] + (li[e] + 255) / 256 * 256;
                    for (int s = beg + tid; s < end; s += NTHREADS) { moi[MO_TOKS + s] = 0; moi[MO_PAIR + s] = -1; mof[MO_GATE + s] = 0.f; }
                    const int t0 = li[8 + e] / 256, t1 = end / 256; for (int tt = t0 + tid; tt < t1; tt += NTHREADS) moi[MO_TILEE + tt] = e; }
                if (tid == 0) moi[MO_NT] = li[24] / 256;
            }
            __syncthreads();
        }
        SEAM(17);
    }
    if (PH(18)) {
        const int ntile = __builtin_amdgcn_readfirstlane(moi[MO_NT]);
        Sched S; S.o.init(ntile, 44, G, blk); S.A = (const char*)APA; S.B = (const char*)(ws + WS_MGU); S.a_tile = 0; S.b_tile = 256ull * D; S.pn_shift = 30; S.a_pn_bytes = 0; S.tile_e = moi + MO_TILEE; S.b_exp = 11264ull * D;
        EpiSwiglu<false, true> E{(bf16_t*)r1, nullptr};
        gemm_phase<EpiSwiglu<false, true>, Sched, true, true, 121, 125>(lds, D / 128, D, D, S, E, moi + MO_TOKS);
        SEAM(18);
    }
    if (PH(19)) {
        const int ntile = __builtin_amdgcn_readfirstlane(moi[MO_NT]);
        const MoeSplit ms = moe_split(ntile, G);
        SchedSK S; S.o.init(ms.F, 8, G, blk); S.A = (const char*)r1; S.B = (const char*)(ws + WS_MD); S.a_tile = 256ull * DFF; S.b_tile = 256ull * DFF; S.tile_e = moi + MO_TILEE; S.b_exp = 2048ull * DFF; S.F = ms.F; S.R = ms.R; S.sk = ms.sk; S.G = G; S.c = blk;
        EpiMoeDown E{APA, moi + MO_PAIR, mof + MO_GATE, (float*)(ws + WS_PART), ms.F * 256, ms.R * 256};
        gemm_phase<EpiMoeDown, SchedSK, false, true, 120, 123, true>(lds, DFF / 128, DFF, DFF, S, E, nullptr);
        SEAM(19);
    }
    if (PH(20)) {
        int lane = threadIdx.x; asm volatile("" : "+v"(lane)); lane &= 63;
        const MoeSplit ms = moe_split(__builtin_amdgcn_readfirstlane(moi[MO_NT]), G); const int tail0 = ms.sk > 1 ? ms.F * 256 : 0x7fffffff; const float* part = (const float*)(ws + WS_PART);
        int sl0 = 0, sl1 = 0;
        if (gw < T) { sl0 = __builtin_amdgcn_readfirstlane(moi[MO_SLOT + 2 * gw]); sl1 = __builtin_amdgcn_readfirstlane(moi[MO_SLOT + 2 * gw + 1]); }
        for (int rep = 0; rep < ((PROBE_SMALL & 8) ? 3 : 1); ++rep) for (int t = gw; t < T; t += ngw) {
            const f32x4* xr = (const f32x4*)(H + (size_t)t * D) + lane;
            f32x4 v[8];
            const int c0 = sl0, c1 = sl1; const int tn = t + ngw < T ? t + ngw : t;
            sl0 = __builtin_amdgcn_readfirstlane(moi[MO_SLOT + 2 * tn]); sl1 = __builtin_amdgcn_readfirstlane(moi[MO_SLOT + 2 * tn + 1]);
            if (c0 < tail0 && c1 < tail0) {
                const u32x2* y0 = (const u32x2*)(APA + (size_t)(2 * t) * D) + lane; const u32x2* y1 = (const u32x2*)(APA + (size_t)(2 * t + 1) * D) + lane;
#pragma unroll
                for (int j = 0; j < 8; ++j) { const u32x2 p0 = y0[64 * j], p1 = y1[64 * j];
                    f32x4 x = xr[64 * j];
                    x.x += __uint_as_float(p0.x << 16) + __uint_as_float(p1.x << 16); x.y += __uint_as_float(p0.x & 0xffff0000u) + __uint_as_float(p1.x & 0xffff0000u);
                    x.z += __uint_as_float(p0.y << 16) + __uint_as_float(p1.y << 16); x.w += __uint_as_float(p0.y & 0xffff0000u) + __uint_as_float(p1.y & 0xffff0000u);
                    v[j] = x; }
            } else {
#pragma unroll
                for (int j = 0; j < 8; ++j) v[j] = xr[64 * j];
#pragma unroll
                for (int k = 0; k < 2; ++k) {
                    const int slot = k ? c1 : c0;
                    if (slot < tail0) { const u32x2* y = (const u32x2*)(APA + (size_t)(2 * t + k) * D) + lane;
#pragma unroll
                        for (int j = 0; j < 8; ++j) { const u32x2 p0 = y[64 * j];
                            v[j].x += __uint_as_float(p0.x << 16); v[j].y += __uint_as_float(p0.x & 0xffff0000u); v[j].z += __uint_as_float(p0.y << 16); v[j].w += __uint_as_float(p0.y & 0xffff0000u); } }
                    else {
                        f32x4 ys[8];
                        for (int ks = 0; ks < ms.sk; ++ks) { const f32x4* pr = (const f32x4*)(part + ((size_t)ks * (ms.R * 256) + (slot - tail0)) * D) + lane;
#pragma unroll
                            for (int j = 0; j < 8; ++j) { const f32x4 q = pr[64 * j]; ys[j] = ks ? ys[j] + q : q; } }
#pragma unroll
                        for (int j = 0; j < 8; ++j) v[j] += ys[j]; }
                }
            }
            float s = 0.f;
#pragma unroll
            for (int j = 0; j < 8; ++j) { const f32x4 x = v[j]; s += (x.x * x.x + x.y * x.y) + (x.z * x.z + x.w * x.w); }
            const float r = __builtin_amdgcn_rsqf(wave_sum(s) * (1.0f / D) + EPS);
            const f32x4* gr = (const f32x4*)a.in[6] + lane; f32x4* orow = (f32x4*)(a.out + (size_t)t * D) + lane;
#pragma unroll
            for (int j = 0; j < 8; ++j) orow[64 * j] = (v[j] * r) * gr[64 * j];
        }
    }
#undef IN
#undef PH
#undef SEAM
}

extern "C" void kernel_launch(void* const* d_in, const int* in_sizes, int n_in, void* d_out, int out_size, void* d_ws, size_t ws_size, hipStream_t stream) {
    static int grid = 0;
    if (grid == 0) {
        if (n_in != 30 || out_size != T * D || ws_size < WS_END) { fprintf(stderr, "kernel_launch: unexpected shapes (n_in %d, out %d, ws %zu < %zu)\n", n_in, out_size, ws_size, (size_t)WS_END); grid = -1; return; }
        int dev = 0, cus = 0, per_cu = 0;
        if (hipGetDevice(&dev) != hipSuccess || hipDeviceGetAttribute(&cus, hipDeviceAttributeMultiprocessorCount, dev) != hipSuccess) { grid = -1; return; }
        if (hipFuncSetAttribute((const void*)mega_fwd, hipFuncAttributeMaxDynamicSharedMemorySize, LDS_BYTES) != hipSuccess) { fprintf(stderr, "kernel_launch: hipFuncSetAttribute failed\n"); grid = -1; return; }
        if (hipOccupancyMaxActiveBlocksPerMultiprocessor(&per_cu, (const void*)mega_fwd, NTHREADS, LDS_BYTES) != hipSuccess || per_cu < 1) { fprintf(stderr, "kernel_launch: occupancy query says %d\n", per_cu); (void)hipGetLastError(); grid = -1; return; }
        grid = cus;
    }
    if (grid < 0) return;
    (void)hipMemsetAsync((char*)d_ws + WS_CTL, 0, 1 * MiB, stream);
    Args a{};
    for (int i = 0; i < 30; ++i) a.in[i] = (const float*)d_in[i];
    a.out = (float*)d_out; a.ws = (unsigned char*)d_ws;
#if N_LAUNCH_MODE == 1
    a.ph_lo = 0; a.ph_hi = NPHASE;
    hipLaunchKernelGGL(mega_fwd, dim3(grid), dim3(NTHREADS), LDS_BYTES, stream, a);
#else
    for (int p = 0; p < NPHASE; ++p) { a.ph_lo = p; a.ph_hi = p + 1; hipLaunchKernelGGL(mega_fwd, dim3(grid), dim3(NTHREADS), LDS_BYTES, stream, a); }
#endif
}
```

```cpp
#include <hip/hip_runtime.h>
#include <type_traits>
#include <cstdio>
#include <cstdint>

#ifndef PROBE_SMALL
#define PROBE_SMALL 0
#endif
#ifndef NSA_PROBE
#define NSA_PROBE 0
#endif
#ifndef REPEAT_MASK
#define REPEAT_MASK 0u
#endif
#ifndef PHASE_MASK
#define PHASE_MASK 0xffffffffu
#endif
#ifndef N_LAUNCH_MODE
#define N_LAUNCH_MODE 1
#endif

#define LAS __attribute__((address_space(3)))
#define GAS __attribute__((address_space(1)))
typedef unsigned short bf16_t;
typedef short bf16x8 __attribute__((ext_vector_type(8)));
typedef float f32x4 __attribute__((ext_vector_type(4)));
typedef float f32x2 __attribute__((ext_vector_type(2)));
typedef unsigned u32x4 __attribute__((ext_vector_type(4)));
typedef unsigned u32x2 __attribute__((ext_vector_type(2)));
typedef int v4i_t __attribute__((ext_vector_type(4)));
typedef int v8i_t __attribute__((ext_vector_type(8)));

constexpr int T = 16384, D = 2048, NHEAD = 16, HD = 128, NGRP = 4;
constexpr int NSA_W = 5168;
constexpr int DFF = 5632, NEXP = 8;
constexpr int MEML = 256, MEMW = 512;
constexpr int NCMP = 1023;
constexpr float EPS = 1e-6f, NEGF = -1e30f, L2E = 1.4426950408889634f, QSCALE = 0.08838834764831845f;
constexpr int NWAVES = 8, NTHREADS = 512;

constexpr size_t MiB = 1ull << 20;
constexpr size_t alm(size_t x) { return (x + MiB - 1) / MiB * MiB; }
constexpr size_t WS_CTL = 0;
constexpr size_t WS_WIN = 1 * MiB;
constexpr size_t WS_WG = WS_WIN + alm(5120ull * 2048 * 2);
constexpr size_t WS_WOUT = WS_WG + alm(256ull * 2048 * 2);
constexpr size_t WS_MWQ = WS_WOUT + alm(2048ull * 2048 * 2);
constexpr size_t WS_MWKV = WS_MWQ + alm(2ull * 512 * 2048 * 2);
constexpr size_t WS_MWO = WS_MWKV + alm(2ull * 1024 * 2048 * 2);
constexpr size_t WS_FGU = WS_MWO + alm(2ull * 2048 * 512 * 2);
constexpr size_t WS_FD = WS_FGU + alm(11264ull * 2048 * 2);
constexpr size_t WS_MGU = WS_FD + alm(2048ull * 5632 * 2);
constexpr size_t WS_MD = WS_MGU + alm(8ull * 11264 * 2048 * 2);
constexpr size_t WS_PW = WS_MD + alm(8ull * 2048 * 5632 * 2);
constexpr size_t WS_C1 = WS_PW + alm(2048ull * 512 * 2);
constexpr size_t WS_C2 = WS_C1 + alm(2ull * 256 * 4096 * 2);
constexpr size_t WS_ROPE = WS_C2 + alm(2ull * 256 * 256 * 2);
constexpr size_t WS_H = WS_ROPE + alm((size_t)T * 64 * 8);
constexpr size_t WS_APA = WS_H + alm((size_t)T * D * 4);
constexpr size_t WS_APB = WS_APA + alm((size_t)T * D * 2);
constexpr size_t WS_MISC = WS_APB + alm((size_t)T * D * 2);
constexpr size_t WS_QM = WS_MISC;
constexpr size_t WS_OM = WS_QM + alm((size_t)T * 512 * 2);
constexpr size_t WS_MEMN = WS_OM + alm((size_t)T * 512 * 2);
constexpr size_t WS_KM = WS_MEMN + alm(2ull * 256 * 2048 * 2);
constexpr size_t WS_VMT = WS_KM + alm(2ull * 256 * 512 * 2);
constexpr size_t WS_SSQ = WS_VMT + alm(2ull * 512 * 256 * 2);
constexpr size_t WS_GATES = WS_SSQ + alm((size_t)T * 32 * 4);
constexpr size_t WS_B1 = WS_GATES + alm((size_t)T * 48 * 4);
constexpr size_t WS_MOE = WS_B1 + MiB;
constexpr size_t WS_IMP = WS_MOE + 2 * MiB;
constexpr size_t WS_R1 = WS_IMP + 32 * MiB;
constexpr int MAXSLOT = 34816;
constexpr size_t R1_BYTES = alm((size_t)MAXSLOT * DFF * 2);
constexpr size_t WS_END = WS_R1 + R1_BYTES;
constexpr size_t R_Q = 0;
constexpr size_t R_BLKK = R_Q + alm((size_t)T * 2048 * 2);
constexpr size_t R_BLKV = R_BLKK + alm(4096ull * 4096 * 2);
constexpr size_t R_KS = R_BLKV + alm(4096ull * 4096 * 2);
constexpr size_t R_VS = R_KS + alm((size_t)T * 512 * 2);
constexpr size_t R_KW = R_VS + alm((size_t)T * 512 * 2);
constexpr size_t R_VW = R_KW + alm((size_t)T * 512 * 2);
constexpr size_t R_VST = R_VW + alm((size_t)T * 512 * 2);
constexpr size_t R_VWT = R_VST + alm((size_t)T * 512 * 2);
constexpr size_t R_KC = R_VWT + alm((size_t)T * 512 * 2);
constexpr size_t R_VCT = R_KC + alm(4ull * 1024 * 128 * 2);
constexpr size_t R_HID = R_VCT + alm(4ull * 128 * 1024 * 2);
constexpr size_t R_O = R_HID + alm(2ull * 4096 * 256 * 2);
constexpr size_t R_NSA_END = R_O + alm((size_t)T * 2048 * 4);
static_assert(R_NSA_END <= R1_BYTES, "NSA overlay");
static_assert(WS_END <= 1476395008ull, "workspace");
constexpr int MO_TOPI = 0;
constexpr int MO_TOPW = MO_TOPI + T * 2;
constexpr int MO_CNTB = MO_TOPW + T * 2;
constexpr int MO_TOKS = MO_CNTB + 256 * 8;
constexpr int MO_PAIR = MO_TOKS + MAXSLOT;
constexpr int MO_GATE = MO_PAIR + MAXSLOT;
constexpr int MO_TILEE = MO_GATE + MAXSLOT;
constexpr int MO_NT = MO_TILEE + 160;
constexpr int MO_SLOT = MO_NT + 1;
static_assert((MO_SLOT + 2 * T) * 4 <= 2 * (int)MiB, "moe tables");
constexpr size_t WS_PART = WS_MGU + 8ull * 11264 * 2048;
struct MoeSplit { int F, R, sk; };
__device__ __forceinline__ MoeSplit moe_split(int ntile, int G) {
    MoeSplit m; m.F = ntile; m.R = 0; m.sk = 1;
    if (G == 256) { m.F = ntile & ~31; m.R = ntile - m.F; m.sk = m.R == 0 ? 1 : m.R <= 8 ? 4 : m.R <= 16 ? 2 : 1; if (m.sk == 1) { m.F = ntile; m.R = 0; } }
    return m;
}

constexpr int CW_BAR = 4096, CW_NSAQ = 8192;

constexpr int LDS_BYTES = 155648;
constexpr int MISC_OFF = LDS_BYTES - 256;

__device__ __forceinline__ unsigned cvt_pk_bf16(float lo, float hi) { unsigned r; asm("v_cvt_pk_bf16_f32 %0, %1, %2" : "=v"(r) : "v"(lo), "v"(hi)); return r; }
__device__ __forceinline__ bf16_t f2bf(float f) { return (bf16_t)(cvt_pk_bf16(f, 0.f) & 0xffffu); }
__device__ __forceinline__ float clamp448(float x) { return fminf(fmaxf(x, -448.f), 448.f); }
__device__ __forceinline__ unsigned pk4_fp8(float a, float b, float c, float d) {
    unsigned r = 0; r = __builtin_amdgcn_cvt_pk_fp8_f32(clamp448(a), clamp448(b), r, false); r = __builtin_amdgcn_cvt_pk_fp8_f32(clamp448(c), clamp448(d), r, true); return r; }
__device__ __forceinline__ float wave_sum(float v) {
#pragma unroll
    for (int o = 32; o >= 1; o >>= 1) v += __shfl_xor(v, o);
    return v;
}
__device__ __forceinline__ float fast_rcp(float x) { return __builtin_amdgcn_rcpf(x); }
__device__ __forceinline__ float fast_exp(float x) { return __builtin_amdgcn_exp2f(x * L2E); }
__device__ __forceinline__ float sigmoidf_(float x) { return fast_rcp(1.f + fast_exp(-x)); }
__device__ __forceinline__ float gelu_tanh(float x) { const float y = 0.7978845608028654f * (x + 0.044715f * x * x * x); const float t = 1.f - 2.f * fast_rcp(1.f + fast_exp(2.f * y)); return 0.5f * x * (1.f + t); }
#define LDS_WAIT() asm volatile("s_waitcnt lgkmcnt(0)" ::: "memory")
#define VM_WAIT() asm volatile("s_waitcnt vmcnt(0)" ::: "memory")

#define XB_TMO      128
#define XB_XCNT(j)  (256  + 64 * (j))
#define XB_XSUB(j)  (1280 + 64 * (j))
#define XB_XGEN(j)  (2304 + 64 * (j))
#define XB_TOP      3328
#define XB_TOPGEN   3392
#define XCD_BAR_WORDS 3456
#define XB_SPIN_CAP (1u << 18)
__device__ __forceinline__ unsigned xb_ld(unsigned* p)              { return __hip_atomic_load(p, __ATOMIC_RELAXED, __HIP_MEMORY_SCOPE_AGENT); }
__device__ __forceinline__ unsigned xb_add(unsigned* p, unsigned v) { return __hip_atomic_fetch_add(p, v, __ATOMIC_RELAXED, __HIP_MEMORY_SCOPE_AGENT); }
__device__ __forceinline__ unsigned xb_xcc_id() { return (unsigned)__builtin_amdgcn_s_getreg((3 << 11) | 20) & 0xFu; }
#define XB_SPIN(cond, bar) do { unsigned _sp = 0; while (cond) { __builtin_amdgcn_s_sleep(1); \
    if ((++_sp & 255u) == 0u) { if (xb_ld(&(bar)[XB_TMO])) break; if (_sp > XB_SPIN_CAP) { atomicAdd(&(bar)[XB_TMO], 1u); break; } } } } while (0)
struct XcdBarrier { unsigned* bar; unsigned x; volatile LAS unsigned* st; };
__device__ __forceinline__ XcdBarrier xcd_barrier_post(unsigned* bar, volatile LAS unsigned* st) {
    XcdBarrier b; b.bar = bar; b.x = xb_xcc_id(); b.st = st;
    if (threadIdx.x == 0) (void)xb_add(&bar[XB_XCNT(b.x)], 1u);
    return b;
}
__device__ __forceinline__ void xcd_barrier_complete(unsigned* bar, unsigned x, unsigned& nloc, unsigned& nx) {
    const unsigned G = gridDim.x * gridDim.y * gridDim.z;
    unsigned sum, cnt, mine, sp = 0u;
    for (;;) {
        sum = 0u; cnt = 0u; mine = 0u;
#pragma unroll
        for (unsigned j = 0; j < 16; ++j) { const unsigned c = xb_ld(&bar[XB_XCNT(j)]); sum += c; cnt += (c > 0u) ? 1u : 0u; mine = (j == x) ? c : mine; }
        if (sum == G) break;
        __builtin_amdgcn_s_sleep(1);
        if ((++sp & 255u) == 0u) { if (xb_ld(&bar[XB_TMO])) break; if (sp > XB_SPIN_CAP) { atomicAdd(&bar[XB_TMO], 1u); break; } }
    }
    nloc = mine > 0u ? mine : 1u; nx = cnt > 0u ? cnt : 1u;
}
__device__ __forceinline__ void xcd_barrier(const XcdBarrier& b) {
    asm volatile("s_waitcnt vmcnt(0)" ::: "memory");
    __syncthreads();
    if (threadIdx.x == 0) {
        unsigned* bar = b.bar;
        __builtin_amdgcn_s_waitcnt(0);
        unsigned nloc = b.st[0], nx = b.st[1];
        if (nloc == 0u) { xcd_barrier_complete(bar, b.x, nloc, nx); b.st[0] = nloc; b.st[1] = nx; }
        const unsigned old = xb_add(&bar[XB_XSUB(b.x)], 1u);
        const unsigned gen = old / nloc;
        if (old + 1u == (gen + 1u) * nloc) {
            __builtin_amdgcn_fence(__ATOMIC_RELEASE, "agent");
            asm volatile("s_waitcnt vmcnt(0)" ::: "memory");
            const unsigned og = xb_add(&bar[XB_TOP], 1u);
            const unsigned tg = og / nx;
            if (og + 1u == (tg + 1u) * nx) xb_add(&bar[XB_TOPGEN], 1u);
            else XB_SPIN(xb_ld(&bar[XB_TOPGEN]) == tg, bar);
            __builtin_amdgcn_fence(__ATOMIC_ACQUIRE, "agent");
            xb_add(&bar[XB_XGEN(b.x)], 1u);
            asm volatile("s_waitcnt vmcnt(0)" ::: "memory");
        } else {
            XB_SPIN(xb_ld(&bar[XB_XGEN(b.x)]) == gen, bar);
            __builtin_amdgcn_fence(__ATOMIC_ACQUIRE, "agent");
            asm volatile("s_waitcnt vmcnt(0)" ::: "memory");
        }
    }
    __syncthreads();
}

namespace gm {
constexpr int BM = 256, BK = 64, HALF = 128, HTB = HALF * BK * 2, STAGE_BYTES = 8 * HTB, NXCD = 8, WGM = 8;
__device__ __forceinline__ int lds_byte(int r, int c) { const int st = (r >> 4) * 2 + (c >> 5), rr = r & 15, cc = c & 31, ob = rr * 64 + cc * 2; return st * 1024 + (ob ^ (((ob >> 9) & 1) << 5)); }
__device__ __forceinline__ void stage_rc(int b, int& R, int& C) { const int st = b / 1024, sb = b % 1024, swz = sb ^ (((sb >> 9) & 1) << 5); R = (st >> 1) * 16 + swz / 64; C = (st & 1) * 32 + (swz % 64) / 2; }
__device__ __forceinline__ int perm32(int rho) { const int n = rho >> 4, i = rho & 15; return 8 * (i >> 2) + 4 * n + (i & 3); }

struct GUnit { const char* A; const char* B; int pm, pn, x0, x1; };

struct TileOrder {
    int nM, nN, nwg, G, c;
    __device__ __forceinline__ void init(int nM_, int nN_, int G_, int c_) { nM = nM_; nN = nN_; nwg = nM * nN; G = G_; c = c_; }
    __device__ __forceinline__ bool map(int i, int& pm, int& pn) const {
        const long L = (long)i * G + c; if (L >= nwg) return false;
        int wgid = (int)L; { const int q = nwg / NXCD, r = nwg % NXCD, xcd = wgid % NXCD, off = wgid / NXCD; wgid = (xcd < r ? xcd * (q + 1) : r * (q + 1) + (xcd - r) * q) + off; }
        const int nig = WGM * nN, gid = wgid / nig, fm = gid * WGM, gsz = (nM - fm) < WGM ? (nM - fm) : WGM;
        pm = fm + ((wgid % nig) % gsz); pn = (wgid % nig) / gsz; return true;
    }
};
struct Sched {
    TileOrder o; const char* A; const char* B; size_t a_tile, b_tile; int pn_shift; size_t a_pn_bytes; const int* tile_e; size_t b_exp;
    __device__ __forceinline__ bool next(int i, GUnit& u) const {
        int pm, pn; if (!o.map(i, pm, pn)) return false;
        u.pm = pm; u.pn = pn; u.x0 = 0; u.x1 = 0;
        u.A = A + (size_t)pm * a_tile + (size_t)(pn >> pn_shift) * a_pn_bytes;
        size_t bo = (size_t)pn * b_tile;
        if (tile_e) { const int e = __builtin_amdgcn_readfirstlane(tile_e[pm]); bo += (size_t)e * b_exp; u.x0 = e; }
        u.B = B + bo; return true;
    }
};
struct SchedSK { TileOrder o; const char* A; const char* B; size_t a_tile, b_tile; const int* tile_e; size_t b_exp; int F, R, sk, G, c;
    __device__ __forceinline__ bool next(int i, GUnit& u) const {
        const int L = i * G + c; int pm, pn, kt0 = 0, ntk = 44, ks1 = 0;
        if (L < F * 8) { if (!o.map(i, pm, pn)) return false; }
        else { const int Lt = L - F * 8; if (Lt >= R * 8 * sk) return false;
            pm = F + Lt / (8 * sk); pn = (Lt / sk) & 7; const int ks = Lt % sk; ks1 = ks + 1;
            if (sk == 4) { kt0 = 11 * ks + (ks & 1); ntk = 12 - 2 * (ks & 1); } else { kt0 = 22 * ks; ntk = 22; } }
        u.pm = pm; u.pn = pn; u.x1 = ntk | (ks1 << 8);
        const int e = __builtin_amdgcn_readfirstlane(tile_e[pm]); u.x0 = e;
        u.A = A + (size_t)pm * a_tile + (size_t)kt0 * 128; u.B = B + (size_t)pn * b_tile + (size_t)e * b_exp + (size_t)kt0 * 128; return true;
    }
};
struct OneUnit { GUnit u; bool on; __device__ __forceinline__ bool next(int i, GUnit& o) const { if (i || !on) return false; o = u; return true; } };

template <class Epi, class Sched_, bool GATHER, bool F8 = false, int SCW = 127, int SCA = 127, bool VARNT = false>
__device__ __forceinline__ void gemm_phase(LAS unsigned char* lds, const int nt_, const int lda, const int ldb, const Sched_& S, const Epi& E, const int* __restrict__ rowtab) {
    constexpr int EB = F8 ? 1 : 2;
    const int tid = threadIdx.x, wid = __builtin_amdgcn_readfirstlane(tid >> 6), lane = tid & 63, wr = wid >> 2, wc = wid & 3, fr = lane & 15, fq = lane >> 4;
    int Rr[2], Cc[2]; unsigned voffB[2];
#pragma unroll
    for (int i = 0; i < 2; ++i) { stage_rc(tid * 16 + i * 8192, Rr[i], Cc[i]); const int Rb = Epi::PERM ? ((Rr[i] & ~31) + perm32(Rr[i] & 31)) : Rr[i]; voffB[i] = (unsigned)(Rb * ldb * EB + Cc[i] * 2); }
    unsigned oA[2][2], oN[2][2];
    const size_t kstep = (size_t)(BK * 2);
    const size_t hstepB = (size_t)HALF * ldb * EB;
    const unsigned ldsw = (unsigned)wid * 1024u;
    const int aoff = lds_byte(wr * 64 + fr, fq * 8), boff = lds_byte(wc * 32 + fr, fq * 8);
#define G_SA(b, h) (((b) * 2 + (h)) * HTB)
#define G_SB(b, h) ((4 + (b) * 2 + (h)) * HTB)
#define G_STAGE(bufoff, gbase, voff) do { _Pragma("unroll") for (int _i = 0; _i < 2; ++_i) \
        __builtin_amdgcn_global_load_lds((const unsigned*)((const char*)(gbase) + (voff)[_i]), (LAS unsigned*)(lds + (bufoff) + ldsw + _i * 8192), 16, 0, 0); } while (0)
#define G_LD8(p) __builtin_shufflevector(*(const LAS v4i_t*)(p), *(const LAS v4i_t*)((p) + 1024), 0, 1, 2, 3, 4, 5, 6, 7)
#define G_LDA(dst, b, h) do { if constexpr (F8) { _Pragma("unroll") for (int m = 0; m < 4; ++m) dst##8[m] = G_LD8(lds + G_SA(b, h) + aoff + m * 2048); } \
        else { _Pragma("unroll") for (int m = 0; m < 4; ++m) _Pragma("unroll") for (int k = 0; k < 2; ++k) dst[m][k] = *(const LAS bf16x8*)(lds + G_SA(b, h) + aoff + m * 2048 + k * 1024); } } while (0)
#define G_LDB(dst, b, h) do { if constexpr (F8) { _Pragma("unroll") for (int n = 0; n < 2; ++n) dst##8[n] = G_LD8(lds + G_SB(b, h) + boff + n * 2048); } \
        else { _Pragma("unroll") for (int n = 0; n < 2; ++n) _Pragma("unroll") for (int k = 0; k < 2; ++k) dst[n][k] = *(const LAS bf16x8*)(lds + G_SB(b, h) + boff + n * 2048 + k * 1024); } } while (0)
#define G_MMA(ai, bj, At, Bt) do { __builtin_amdgcn_s_setprio(1); \
        if constexpr (F8) { _Pragma("unroll") for (int m = 0; m < 4; ++m) _Pragma("unroll") for (int n = 0; n < 2; ++n) \
            asm volatile("v_mfma_scale_f32_16x16x128_f8f6f4 %0, %1, %2, %0, %3, %4 op_sel_hi:[0,0,0]" : "+v"(acc[ai][bj][m][n]) : "v"(Bt##8[n]), "v"(At##8[m]), "v"(scw_reg), "v"(sca_reg)); } \
        else { _Pragma("unroll") for (int m = 0; m < 4; ++m) _Pragma("unroll") for (int n = 0; n < 2; ++n) _Pragma("unroll") for (int k = 0; k < 2; ++k) \
            acc[ai][bj][m][n] = __builtin_amdgcn_mfma_f32_16x16x32_bf16(Bt[n][k], At[m][k], acc[ai][bj][m][n], 0, 0, 0); } \
        __builtin_amdgcn_s_setprio(0); } while (0)
#define G_WAIT_V(n) asm volatile("s_waitcnt vmcnt(" #n ")" ::: "memory")
#define G_WAIT_L(n) asm volatile("s_waitcnt lgkmcnt(" #n ")" ::: "memory")
#define G_BAR __builtin_amdgcn_s_barrier()
#define G_SCHED __builtin_amdgcn_sched_barrier(0)
#define G_SETOFF(dst, U) do { _Pragma("unroll") for (int _h = 0; _h < 2; ++_h) _Pragma("unroll") for (int _i = 0; _i < 2; ++_i) { \
        if constexpr (GATHER) dst[_h][_i] = (unsigned)rowtab[(U).pm * 256 + _h * 128 + Rr[_i]] * (unsigned)(lda * EB) + (unsigned)(Cc[_i] * 2); \
        else dst[_h][_i] = (unsigned)((_h * 128 + Rr[_i]) * lda * EB + Cc[_i] * 2); } } while (0)
    GUnit cur, nxt; int ui = 0;
    if (!S.next(0, cur)) return;
    G_SETOFF(oA, cur);
    f32x4 acc[2][2][4][2];
#pragma unroll
    for (int a = 0; a < 2; ++a)
#pragma unroll
        for (int b = 0; b < 2; ++b)
#pragma unroll
            for (int m = 0; m < 4; ++m)
#pragma unroll
                for (int n = 0; n < 2; ++n) acc[a][b][m][n] = (f32x4){0.f, 0.f, 0.f, 0.f};
    bf16x8 At[4][2], B0[2][2], B1[2][2]; v8i_t At8[4], B08[2], B18[2]; const int scw_reg = SCW * 0x01010101, sca_reg = SCA * 0x01010101;
    const char* cA = cur.A; const char* cB = cur.B;
    G_STAGE(G_SB(0, 0), cB, voffB); G_STAGE(G_SB(0, 1), cB + hstepB, voffB); G_STAGE(G_SA(0, 0), cA, oA[0]); G_STAGE(G_SA(0, 1), cA, oA[1]);
    if (wr == 1) G_BAR;
    G_WAIT_V(2); G_BAR;
    G_STAGE(G_SB(1, 0), cB + kstep, voffB); G_STAGE(G_SA(1, 0), cA + kstep, oA[0]); G_STAGE(G_SB(1, 1), cB + hstepB + kstep, voffB);
    G_WAIT_V(6); G_BAR;
    for (;;) {
        const bool has_next = S.next(ui + 1, nxt);
        const char* nA = has_next ? nxt.A : cA; const char* nB = has_next ? nxt.B : cB;
        if constexpr (GATHER) {
            if (has_next) { G_SETOFF(oN, nxt); }
            else {
#pragma unroll
                for (int h = 0; h < 2; ++h)
#pragma unroll
                    for (int i = 0; i < 2; ++i) oN[h][i] = oA[h][i]; }
            asm volatile("" : "+v"(oN[0][0]), "+v"(oN[0][1]), "+v"(oN[1][0]), "+v"(oN[1][1]));
        }
        const int nt = VARNT ? __builtin_amdgcn_readfirstlane(cur.x1 & 255) : nt_;
        for (int t = 0; t < nt; t += 2) {
            const bool last = (t == nt - 2);
            const char* a1 = cA + (size_t)(t + 1) * kstep;
            const char* a2 = last ? nA : cA + (size_t)(t + 2) * kstep; const char* b2 = last ? nB : cB + (size_t)(t + 2) * kstep;
            const char* a3 = a2 + kstep; const char* b3 = b2 + kstep;
            G_LDB(B0, 0, 0); G_LDB(B1, 0, 1); G_SCHED; G_LDA(At, 0, 0); G_STAGE(G_SA(1, 1), a1, oA[1]);
            G_WAIT_V(8); G_WAIT_L(0); G_BAR; G_MMA(0, 0, At, B0); G_MMA(0, 1, At, B1); G_BAR; G_SCHED;
            if constexpr (GATHER) { if (last) {
#pragma unroll
                for (int h = 0; h < 2; ++h)
#pragma unroll
                    for (int i = 0; i < 2; ++i) oA[h][i] = oN[h][i]; } }
            G_LDA(At, 0, 1); G_STAGE(G_SB(0, 0), b2, voffB); G_STAGE(G_SB(0, 1), b2 + hstepB, voffB); G_STAGE(G_SA(0, 0), a2, oA[0]);
            G_WAIT_V(8); G_WAIT_L(0); G_BAR; G_MMA(1, 0, At, B0); G_MMA(1, 1, At, B1); G_BAR; G_SCHED;
            G_LDB(B0, 1, 0); G_LDB(B1, 1, 1); G_SCHED; G_LDA(At, 1, 0); G_STAGE(G_SA(0, 1), a2, oA[1]);
            G_WAIT_V(8); G_WAIT_L(0); G_BAR; G_MMA(0, 0, At, B0); G_MMA(0, 1, At, B1); G_BAR; G_SCHED;
            G_LDA(At, 1, 1); G_STAGE(G_SB(1, 0), b3, voffB); G_STAGE(G_SB(1, 1), b3 + hstepB, voffB); G_STAGE(G_SA(1, 0), a3, oA[0]);
            G_WAIT_V(8); G_WAIT_L(0); G_BAR; G_MMA(1, 0, At, B0); G_MMA(1, 1, At, B1); G_BAR; G_SCHED;
        }
        if constexpr (F8) asm volatile("s_nop 15\n\ts_nop 15" ::: "memory");
        if (wr == 0) G_BAR;
        E(acc, cur, wr, wc, fr, fq);
        if (!has_next) break;
#pragma unroll
        for (int a = 0; a < 2; ++a)
#pragma unroll
            for (int b = 0; b < 2; ++b)
#pragma unroll
                for (int m = 0; m < 4; ++m)
#pragma unroll
                    for (int n = 0; n < 2; ++n) acc[a][b][m][n] = (f32x4){0.f, 0.f, 0.f, 0.f};
        cur = nxt; cA = nA; cB = nB; ++ui;
        if (wr == 1) G_BAR;
    }
    G_WAIT_V(0);
    G_BAR;
#undef G_SA
#undef G_SB
#undef G_STAGE
#undef G_LDA
#undef G_LDB
#undef G_MMA
#undef G_LD8
#undef G_WAIT_V
#undef G_WAIT_L
#undef G_BAR
#undef G_SCHED
#undef G_SETOFF
}

typedef f32x4 Acc[2][2][4][2];

__device__ __forceinline__ float row_rstd(const float* ssqp, int row, int fq) {
    const f32x4* p = (const f32x4*)(ssqp + (size_t)row * 32 + 8 * fq); const f32x4 a = p[0], b = p[1];
    float s = (a.x + a.y) + (a.z + a.w) + (b.x + b.y) + (b.z + b.w);
    s += __shfl_xor(s, 16); s += __shfl_xor(s, 32);
    return __builtin_amdgcn_rsqf(s * (1.0f / 2048.0f) + EPS);
}

struct EpiInProj {
    static constexpr bool PERM = true;
    bf16_t* q; bf16_t* blkK; bf16_t* blkV; bf16_t* ks; bf16_t* vs; bf16_t* kw; bf16_t* vw; const float* rope;
    __device__ __forceinline__ void operator()(const Acc& acc, const GUnit& u, int wr, int wc, int fr, int fq) const {
        const int hh = wc >> 1, i0 = (wc & 1) * 32 + 8 * fq, H = 2 * u.pn + hh;
        const int seg = (H - 16) >> 2, gi = (H - 16) & 3;
        const bool isq = H < 16, rope_on = isq || seg == 2 || seg == 4;
        const float sc = isq ? QSCALE : 1.0f;
        const int row0 = u.pm * 256 + wr * 64 + fr;
        f32x4 csn[4];
        if (rope_on) { const f32x4* cs = (const f32x4*)(rope + ((size_t)row0 * 64 + i0) * 2);
#pragma unroll
            for (int p = 0; p < 4; ++p) csn[p] = cs[p]; }
#pragma unroll
        for (int ai = 0; ai < 2; ++ai)
#pragma unroll
            for (int m = 0; m < 4; ++m) {
                const int row = row0 + ai * 128 + m * 16;
                float x1[8], x2[8];
#pragma unroll
                for (int n = 0; n < 2; ++n)
#pragma unroll
                    for (int j = 0; j < 4; ++j) { x1[4 * n + j] = acc[ai][0][m][n][j]; x2[4 * n + j] = acc[ai][1][m][n][j]; }
                if (rope_on) {
                    f32x4 csv[4];
#pragma unroll
                    for (int p = 0; p < 4; ++p) csv[p] = csn[p];
                    if (ai * 4 + m < 7) { const int rown = row0 + ((ai * 4 + m + 1) >> 2) * 128 + ((ai * 4 + m + 1) & 3) * 16; const f32x4* cs = (const f32x4*)(rope + ((size_t)rown * 64 + i0) * 2);
#pragma unroll
                        for (int p = 0; p < 4; ++p) csn[p] = cs[p]; }
#pragma unroll
                    for (int p = 0; p < 4; ++p) { const f32x4 c = csv[p];
                        const float a0 = x1[2 * p], b0 = x2[2 * p], a1 = x1[2 * p + 1], b1 = x2[2 * p + 1];
                        x1[2 * p] = a0 * c.x - b0 * c.y; x2[2 * p] = b0 * c.x + a0 * c.y;
                        x1[2 * p + 1] = a1 * c.z - b1 * c.w; x2[2 * p + 1] = b1 * c.z + a1 * c.w; }
                }
                u32x4 w1, w2;
                w1.x = cvt_pk_bf16(x1[0] * sc, x1[1] * sc); w1.y = cvt_pk_bf16(x1[2] * sc, x1[3] * sc); w1.z = cvt_pk_bf16(x1[4] * sc, x1[5] * sc); w1.w = cvt_pk_bf16(x1[6] * sc, x1[7] * sc);
                w2.x = cvt_pk_bf16(x2[0] * sc, x2[1] * sc); w2.y = cvt_pk_bf16(x2[2] * sc, x2[3] * sc); w2.z = cvt_pk_bf16(x2[4] * sc, x2[5] * sc); w2.w = cvt_pk_bf16(x2[6] * sc, x2[7] * sc);
                if (isq) { bf16_t* d = q + (size_t)row * 2048 + H * 128 + i0; *(u32x4*)d = w1; *(u32x4*)(d + 64) = w2; }
                else if (seg < 2) {
                    unsigned char* blk = (unsigned char*)(seg == 0 ? blkK : blkV); const int c1 = row >> 4, i1 = row & 15;
                    u32x2 f1, f2; f1.x = pk4_fp8(4.f * x1[0], 4.f * x1[1], 4.f * x1[2], 4.f * x1[3]); f1.y = pk4_fp8(4.f * x1[4], 4.f * x1[5], 4.f * x1[6], 4.f * x1[7]);
                    f2.x = pk4_fp8(4.f * x2[0], 4.f * x2[1], 4.f * x2[2], 4.f * x2[3]); f2.y = pk4_fp8(4.f * x2[4], 4.f * x2[5], 4.f * x2[6], 4.f * x2[7]);
                    if (c1 < NCMP) { unsigned char* d = blk + (size_t)(c1 * 4 + gi) * 4096 + i1 * 128 + i0; *(u32x2*)d = f1; *(u32x2*)(d + 64) = f2; }
                    if (c1 >= 1) { unsigned char* d = blk + (size_t)((c1 - 1) * 4 + gi) * 4096 + (i1 + 16) * 128 + i0; *(u32x2*)d = f1; *(u32x2*)(d + 64) = f2; }
                } else {
                    bf16_t* buf = seg == 2 ? ks : seg == 3 ? vs : seg == 4 ? kw : vw;
                    bf16_t* d = buf + (size_t)row * 512 + gi * 128 + i0; *(u32x4*)d = w1; *(u32x4*)(d + 64) = w2;
                }
            }
    }
};
struct EpiCmp1 {
    static constexpr bool PERM = true;
    bf16_t* hid; const float* b1;
    __device__ __forceinline__ void operator()(const Acc& acc, const GUnit& u, int wr, int wc, int fr, int fq) const {
        const int row0 = u.pm * 256 + wr * 64 + fr, col0 = wc * 32 + 8 * fq; const float* bb = b1 + u.x0 * 16 * 256; bf16_t* hb = hid + (size_t)u.x0 * 4096 * 256;
#pragma unroll
        for (int bj = 0; bj < 2; ++bj) {
            f32x4 bv0 = (f32x4){0.f, 0.f, 0.f, 0.f}, bv1 = bv0;
#pragma unroll 2
            for (int kc = 0; kc < 16; ++kc) { bv0 += *(const f32x4*)(bb + kc * 256 + bj * 128 + col0); bv1 += *(const f32x4*)(bb + kc * 256 + bj * 128 + col0 + 4); }
#pragma unroll
            for (int ai = 0; ai < 2; ++ai)
#pragma unroll
                for (int m = 0; m < 4; ++m) { const int row = row0 + ai * 128 + m * 16;
                    const f32x4 v0 = acc[ai][bj][m][0] + bv0, v1 = acc[ai][bj][m][1] + bv1; u32x4 w;
                    w.x = cvt_pk_bf16(gelu_tanh(v0.x), gelu_tanh(v0.y)); w.y = cvt_pk_bf16(gelu_tanh(v0.z), gelu_tanh(v0.w));
                    w.z = cvt_pk_bf16(gelu_tanh(v1.x), gelu_tanh(v1.y)); w.w = cvt_pk_bf16(gelu_tanh(v1.z), gelu_tanh(v1.w));
                    *(u32x4*)(hb + (size_t)row * 256 + bj * 128 + col0) = w; }
        }
    }
};
struct EpiCmp2 {
    static constexpr bool PERM = true;
    bf16_t* kc; bf16_t* vct; const float* rope;
    __device__ __forceinline__ void operator()(const Acc& acc, const GUnit& u, int wr, int wc, int fr, int fq) const {
        if (wc >= 2) return;
        const int i0 = wc * 32 + 8 * fq, row0 = u.pm * 256 + wr * 64 + fr;
#pragma unroll
        for (int ai = 0; ai < 2; ++ai)
#pragma unroll
            for (int m = 0; m < 4; ++m) {
                const int row = row0 + ai * 128 + m * 16, c = row >> 2, g = row & 3; const bool ok = c < NCMP;
                float x1[8], x2[8];
#pragma unroll
                for (int n = 0; n < 2; ++n)
#pragma unroll
                    for (int j = 0; j < 4; ++j) { x1[4 * n + j] = ok ? acc[ai][0][m][n][j] : 0.f; x2[4 * n + j] = ok ? acc[ai][1][m][n][j] : 0.f; }
                if (u.x0 == 0) {
                    if (ok) { const f32x4* cs = (const f32x4*)(rope + ((size_t)(16 * c + 31) * 64 + i0) * 2);
#pragma unroll
                        for (int p = 0; p < 4; ++p) { const f32x4 cc = cs[p];
                            const float a0 = x1[2 * p], b0 = x2[2 * p], a1 = x1[2 * p + 1], b1 = x2[2 * p + 1];
                            x1[2 * p] = a0 * cc.x - b0 * cc.y; x2[2 * p] = b0 * cc.x + a0 * cc.y;
                            x1[2 * p + 1] = a1 * cc.z - b1 * cc.w; x2[2 * p + 1] = b1 * cc.z + a1 * cc.w; } }
                    u32x4 w1, w2;
                    w1.x = cvt_pk_bf16(x1[0], x1[1]); w1.y = cvt_pk_bf16(x1[2], x1[3]); w1.z = cvt_pk_bf16(x1[4], x1[5]); w1.w = cvt_pk_bf16(x1[6], x1[7]);
                    w2.x = cvt_pk_bf16(x2[0], x2[1]); w2.y = cvt_pk_bf16(x2[2], x2[3]); w2.z = cvt_pk_bf16(x2[4], x2[5]); w2.w = cvt_pk_bf16(x2[6], x2[7]);
                    bf16_t* d = kc + ((size_t)g * 1024 + c) * 128 + i0; *(u32x4*)d = w1; *(u32x4*)(d + 64) = w2;
                } else {
#pragma unroll
                    for (int j = 0; j < 8; ++j) { vct[((size_t)g * 128 + i0 + j) * 1024 + c] = f2bf(x1[j]); vct[((size_t)g * 128 + 64 + i0 + j) * 1024 + c] = f2bf(x2[j]); }
                }
            }
    }
};
struct EpiGates {
    static constexpr bool PERM = false;
    float* gates; const float* gb;
    __device__ __forceinline__ void operator()(const Acc& acc, const GUnit& u, int wr, int wc, int fr, int fq) const {
        if (wc >= 2) return;
        const int row0 = u.pm * 256 + wr * 64 + fr;
#pragma unroll
        for (int n = 0; n < 2; ++n) {
            if (wc == 1 && n == 1) continue;
            const int c = 32 * wc + 16 * n + 4 * fq; const f32x4 bv = *(const f32x4*)(gb + c);
#pragma unroll
            for (int ai = 0; ai < 2; ++ai)
#pragma unroll
                for (int m = 0; m < 4; ++m) { const int row = row0 + ai * 128 + m * 16; const f32x4 v = acc[ai][0][m][n] + bv;
                    *(f32x4*)(gates + (size_t)row * 48 + c) = (f32x4){sigmoidf_(v.x), sigmoidf_(v.y), sigmoidf_(v.z), sigmoidf_(v.w)}; }
        }
    }
};
struct EpiMemKV {
    static constexpr bool PERM = true;
    bf16_t* km; bf16_t* vmt;
    __device__ __forceinline__ void operator()(const Acc& acc, const GUnit& u, int wr, int wc, int fr, int fq) const {
        const int row0 = wr * 64 + fr, l = u.x0;
#pragma unroll
        for (int ai = 0; ai < 2; ++ai)
#pragma unroll
            for (int m = 0; m < 4; ++m) { const int row = row0 + ai * 128 + m * 16;
#pragma unroll
                for (int bj = 0; bj < 2; ++bj) { const f32x4 v0 = acc[ai][bj][m][0], v1 = acc[ai][bj][m][1];
                    if (u.pn < 2) { u32x4 w; w.x = cvt_pk_bf16(v0.x, v0.y); w.y = cvt_pk_bf16(v0.z, v0.w); w.z = cvt_pk_bf16(v1.x, v1.y); w.w = cvt_pk_bf16(v1.z, v1.w);
                        *(u32x4*)(km + ((size_t)l * 256 + row) * 512 + u.pn * 256 + bj * 128 + wc * 32 + 8 * fq) = w; }
                    else { const int d0 = (u.pn - 2) * 256 + bj * 128 + wc * 32 + 8 * fq; bf16_t* vb = vmt + (size_t)l * 512 * 256;
#pragma unroll
                        for (int j = 0; j < 4; ++j) { vb[(size_t)(d0 + j) * 256 + row] = f2bf(v0[j]); vb[(size_t)(d0 + 4 + j) * 256 + row] = f2bf(v1[j]); } }
                }
            }
    }
};
template <bool HAS_AP, bool HAS_SSQ, bool POOL, bool AP8 = false>
struct EpiRes {
    static constexpr bool PERM = false;
    const float* hin; float* hout; bf16_t* ap; const float* gain; float* ssqp; const float* bias; const float* scale;
    __device__ __forceinline__ void operator()(const Acc& acc, const GUnit& u, int wr, int wc, int fr, int fq) const {
        const int row0 = u.pm * 256 + wr * 64 + fr, col0 = u.pn * 256 + wc * 32 + 4 * fq;
        f32x4 gv[2][2], bv[2][2], sv[2][2];
#pragma unroll
        for (int bj = 0; bj < 2; ++bj)
#pragma unroll
            for (int n = 0; n < 2; ++n) { const int c = col0 + bj * 128 + n * 16;
                if (HAS_AP) gv[bj][n] = *(const f32x4*)(gain + c);
                if (POOL) { bv[bj][n] = *(const f32x4*)(bias + c); sv[bj][n] = *(const f32x4*)(scale + c); } }
        f32x4 hnx[2][2];
#pragma unroll
        for (int bj = 0; bj < 2; ++bj)
#pragma unroll
            for (int n = 0; n < 2; ++n) hnx[bj][n] = *(const f32x4*)(hin + (size_t)row0 * D + col0 + bj * 128 + n * 16);
#pragma unroll
        for (int ai = 0; ai < 2; ++ai)
#pragma unroll
            for (int m = 0; m < 4; ++m) { const int row = row0 + ai * 128 + m * 16; const size_t off = (size_t)row * D + col0; float ss = 0.f;
                f32x4 hcur[2][2];
#pragma unroll
                for (int bj = 0; bj < 2; ++bj)
#pragma unroll
                    for (int n = 0; n < 2; ++n) hcur[bj][n] = hnx[bj][n];
                if (ai * 4 + m < 7) { const int rown = row0 + ((ai * 4 + m + 1) >> 2) * 128 + ((ai * 4 + m + 1) & 3) * 16;
#pragma unroll
                    for (int bj = 0; bj < 2; ++bj)
#pragma unroll
                        for (int n = 0; n < 2; ++n) hnx[bj][n] = *(const f32x4*)(hin + (size_t)rown * D + col0 + bj * 128 + n * 16); }
#pragma unroll
                for (int bj = 0; bj < 2; ++bj)
#pragma unroll
                    for (int n = 0; n < 2; ++n) { const f32x4 hv = hcur[bj][n]; f32x4 v = acc[ai][bj][m][n];
                        if (POOL) v = (v + bv[bj][n]) * sv[bj][n];
                        const f32x4 o = hv + v; *(f32x4*)(hout + off + bj * 128 + n * 16) = o;
                        if (HAS_SSQ) ss += (o.x * o.x + o.y * o.y) + (o.z * o.z + o.w * o.w);
                        if (HAS_AP) { const f32x4 z = o * gv[bj][n];
                            if (AP8) *(unsigned*)((unsigned char*)ap + off + bj * 128 + n * 16) = pk4_fp8(4.f * z.x, 4.f * z.y, 4.f * z.z, 4.f * z.w);
                            else { u32x2 w; w.x = cvt_pk_bf16(z.x, z.y); w.y = cvt_pk_bf16(z.z, z.w); *(u32x2*)(ap + off + bj * 128 + n * 16) = w; } } }
                if (HAS_SSQ) { ss += __shfl_xor(ss, 16); ss += __shfl_xor(ss, 32); if (fq == 0) ssqp[(size_t)row * 32 + u.pn * 4 + wc] = ss; }
            }
    }
};
struct EpiMemQ {
    static constexpr bool PERM = true;
    bf16_t* qm; const float* ssqp;
    __device__ __forceinline__ void operator()(const Acc& acc, const GUnit& u, int wr, int wc, int fr, int fq) const {
        const int row0 = u.pm * 256 + wr * 64 + fr, col0 = u.pn * 256 + wc * 32 + 8 * fq;
        float rr[2][4];
#pragma unroll
        for (int ai = 0; ai < 2; ++ai)
#pragma unroll
            for (int m = 0; m < 4; ++m) rr[ai][m] = row_rstd(ssqp, row0 + ai * 128 + m * 16, fq) * QSCALE;
#pragma unroll
        for (int ai = 0; ai < 2; ++ai)
#pragma unroll
            for (int m = 0; m < 4; ++m) { const int row = row0 + ai * 128 + m * 16; const float r = rr[ai][m];
#pragma unroll
                for (int bj = 0; bj < 2; ++bj) { const f32x4 v0 = acc[ai][bj][m][0] * r, v1 = acc[ai][bj][m][1] * r; u32x4 w;
                    w.x = cvt_pk_bf16(v0.x, v0.y); w.y = cvt_pk_bf16(v0.z, v0.w); w.z = cvt_pk_bf16(v1.x, v1.y); w.w = cvt_pk_bf16(v1.z, v1.w);
                    *(u32x4*)(qm + (size_t)row * 512 + col0 + bj * 128) = w; } }
    }
};
template <bool RSTD, bool F8OUT = false>
struct EpiSwiglu {
    static constexpr bool PERM = true;
    bf16_t* act; const float* ssqp;
    __device__ __forceinline__ void operator()(const Acc& acc, const GUnit& u, int wr, int wc, int fr, int fq) const {
        const int row0 = u.pm * 256 + wr * 64 + fr, col0 = u.pn * 128 + wc * 32 + 8 * fq;
        float rr[2][4];
#pragma unroll
        for (int ai = 0; ai < 2; ++ai)
#pragma unroll
            for (int m = 0; m < 4; ++m) rr[ai][m] = RSTD ? row_rstd(ssqp, row0 + ai * 128 + m * 16, fq) : 1.f;
#pragma unroll
        for (int ai = 0; ai < 2; ++ai)
#pragma unroll
            for (int m = 0; m < 4; ++m) { const int row = row0 + ai * 128 + m * 16; const float r = rr[ai][m];
                float o[8];
#pragma unroll
                for (int n = 0; n < 2; ++n)
#pragma unroll
                    for (int j = 0; j < 4; ++j) { const float g = acc[ai][0][m][n][j] * r, uu = acc[ai][1][m][n][j] * r; o[4 * n + j] = g * sigmoidf_(g) * uu; }
                if constexpr (F8OUT) { u32x2 w; w.x = pk4_fp8(16.f * o[0], 16.f * o[1], 16.f * o[2], 16.f * o[3]); w.y = pk4_fp8(16.f * o[4], 16.f * o[5], 16.f * o[6], 16.f * o[7]);
                    *(u32x2*)((unsigned char*)act + (size_t)row * DFF + col0) = w; }
                else { u32x4 w; w.x = cvt_pk_bf16(o[0], o[1]); w.y = cvt_pk_bf16(o[2], o[3]); w.z = cvt_pk_bf16(o[4], o[5]); w.w = cvt_pk_bf16(o[6], o[7]);
                    *(u32x4*)(act + (size_t)row * DFF + col0) = w; } }
    }
};
struct EpiMoeDown {
    static constexpr bool PERM = true;
    bf16_t* ybuf; const int* pair; const float* gate; float* part; int tail_row0, part_rows;
    __device__ __forceinline__ void operator()(const Acc& acc, const GUnit& u, int wr, int wc, int fr, int fq) const {
        const int row0 = u.pm * 256 + wr * 64 + fr, col0 = u.pn * 256 + wc * 32 + 8 * fq;
        int prs[2][4]; float gs[2][4];
#pragma unroll
        for (int ai = 0; ai < 2; ++ai)
#pragma unroll
            for (int m = 0; m < 4; ++m) { prs[ai][m] = pair[row0 + ai * 128 + m * 16]; gs[ai][m] = gate[row0 + ai * 128 + m * 16]; }
        const int ks1 = __builtin_amdgcn_readfirstlane(u.x1 >> 8);
        if (ks1) {
            float* pb = part + ((size_t)(ks1 - 1) * part_rows + (row0 - tail_row0)) * D + col0;
#pragma unroll
            for (int ai = 0; ai < 2; ++ai)
#pragma unroll
                for (int m = 0; m < 4; ++m) { const float g = gs[ai][m];
                    if (prs[ai][m] >= 0) {
#pragma unroll
                        for (int bj = 0; bj < 2; ++bj) { float* q = pb + (size_t)(ai * 128 + m * 16) * D + bj * 128; *(f32x4*)q = acc[ai][bj][m][0] * g; *(f32x4*)(q + 4) = acc[ai][bj][m][1] * g; } } }
            return;
        }
#pragma unroll
        for (int ai = 0; ai < 2; ++ai)
#pragma unroll
            for (int m = 0; m < 4; ++m) { const int pr = prs[ai][m]; const float g = gs[ai][m];
                if (pr >= 0) {
#pragma unroll
                    for (int bj = 0; bj < 2; ++bj) { const f32x4 v0 = acc[ai][bj][m][0] * g, v1 = acc[ai][bj][m][1] * g; u32x4 w;
                        w.x = cvt_pk_bf16(v0.x, v0.y); w.y = cvt_pk_bf16(v0.z, v0.w); w.z = cvt_pk_bf16(v1.x, v1.y); w.w = cvt_pk_bf16(v1.z, v1.w);
                        *(u32x4*)(ybuf + (size_t)pr * D + col0 + bj * 128) = w; } } }
    }
};
}

struct CT { bf16x8 q[4]; f32x4 o[8]; float m, l; };
__device__ __forceinline__ f32x4 mfma16(bf16x8 a, bf16x8 b, f32x4 c) { return __builtin_amdgcn_mfma_f32_16x16x32_bf16(a, b, c, 0, 0, 0); }
__device__ __forceinline__ void ct_init(CT& c) {
#pragma unroll
    for (int d = 0; d < 8; ++d) c.o[d] = (f32x4){0.f, 0.f, 0.f, 0.f};
    c.m = NEGF; c.l = 0.f;
}
template <int NCT>
__device__ __forceinline__ void att_scores(const CT (&ct)[NCT], const bf16_t* Kp, int kstr, int lane, f32x4 (&s)[NCT][2]) {
    const int i = lane & 15, g = lane >> 4;
    const bf16_t* k0 = Kp + (size_t)(8 * (i >> 2) + (i & 3)) * kstr + 8 * g;
#pragma unroll
    for (int c = 0; c < NCT; ++c) { s[c][0] = (f32x4){0.f, 0.f, 0.f, 0.f}; s[c][1] = (f32x4){0.f, 0.f, 0.f, 0.f}; }
#pragma unroll
    for (int ks = 0; ks < 4; ++ks) {
        const bf16x8 ka = *(const bf16x8*)(k0 + 32 * ks), kb = *(const bf16x8*)(k0 + (size_t)4 * kstr + 32 * ks);
#pragma unroll
        for (int c = 0; c < NCT; ++c) { s[c][0] = mfma16(ka, ct[c].q[ks], s[c][0]); s[c][1] = mfma16(kb, ct[c].q[ks], s[c][1]); }
    }
}
__device__ __forceinline__ bf16x8 att_softmax(CT& c, const f32x4 (&s)[2], const bool (&valid)[8], bool do_pv) {
    float sv[8];
#pragma unroll
    for (int e = 0; e < 8; ++e) sv[e] = valid[e] ? s[e >> 2][e & 3] : NEGF;
    float mx = fmaxf(fmaxf(fmaxf(sv[0], sv[1]), fmaxf(sv[2], sv[3])), fmaxf(fmaxf(sv[4], sv[5]), fmaxf(sv[6], sv[7])));
    mx = fmaxf(mx, __shfl_xor(mx, 16)); mx = fmaxf(mx, __shfl_xor(mx, 32));
    const float mnew = fmaxf(c.m, mx), alpha = __builtin_amdgcn_exp2f((c.m - mnew) * L2E);
    float p[8], ps = 0.f;
#pragma unroll
    for (int e = 0; e < 8; ++e) { p[e] = valid[e] ? __builtin_amdgcn_exp2f((sv[e] - mnew) * L2E) : 0.f; ps += p[e]; }
    c.l = c.l * alpha + ps; c.m = mnew;
    if (do_pv) {
#pragma unroll
        for (int d = 0; d < 8; ++d) c.o[d] = c.o[d] * alpha;
    }
    u32x4 w; w.x = cvt_pk_bf16(p[0], p[1]); w.y = cvt_pk_bf16(p[2], p[3]); w.z = cvt_pk_bf16(p[4], p[5]); w.w = cvt_pk_bf16(p[6], p[7]);
    return __builtin_bit_cast(bf16x8, w);
}
template <int NCT>
__device__ __forceinline__ void att_pv(CT (&ct)[NCT], const bf16x8 (&pb)[NCT], const bf16_t* Vp, int vstr, int lane) {
    const int i = lane & 15, g = lane >> 4;
    const bf16_t* v0 = Vp + (size_t)i * vstr + 8 * g;
#pragma unroll
    for (int d = 0; d < 8; ++d) { const bf16x8 vf = *(const bf16x8*)(v0 + (size_t)(16 * d) * vstr);
#pragma unroll
        for (int c = 0; c < NCT; ++c) ct[c].o[d] = mfma16(vf, pb[c], ct[c].o[d]); }
}
__device__ __forceinline__ float ct_lsum(const CT& c) { float l = c.l; l += __shfl_xor(l, 16); l += __shfl_xor(l, 32); return l; }

struct Args { const float* in[30]; float* out; unsigned char* ws; int ph_lo, ph_hi; };

struct TrDesc { const float* src; unsigned char* dst; int ldw, ldt, nvalid; float scale; };
__device__ __forceinline__ void tr_load(const TrDesc& d, float (&v)[32], int lane) {
    const int nn = lane & 31, kh = lane >> 5; const bool ok = nn < d.nvalid; const float* W = d.src + (size_t)kh * d.ldw + (ok ? nn : 0);
#pragma unroll
    for (int i = 0; i < 32; ++i) v[i] = W[(size_t)(2 * i) * d.ldw];
}
__device__ __forceinline__ void tr_store(const TrDesc& d, const float (&v)[32], LAS float* scr, int lane) {
    const int nn = lane & 31, kh = lane >> 5; const bool ok = nn < d.nvalid;
#pragma unroll
    for (int i = 0; i < 32; ++i) scr[(2 * i + kh) * 33 + nn] = ok ? v[i] : 0.f;
    LDS_WAIT(); asm volatile("" ::: "memory");
    if (d.scale != 0.f) {
        const int c = lane & 3; const float sc = d.scale;
#pragma unroll
        for (int j = 0; j < 2; ++j) { const int n = (lane >> 2) + 16 * j; const LAS float* s = scr + (16 * c) * 33 + n;
            u32x4 o; o.x = pk4_fp8(sc * s[0 * 33], sc * s[1 * 33], sc * s[2 * 33], sc * s[3 * 33]); o.y = pk4_fp8(sc * s[4 * 33], sc * s[5 * 33], sc * s[6 * 33], sc * s[7 * 33]);
            o.z = pk4_fp8(sc * s[8 * 33], sc * s[9 * 33], sc * s[10 * 33], sc * s[11 * 33]); o.w = pk4_fp8(sc * s[12 * 33], sc * s[13 * 33], sc * s[14 * 33], sc * s[15 * 33]);
            *(u32x4*)(d.dst + (size_t)n * d.ldt + 16 * c) = o; }
    } else {
        const int c = lane & 7; bf16_t* WT = (bf16_t*)d.dst;
#pragma unroll
        for (int j = 0; j < 4; ++j) { const int n = (lane >> 3) + 8 * j; const LAS float* s = scr + (8 * c) * 33 + n;
            u32x4 o; o.x = cvt_pk_bf16(s[0 * 33], s[1 * 33]); o.y = cvt_pk_bf16(s[2 * 33], s[3 * 33]); o.z = cvt_pk_bf16(s[4 * 33], s[5 * 33]); o.w = cvt_pk_bf16(s[6 * 33], s[7 * 33]);
            *(u32x4*)(WT + (size_t)n * d.ldt + 8 * c) = o; }
    }
    LDS_WAIT(); asm volatile("" ::: "memory");
}
__device__ __forceinline__ int map_in(int n0) { const int H = n0 >> 7, d = n0 & 127; return 256 * (H >> 1) + 128 * (d >> 6) + 64 * (H & 1) + (d & 63); }
__device__ __forceinline__ int map_gu(int c, int up) { return 256 * (c >> 7) + 128 * up + (c & 127); }
__device__ __forceinline__ int map_c2(int d) { return 128 * (d >> 6) + (d & 63); }
__device__ __forceinline__ void rms_row_bf16(const float* xrow, const float* gain, bf16_t* orow, int lane) {
    const f32x4* xr = (const f32x4*)xrow + lane; f32x4 v[8]; float s = 0.f;
#pragma unroll
    for (int j = 0; j < 8; ++j) { v[j] = xr[64 * j]; s += (v[j].x * v[j].x + v[j].y * v[j].y) + (v[j].z * v[j].z + v[j].w * v[j].w); }
    const float r = __builtin_amdgcn_rsqf(wave_sum(s) * (1.0f / D) + EPS);
    const f32x4* gr = (const f32x4*)gain + lane; u32x2* o8 = (u32x2*)orow + lane;
#pragma unroll
    for (int j = 0; j < 8; ++j) { const f32x4 g = gr[64 * j]; const f32x4 z = (v[j] * r) * g; u32x2 w; w.x = cvt_pk_bf16(z.x, z.y); w.y = cvt_pk_bf16(z.z, z.w); o8[64 * j] = w; }
}
__device__ __forceinline__ void rms_row_f8(const float* xrow, const float* gain, unsigned char* orow, int lane) {
    const f32x4* xr = (const f32x4*)xrow + lane; f32x4 v[8]; float s = 0.f;
#pragma unroll
    for (int j = 0; j < 8; ++j) { v[j] = xr[64 * j]; s += (v[j].x * v[j].x + v[j].y * v[j].y) + (v[j].z * v[j].z + v[j].w * v[j].w); }
    const float r = __builtin_amdgcn_rsqf(wave_sum(s) * (1.0f / D) + EPS) * 4.0f;
    const f32x4* gr = (const f32x4*)gain + lane; unsigned* o4 = (unsigned*)orow + lane;
#pragma unroll
    for (int j = 0; j < 8; ++j) { const f32x4 g = gr[64 * j]; const f32x4 z = (v[j] * r) * g; o4[64 * j] = pk4_fp8(z.x, z.y, z.z, z.w); }
}
__device__ __forceinline__ void tr_decode(const Args& a, int it, TrDesc& dd) {
    unsigned char* ws = a.ws;
    constexpr int I_MOE = 45056, I_F = 5632, I_IN = 5120, I_ING = 64, I_OUT = 2048, I_M4 = 1024, I_PW = 512, I_C1 = 512, I_C2 = 16;
        const float* src; int ldw, nvalid = 32, ldt; unsigned char* dst; float scale = 0.f;
        int r = it;
        if (r < 3 * I_MOE) { const int which = r / I_MOE, rr = r % I_MOE, e = rr / 5632, q = rr % 5632;
            if (which < 2) { const int kb = q / 176, nb = q % 176;
                src = a.in[27 + which] + (size_t)e * 2048 * 5632 + (size_t)(kb * 64) * 5632 + nb * 32; ldw = 5632; scale = 64.f; dst = ws + WS_MGU + ((size_t)e * 11264 + map_gu(nb * 32, which)) * 2048 + kb * 64; ldt = 2048; }
            else { const int kb = q / 64, nb = q % 64;
                src = a.in[29] + (size_t)e * 5632 * 2048 + (size_t)(kb * 64) * 2048 + nb * 32; ldw = 2048; scale = 128.f; dst = ws + WS_MD + ((size_t)e * 2048 + nb * 32) * 5632 + kb * 64; ldt = 5632; } }
        else if ((r -= 3 * I_MOE) < 2 * I_F) { const int which = r / I_F, q = r % I_F, kb = q / 176, nb = q % 176;
            src = a.in[23 + which] + (size_t)(kb * 64) * 5632 + nb * 32; ldw = 5632; dst = ws + WS_FGU + ((size_t)map_gu(nb * 32, which) * 2048 + kb * 64) * 2; ldt = 2048; }
        else if ((r -= 2 * I_F) < I_F) { const int kb = r / 64, nb = r % 64;
            src = a.in[25] + (size_t)(kb * 64) * 2048 + nb * 32; ldw = 2048; scale = 128.f; dst = ws + WS_FD + (size_t)(nb * 32) * 5632 + kb * 64; ldt = 5632; }
        else if ((r -= I_F) < I_IN) { const int kb = r / 160, nb = r % 160;
            src = a.in[7] + (size_t)(kb * 64) * NSA_W + nb * 32; ldw = NSA_W; scale = 64.f; dst = ws + WS_WIN + (size_t)map_in(nb * 32) * 2048 + kb * 64; ldt = 2048; }
        else if ((r -= I_IN) < I_ING) { const int kb = r / 2, nb = r % 2;
            src = a.in[7] + (size_t)(kb * 64) * NSA_W + 5120 + nb * 32; ldw = NSA_W; nvalid = 48 - 32 * nb; scale = 64.f; dst = ws + WS_WG + (size_t)(nb * 32) * 2048 + kb * 64; ldt = 2048; }
        else if ((r -= I_ING) < I_OUT) { const int kb = r / 64, nb = r % 64;
            src = a.in[15] + (size_t)(kb * 64) * 2048 + nb * 32; ldw = 2048; scale = 64.f; dst = ws + WS_WOUT + (size_t)(nb * 32) * 2048 + kb * 64; ldt = 2048; }
        else if ((r -= I_OUT) < I_M4) { const int l = r / 512, q = r % 512, kb = q / 16, nb = q % 16;
            src = a.in[19] + (size_t)l * 2048 * 512 + (size_t)(kb * 64) * 512 + nb * 32; ldw = 512; scale = 64.f; dst = ws + WS_MWQ + ((size_t)l * 512 + nb * 32) * 2048 + kb * 64; ldt = 2048; }
        else if ((r -= I_M4) < 2 * I_M4) { const int which = r / I_M4, rr = r % I_M4, l = rr / 512, q = rr % 512, kb = q / 16, nb = q % 16;
            src = a.in[20 + which] + (size_t)l * 2048 * 512 + (size_t)(kb * 64) * 512 + nb * 32; ldw = 512; dst = ws + WS_MWKV + (((size_t)l * 1024 + which * 512 + nb * 32) * 2048 + kb * 64) * 2; ldt = 2048; }
        else if ((r -= 2 * I_M4) < I_M4) { const int l = r / 512, q = r % 512, kb = q / 64, nb = q % 64;
            src = a.in[22] + (size_t)l * 512 * 2048 + (size_t)(kb * 64) * 2048 + nb * 32; ldw = 2048; dst = ws + WS_MWO + (((size_t)l * 2048 + nb * 32) * 512 + kb * 64) * 2; ldt = 512; }
        else if ((r -= I_M4) < I_PW) { const int g = r / 128, q = r % 128, kb = q / 16, nb = q % 16;
            src = a.in[16] + (size_t)g * 512 * 512 + (size_t)(kb * 64) * 512 + nb * 32; ldw = 512; dst = ws + WS_PW + (((size_t)g * 512 + nb * 32) * 512 + kb * 64) * 2; ldt = 512; }
        else if ((r -= I_PW) < 2 * I_C1) { const int kv = r / I_C1, q = r % I_C1, kb = q / 8, nb = q % 8;
            src = a.in[kv ? 13 : 11] + (size_t)(kb * 64) * 256 + nb * 32; ldw = 256; scale = 64.f; dst = ws + WS_C1 + ((size_t)kv * 256 + nb * 32) * 4096 + kb * 64; ldt = 4096; }
        else { r -= 2 * I_C1; const int kv = r / I_C2, q = r % I_C2, kb = q / 4, nb = q % 4;
            src = a.in[kv ? 14 : 12] + (size_t)(kb * 64) * 128 + nb * 32; ldw = 128; dst = ws + WS_C2 + (((size_t)kv * 256 + map_c2(nb * 32)) * 256 + kb * 64) * 2; ldt = 256; }
        dd.src = src; dd.dst = dst; dd.ldw = ldw; dd.ldt = ldt; dd.nvalid = nvalid; dd.scale = scale;
}
constexpr int TRN_MOE = 90112 + 29056;
constexpr int TRN_TOTAL = TRN_MOE + 16896 + 2048 + 1024 + 1024 + 512, TRP0_TOTAL = 5184 + 2048 + 1056;
__device__ __forceinline__ int tr_map_nsa(int n) { n -= TRN_MOE; return n < 0 ? n + TRN_MOE : n < 16896 ? 135168 + n : n < 18944 ? 157248 + (n - 16896) : n < 19968 ? 159296 + (n - 18944) : n < 20992 ? 162368 + (n - 19968) : 163392 + (n - 20992); }
__device__ __forceinline__ int tr_map_p0(int v) { return v < 5184 ? 152064 + v : v < 7232 ? 160320 + (v - 5184) : 163904 + (v - 7232); }
template <bool NSAMAP>
__device__ __forceinline__ void tr_run(const Args& a, LAS float* scr, int n0, int n1, int w, int nw, int lane) {
    int it = n0 + w; TrDesc dc; float vc[32];
    dc.src = nullptr; dc.dst = nullptr; dc.ldw = 0; dc.ldt = 0; dc.nvalid = 0; dc.scale = 0.f;
    if (it < n1) { tr_decode(a, NSAMAP ? tr_map_nsa(it) : tr_map_p0(it), dc); tr_load(dc, vc, lane); }
    while (it < n1) {
        const int itn = it + nw; TrDesc dn = dc; float vn[32];
        if (itn < n1) { tr_decode(a, NSAMAP ? tr_map_nsa(itn) : tr_map_p0(itn), dn); tr_load(dn, vn, lane); }
        else {
#pragma unroll
            for (int i = 0; i < 32; ++i) vn[i] = 0.f; }
        tr_store(dc, vc, scr, lane);
        dc = dn;
#pragma unroll
        for (int i = 0; i < 32; ++i) vc[i] = vn[i];
        it = itn;
    }
}
template <int NB>
__device__ __forceinline__ void tr_burst_nsa(const Args& a, LAS float* scr, int n0, int n1, int w, int nw, int lane) {
    for (int base = n0 + w; base < n1; base += NB * nw) {
        TrDesc d[NB]; float v[NB][32];
#pragma unroll
        for (int k = 0; k < NB; ++k) { const int it = base + k * nw; if (it < n1) { tr_decode(a, tr_map_nsa(it), d[k]); tr_load(d[k], v[k], lane); } }
#pragma unroll
        for (int k = 0; k < NB; ++k) { const int it = base + k * nw; if (it < n1) tr_store(d[k], v[k], scr, lane); }
    }
}
constexpr int TR_NDEF = 45056 - 29056, TR_D0 = 3 * 45056 - TR_NDEF, TR_D1 = TR_D0, TR_D2 = TR_D1 + 8000, TR_D3 = 3 * 45056;
constexpr int TR_PER_UNIT = 144;
static_assert(1024 * TR_PER_UNIT >= TRN_TOTAL, "deferred ranges");
__device__ __forceinline__ void tr_moe_range(const Args& a, LAS float* scr, int r0, int r1, int w, int nw, int lane) {
    auto decode = [&](int r, TrDesc& dd) { const int which = r / 45056, rr = r % 45056, e = rr / 5632, q = rr % 5632; dd.nvalid = 32;
        if (which < 2) { const int kb = q / 176, nb = q % 176;
            dd.src = a.in[27 + which] + (size_t)e * 2048 * 5632 + (size_t)(kb * 64) * 5632 + nb * 32; dd.ldw = 5632; dd.scale = 64.f; dd.dst = a.ws + WS_MGU + ((size_t)e * 11264 + map_gu(nb * 32, which)) * 2048 + kb * 64; dd.ldt = 2048; }
        else { const int kb = q / 64, nb = q % 64;
            dd.src = a.in[29] + (size_t)e * 5632 * 2048 + (size_t)(kb * 64) * 2048 + nb * 32; dd.ldw = 2048; dd.scale = 128.f; dd.dst = a.ws + WS_MD + ((size_t)e * 2048 + nb * 32) * 5632 + kb * 64; dd.ldt = 5632; } };
    int it = r0 + w; TrDesc dc; float vc[32];
    if (it < r1) { decode(it, dc); tr_load(dc, vc, lane); }
    while (it < r1) {
        const int itn = it + nw; TrDesc dn = dc; float vn[32];
        if (itn < r1) { decode(itn, dn); tr_load(dn, vn, lane); }
        else {
#pragma unroll
            for (int i = 0; i < 32; ++i) vn[i] = 0.f; }
        tr_store(dc, vc, scr, lane);
        dc = dn;
#pragma unroll
        for (int i = 0; i < 32; ++i) vc[i] = vn[i];
        it = itn;
    }
}
__device__ __forceinline__ void phase_prologue(const Args& a, LAS unsigned char* lds, int gw, int ngw, int wave, int lane) {
    unsigned char* ws = a.ws;
    LAS float* scr = (LAS float*)(lds + wave * 8448);
    constexpr int I_MOE = 45056, I_F = 5632, I_IN = 5120, I_ING = 64, I_OUT = 2048, I_M4 = 1024, I_PW = 512, I_C1 = 512, I_C2 = 16;
    constexpr int NITEMS = 3 * I_MOE + 3 * I_F + I_IN + I_ING + I_OUT + 4 * I_M4 + I_PW + 2 * I_C1 + 2 * I_C2;
    auto decode = [&](int it, TrDesc& dd) { tr_decode(a, it, dd); };
    tr_run<false>(a, scr, 0, TRP0_TOTAL, gw, ngw, lane);
    for (int m = gw; m < T; m += ngw) rms_row_f8(a.in[0] + (size_t)m * D, a.in[2], ws + WS_APA + (size_t)m * D, lane);
    for (int m = gw; m < 2 * MEML; m += ngw) { const int l = m >> 8, r = m & 255; rms_row_bf16(a.in[1] + (size_t)r * D, a.in[4] + l * D, (bf16_t*)(ws + WS_MEMN) + (size_t)m * D, lane); }
    { float* rope = (float*)(ws + WS_ROPE);
      for (int idx = gw * 64 + lane; idx < T * 64; idx += ngw * 64) { const int pos = idx >> 6, i = idx & 63;
          const float inv = (float)exp(-(double)i * (9.210340371976184 / 64.0)); const float ang = (float)pos * inv; double sn, cs; sincos((double)ang, &sn, &cs);
          *(f32x2*)(rope + (size_t)idx * 2) = (f32x2){(float)cs, (float)sn}; } }
    if (gw < 32) { const int kv = gw >> 4, kc = gw & 15; const float* pe = a.in[kv ? 10 : 9] + kc * 256; const float* w1 = a.in[kv ? 13 : 11] + (size_t)kc * 256 * 256; f32x4 s = (f32x4){0.f, 0.f, 0.f, 0.f};
#pragma unroll 8
        for (int k = 0; k < 256; ++k) s += pe[k] * *(const f32x4*)(w1 + (size_t)k * 256 + 4 * lane);
        *(f32x4*)((float*)(ws + WS_B1) + (kv * 16 + kc) * 256 + 4 * lane) = s; }
}

__device__ __forceinline__ void vtrans_item(const bf16_t* __restrict__ src, bf16_t* __restrict__ dst, LAS bf16_t* scr, int lane) {
    const int ch = lane & 15, tr = lane >> 4;
    u32x4 v[16];
#pragma unroll
    for (int it = 0; it < 16; ++it) v[it] = *(const u32x4*)(src + (size_t)(tr + 4 * it) * 512 + ch * 8);
#pragma unroll
    for (int it = 0; it < 16; ++it) { const int t = tr + 4 * it; const unsigned w[4] = {v[it].x, v[it].y, v[it].z, v[it].w};
#pragma unroll
        for (int j = 0; j < 4; ++j) { scr[(ch * 8 + 2 * j) * 72 + t] = (bf16_t)(w[j] & 0xffffu); scr[(ch * 8 + 2 * j + 1) * 72 + t] = (bf16_t)(w[j] >> 16); } }
    LDS_WAIT(); asm volatile("" ::: "memory");
    const int c8 = lane & 7, dr = lane >> 3;
#pragma unroll
    for (int rr = 0; rr < 16; ++rr) { const int d = rr * 8 + dr; const u32x4 o = *(const LAS u32x4*)(scr + d * 72 + c8 * 8); *(u32x4*)(dst + (size_t)d * T + c8 * 8) = o; }
    LDS_WAIT(); asm volatile("" ::: "memory");
}

constexpr int NSA_MK = 131072, NSA_WUN = 133120, NSA_BUN = 133632, NSA_JL = 133696, NSA_NJ = 133952;
__device__ __forceinline__ float red16_max(float m) { auto rr = __builtin_amdgcn_permlane16_swap(__float_as_uint(m), __float_as_uint(m), false, false); return fmaxf(__uint_as_float(rr[0]), __uint_as_float(rr[1])); }
__device__ __forceinline__ float red32_max(float m) { auto rr = __builtin_amdgcn_permlane32_swap(__float_as_uint(m), __float_as_uint(m), false, false); return fmaxf(__uint_as_float(rr[0]), __uint_as_float(rr[1])); }
__device__ __forceinline__ float red16_sum(float m) { auto rr = __builtin_amdgcn_permlane16_swap(__float_as_uint(m), __float_as_uint(m), false, false); return __uint_as_float(rr[0]) + __uint_as_float(rr[1]); }
__device__ __forceinline__ float red32_sum(float m) { auto rr = __builtin_amdgcn_permlane32_swap(__float_as_uint(m), __float_as_uint(m), false, false); return __uint_as_float(rr[0]) + __uint_as_float(rr[1]); }
#define DPP_I(x, ctrl) __builtin_amdgcn_mov_dpp((x), (ctrl), 0xF, 0xF, true)
__device__ __forceinline__ float wave_max_dpp(float v) {
    v = fmaxf(v, __builtin_bit_cast(float, DPP_I(__builtin_bit_cast(int, v), 0xB1)));
    v = fmaxf(v, __builtin_bit_cast(float, DPP_I(__builtin_bit_cast(int, v), 0x4E)));
    v = fmaxf(v, __builtin_bit_cast(float, DPP_I(__builtin_bit_cast(int, v), 0x141)));
    v = fmaxf(v, __builtin_bit_cast(float, DPP_I(__builtin_bit_cast(int, v), 0x140)));
    return red32_max(red16_max(v));
}
__device__ __forceinline__ unsigned umin_(unsigned a, unsigned b) { return a < b ? a : b; }
__device__ __forceinline__ unsigned wave_min_dpp(unsigned v) {
    v = umin_(v, (unsigned)DPP_I((int)v, 0xB1)); v = umin_(v, (unsigned)DPP_I((int)v, 0x4E)); v = umin_(v, (unsigned)DPP_I((int)v, 0x141)); v = umin_(v, (unsigned)DPP_I((int)v, 0x140));
    { auto rr = __builtin_amdgcn_permlane16_swap(v, v, false, false); v = umin_(rr[0], rr[1]); }
    { auto rr = __builtin_amdgcn_permlane32_swap(v, v, false, false); v = umin_(rr[0], rr[1]); }
    return v;
}
__device__ __forceinline__ float quad_sum(float v) {
    int x = __builtin_bit_cast(int, v);
    float a = v + __builtin_bit_cast(float, __builtin_amdgcn_mov_dpp(x, 0xB1, 0xF, 0xF, true));
    int y = __builtin_bit_cast(int, a);
    return a + __builtin_bit_cast(float, __builtin_amdgcn_mov_dpp(y, 0x4E, 0xF, 0xF, true));
}
struct StageLane { unsigned kp[2], vp[2]; };
__device__ __forceinline__ StageLane stage_lane(int wave, int lane) {
    StageLane L;
#pragma unroll
    for (int k = 0; k < 2; ++k) { const int rho = 4 * (2 * wave + k) + (lane >> 4), pos = lane & 15, i = rho & 15, c = pos ^ i, key = 32 * (rho >> 5) + 8 * (i >> 2) + (i & 3) + 4 * ((rho >> 4) & 1);
        L.kp[k] = (unsigned)key | ((unsigned)c << 8);
        const int r = 8 * (2 * wave + k) + (lane >> 3), pv = lane & 7, cv = pv ^ ((r >> 1) & 7); L.vp[k] = (unsigned)r | ((unsigned)cv << 8); }
    return L;
}
__device__ __forceinline__ void nsa_stage(LAS unsigned char* buf, const bf16_t* Kp, int kshift, const bf16_t* Vp, int vshift, bool doV, int wave, const StageLane& L) {
#pragma unroll
    for (int k = 0; k < 2; ++k) { const unsigned off = ((L.kp[k] & 255u) << kshift) + ((L.kp[k] >> 8) << 4);
        __builtin_amdgcn_global_load_lds((const unsigned*)((const char*)Kp + off), (LAS unsigned*)(buf + (2 * wave + k) * 1024), 16, 0, 0); }
    if (doV) {
#pragma unroll
        for (int k = 0; k < 2; ++k) { const unsigned off = ((L.vp[k] & 255u) << vshift) + ((L.vp[k] >> 8) << 4);
            __builtin_amdgcn_global_load_lds((const unsigned*)((const char*)Vp + off), (LAS unsigned*)(buf + 16384 + (2 * wave + k) * 1024), 16, 0, 0); } }
}
__device__ __forceinline__ bf16x8 lds_k(const LAS unsigned char* buf, int h, int tt, int ks, int i, int g) { return *(const LAS bf16x8*)(buf + (16 * (2 * h + tt) + i) * 256 + (((4 * ks + g) ^ i) << 4)); }
__device__ __forceinline__ bf16x8 lds_v(const LAS unsigned char* buf, int h, int dt, int i, int g) { return *(const LAS bf16x8*)(buf + 16384 + (16 * dt + i) * 128 + (((4 * h + g) ^ (i >> 1)) << 4)); }
__device__ __forceinline__ void nsa_scores(const CT (&ct)[2], const LAS unsigned char* buf, int h, const bool (&act)[2], int i, int g, f32x4 (&s)[2][2]) {
#pragma unroll
    for (int c = 0; c < 2; ++c) { s[c][0] = (f32x4){0.f, 0.f, 0.f, 0.f}; s[c][1] = (f32x4){0.f, 0.f, 0.f, 0.f}; }
#pragma unroll
    for (int ks = 0; ks < 4; ++ks) { const bf16x8 ka = lds_k(buf, h, 0, ks, i, g), kb = lds_k(buf, h, 1, ks, i, g);
#pragma unroll
        for (int c = 0; c < 2; ++c) if (act[c]) { s[c][0] = mfma16(ka, ct[c].q[ks], s[c][0]); s[c][1] = mfma16(kb, ct[c].q[ks], s[c][1]); } }
}
template <bool DO_PV>
__device__ __forceinline__ bf16x8 nsa_softmax(CT& c, const f32x4 (&s)[2], const bool (&valid)[8]) {
    float sv[8];
#pragma unroll
    for (int e = 0; e < 8; ++e) sv[e] = valid[e] ? s[e >> 2][e & 3] : NEGF;
    float mx = fmaxf(fmaxf(fmaxf(sv[0], sv[1]), fmaxf(sv[2], sv[3])), fmaxf(fmaxf(sv[4], sv[5]), fmaxf(sv[6], sv[7])));
    mx = red16_max(mx); mx = red32_max(mx);
    const float mnew = fmaxf(c.m, mx), alpha = __builtin_amdgcn_exp2f((c.m - mnew) * L2E);
    float p[8], ps = 0.f;
#pragma unroll
    for (int e = 0; e < 8; ++e) { p[e] = valid[e] ? __builtin_amdgcn_exp2f((sv[e] - mnew) * L2E) : 0.f; ps += p[e]; }
    c.l = c.l * alpha + ps; c.m = mnew;
    if (DO_PV) {
#pragma unroll
        for (int d = 0; d < 8; ++d) c.o[d] = c.o[d] * alpha;
    }
    u32x4 w; w.x = cvt_pk_bf16(p[0], p[1]); w.y = cvt_pk_bf16(p[2], p[3]); w.z = cvt_pk_bf16(p[4], p[5]); w.w = cvt_pk_bf16(p[6], p[7]);
    return __builtin_bit_cast(bf16x8, w);
}
__device__ __forceinline__ void nsa_pv(CT (&ct)[2], const LAS unsigned char* buf, int h, const bool (&act)[2], const bf16x8 (&pb)[2], int i, int g) {
#pragma unroll
    for (int d = 0; d < 8; ++d) { const bf16x8 vf = lds_v(buf, h, d, i, g);
#pragma unroll
        for (int c = 0; c < 2; ++c) if (act[c]) ct[c].o[d] = mfma16(vf, pb[c], ct[c].o[d]); }
}
__device__ __forceinline__ float ct_lsum2(const CT& c) { return red32_sum(red16_sum(c.l)); }

template <int MASK>
__device__ __forceinline__ void nsa_slc_tile(CT (&ct)[2], const LAS unsigned char* buf, const bool (&selq)[2], const int (&myq)[2], const int j, const int i16, const int g4) {
    const bool act[2] = {(MASK & 1) != 0, (MASK & 2) != 0};
#pragma unroll
    for (int h = 0; h < 2; ++h) { f32x4 s[2][2]; nsa_scores(ct, buf, h, act, i16, g4, s);
        bf16x8 pb[2];
#pragma unroll
        for (int c = 0; c < 2; ++c) if (act[c]) { bool valid[8];
#pragma unroll
            for (int e = 0; e < 8; ++e) valid[e] = selq[c] && (64 * j + 32 * h + 8 * g4 + e <= myq[c]);
            pb[c] = nsa_softmax<true>(ct[c], s[c], valid); }
        nsa_pv(ct, buf, h, act, pb, i16, g4); }
}
#define PIN8(x) asm volatile("" : "+v"((x)[0]), "+v"((x)[1]), "+v"((x)[2]), "+v"((x)[3]), "+v"((x)[4]), "+v"((x)[5]), "+v"((x)[6]), "+v"((x)[7]))
template <int C>
__device__ __forceinline__ void nsa_slc_fast(CT (&ct)[2], const LAS unsigned char* buf, const bool selq, const int i16, const int g4) {
    CT& c = ct[C];
    f32x4 s[2][2];
#pragma unroll
    for (int h = 0; h < 2; ++h) { s[h][0] = (f32x4){0.f, 0.f, 0.f, 0.f}; s[h][1] = (f32x4){0.f, 0.f, 0.f, 0.f};
        bf16x8 kf[8];
#pragma unroll
        for (int ks = 0; ks < 4; ++ks) { kf[2 * ks] = lds_k(buf, h, 0, ks, i16, g4); kf[2 * ks + 1] = lds_k(buf, h, 1, ks, i16, g4); }
        PIN8(kf);
#pragma unroll
        for (int ks = 0; ks < 4; ++ks) { s[h][0] = mfma16(kf[2 * ks], c.q[ks], s[h][0]); s[h][1] = mfma16(kf[2 * ks + 1], c.q[ks], s[h][1]); } }
    bf16x8 vf[8];
#pragma unroll
    for (int d = 0; d < 8; ++d) vf[d] = lds_v(buf, 0, d, i16, g4);
    float mx = fmaxf(fmaxf(fmaxf(s[0][0].x, s[0][0].y), fmaxf(s[0][0].z, s[0][0].w)), fmaxf(fmaxf(s[0][1].x, s[0][1].y), fmaxf(s[0][1].z, s[0][1].w)));
    mx = fmaxf(mx, fmaxf(fmaxf(fmaxf(s[1][0].x, s[1][0].y), fmaxf(s[1][0].z, s[1][0].w)), fmaxf(fmaxf(s[1][1].x, s[1][1].y), fmaxf(s[1][1].z, s[1][1].w))));
    mx = selq ? mx : NEGF;
    mx = red16_max(mx); mx = red32_max(mx);
    const float mnew = fmaxf(c.m, mx), nb = -mnew * L2E;
    if (__builtin_amdgcn_ballot_w64(mnew != c.m) != 0ull) {
        const float alpha = __builtin_amdgcn_exp2f((c.m - mnew) * L2E); c.l *= alpha; c.m = mnew;
#pragma unroll
        for (int d = 0; d < 8; ++d) c.o[d] = c.o[d] * alpha;
    }
    const unsigned keep = selq ? 0xffffffffu : 0u; float ps = 0.f;
    bf16x8 pb[2];
#pragma unroll
    for (int h = 0; h < 2; ++h) { float p[8];
#pragma unroll
        for (int e = 0; e < 8; ++e) { p[e] = __builtin_amdgcn_exp2f(__builtin_fmaf(s[h][e >> 2][e & 3], L2E, nb)); ps += p[e]; }
        u32x4 w; w.x = cvt_pk_bf16(p[0], p[1]) & keep; w.y = cvt_pk_bf16(p[2], p[3]) & keep; w.z = cvt_pk_bf16(p[4], p[5]) & keep; w.w = cvt_pk_bf16(p[6], p[7]) & keep;
        pb[h] = __builtin_bit_cast(bf16x8, w); }
    c.l += selq ? ps : 0.f;
    PIN8(vf);
#pragma unroll
    for (int d = 0; d < 8; ++d) c.o[d] = mfma16(vf[d], pb[0], c.o[d]);
#pragma unroll
    for (int d = 0; d < 8; ++d) vf[d] = lds_v(buf, 1, d, i16, g4);
    PIN8(vf);
#pragma unroll
    for (int d = 0; d < 8; ++d) c.o[d] = mfma16(vf[d], pb[1], c.o[d]);
}
#define NSA_WAITV(n) asm volatile("s_waitcnt vmcnt(" #n ")" ::: "memory")
#define NSA_BAR() do { asm volatile("" ::: "memory"); __builtin_amdgcn_s_barrier(); asm volatile("" ::: "memory"); } while (0)
__device__ __forceinline__ void nsa_unit(const unsigned char* ws, const int Tq, const int grp, LAS unsigned char* lds, const int wave, const int lane_in) {
    int lane = lane_in; asm volatile("" : "+v"(lane));
    const unsigned char* r1 = ws + WS_R1;
    const bf16_t* qb = (const bf16_t*)(r1 + R_Q);
#define kc ((const bf16_t*)(r1 + R_KC) + (size_t)grp * 1024 * 128)
#define vct ((const bf16_t*)(r1 + R_VCT) + (size_t)grp * 128 * 1024)
#define ks ((const bf16_t*)(r1 + R_KS) + grp * 128)
#define vst ((const bf16_t*)(r1 + R_VST) + (size_t)grp * 128 * T)
#define kw ((const bf16_t*)(r1 + R_KW) + grp * 128)
#define vwt ((const bf16_t*)(r1 + R_VWT) + (size_t)grp * 128 * T)
    const float* gates = (const float*)(ws + WS_GATES); unsigned char* ob = (unsigned char*)(ws + WS_R1 + R_BLKK); float* part = (float*)(ws + WS_R1 + R_O);
    float* imp_own = (float*)(ws + WS_IMP) + (size_t)blockIdx.x * 32768 + wave * 8 * 256;
    LAS unsigned* mk = (LAS unsigned*)(lds + NSA_MK);
    LAS unsigned* wun = (LAS unsigned*)(lds + NSA_WUN);
    LAS unsigned* bun = (LAS unsigned*)(lds + NSA_BUN);
    LAS unsigned char* jl = (LAS unsigned char*)(lds + NSA_JL);
    LAS int* njp = (LAS int*)(lds + NSA_NJ);
    const int i16 = lane & 15, g4 = lane >> 4, qi = i16 >> 2, hd = grp * 4 + (i16 & 3);
    const int q0 = Tq * 64 + wave * 8;
    const StageLane SL = stage_lane(wave, lane);
    int myq[2]; CT ct[2];
#pragma unroll
    for (int c = 0; c < 2; ++c) { myq[c] = q0 + 4 * c + qi;
#pragma unroll
        for (int ksx = 0; ksx < 4; ++ksx) ct[c].q[ksx] = *(const bf16x8*)(qb + (size_t)myq[c] * 2048 + hd * 128 + 32 * ksx + 8 * g4); }
    const bool act2[2] = {true, true};
    VM_WAIT(); NSA_BAR();
    if (threadIdx.x < 8) bun[threadIdx.x] = 0u;
    const int nst = (4 * Tq + 3 + 63) >> 6;
    {
    ct_init(ct[0]); ct_init(ct[1]);
#pragma unroll
    for (int p = 0; p < 3; ++p) if (p < nst) nsa_stage(lds + p * 32768, kc + (size_t)(64 * p) * 128, 8, vct, 11, false, wave, SL);
    const int nfull = nst > 2 ? nst - 2 : 0;
    auto p1step = [&](const int st, auto MK) { constexpr bool MASKED = decltype(MK)::value;
        if (st + 2 < nst) NSA_WAITV(4); else if (st + 1 < nst) NSA_WAITV(2); else NSA_WAITV(0);
        NSA_BAR();
        if (st + 3 < nst) nsa_stage(lds + ((st + 3) & 3) * 32768, kc + (size_t)(64 * (st + 3)) * 128, 8, vct, 11, false, wave, SL);
        const LAS unsigned char* buf = lds + (st & 3) * 32768;
#pragma unroll
        for (int h = 0; h < 2; ++h) { f32x4 s[2][2]; nsa_scores(ct, buf, h, act2, i16, g4, s);
#pragma unroll
            for (int c = 0; c < 2; ++c) { bool valid[8];
#pragma unroll
                for (int e = 0; e < 8; ++e) { const int cidx = 64 * st + 32 * h + 8 * g4 + e; valid[e] = MASKED ? (16 * cidx + 31 <= myq[c]) : true; }
                (void)nsa_softmax<false>(ct[c], s[c], valid); } } };
    for (int st = 0; st < nfull; ++st) p1step(st, std::false_type{});
    for (int st = nfull; st < nst; ++st) p1step(st, std::true_type{});
    float mfin[2], linv[2];
#pragma unroll
    for (int c = 0; c < 2; ++c) { const float l = ct_lsum2(ct[c]); mfin[c] = ct[c].m; linv[c] = l > 0.f ? 1.0f / l : 0.f; }
    VM_WAIT(); NSA_BAR();
#pragma unroll
    for (int p = 0; p < 3; ++p) if (p < nst) nsa_stage(lds + p * 32768, kc + (size_t)(64 * p) * 128, 8, vct + 64 * p, 11, true, wave, SL);
    auto p2step = [&](const int st, auto MK) { constexpr bool MASKED = decltype(MK)::value;
        if (st + 2 < nst) NSA_WAITV(8); else if (st + 1 < nst) NSA_WAITV(4); else NSA_WAITV(0);
        NSA_BAR();
        if (st + 3 < nst) nsa_stage(lds + ((st + 3) & 3) * 32768, kc + (size_t)(64 * (st + 3)) * 128, 8, vct + 64 * (st + 3), 11, true, wave, SL);
        const LAS unsigned char* buf = lds + (st & 3) * 32768;
#pragma unroll
        for (int h = 0; h < 2; ++h) { f32x4 s[2][2]; nsa_scores(ct, buf, h, act2, i16, g4, s);
            bf16x8 pb[2];
#pragma unroll
            for (int c = 0; c < 2; ++c) { float p[8];
#pragma unroll
                for (int e = 0; e < 8; ++e) { const int cidx = 64 * st + 32 * h + 8 * g4 + e; const bool valid = MASKED ? (16 * cidx + 31 <= myq[c]) : true;
                    p[e] = valid ? __builtin_amdgcn_exp2f((s[c][e >> 2][e & 3] - mfin[c]) * L2E) * linv[c] : 0.f; }
                u32x4 w; w.x = cvt_pk_bf16(p[0], p[1]); w.y = cvt_pk_bf16(p[2], p[3]); w.z = cvt_pk_bf16(p[4], p[5]); w.w = cvt_pk_bf16(p[6], p[7]);
                pb[c] = __builtin_bit_cast(bf16x8, w);
#pragma unroll
                for (int e = 0; e < 8; ++e) p[e] = quad_sum(p[e]);
                if ((lane & 3) == 0) { float* row = imp_own + (4 * c + qi) * 256;
#pragma unroll
                    for (int tt = 0; tt < 2; ++tt) { const int j = 16 * st + 8 * h + 2 * g4 + tt;
                        row[j] = 2.f * (p[4 * tt] + p[4 * tt + 1] + p[4 * tt + 2]) + p[4 * tt + 3];
                        if (j + 1 < 256) row[16384 + j + 1] = p[4 * tt + 3]; } }
            }
            nsa_pv(ct, buf, h, act2, pb, i16, g4);
        } };
    for (int st = 0; st < nfull; ++st) p2step(st, std::false_type{});
    for (int st = nfull; st < nst; ++st) p2step(st, std::true_type{});
    }
#pragma unroll
    for (int c = 0; c < 2; ++c) { int ln = lane; asm volatile("" : "+v"(ln)); const int hd_ = grp * 4 + (ln & 3), mq_ = q0 + 4 * c + ((ln & 15) >> 2), g4_ = ln >> 4;
        const float gt = gates[(size_t)mq_ * 48 + 0 * 16 + hd_]; float* pp = part + (size_t)mq_ * 2048 + hd_ * 128 + 4 * g4_;
#pragma unroll
        for (int d = 0; d < 8; ++d) *(f32x4*)(pp + 16 * d) = ct[c].o[d] * gt; }
    VM_WAIT();
    const int curT = q0 >> 6;
    float vall[8][4];
#pragma unroll
    for (int qq = 0; qq < 8; ++qq)
#pragma unroll
        for (int k = 0; k < 4; ++k) { const int j = lane + 64 * k; const bool cand = (curT + 1 > 16) & (j >= 1) & (j <= curT - 2); const int jj = cand ? j : 1;
            const float v = __hip_atomic_load(imp_own + qq * 256 + jj, __ATOMIC_RELAXED, __HIP_MEMORY_SCOPE_AGENT) + __hip_atomic_load(imp_own + 16384 + qq * 256 + jj, __ATOMIC_RELAXED, __HIP_MEMORY_SCOPE_AGENT);
            vall[qq][k] = cand ? v : -1.f; }
#pragma unroll
    for (int qq = 0; qq < 8; ++qq) {
        const int cur = curT; bool sel[4]; float val[4];
#pragma unroll
        for (int k = 0; k < 4; ++k) { const int j = lane + 64 * k;
            if (cur + 1 <= 16) { sel[k] = (j <= cur); val[k] = -1.f; }
            else { sel[k] = (j == 0) | (j == cur) | (j == cur - 1); val[k] = vall[qq][k]; } }
        if (cur + 1 > 16) {
            int key[4];
#pragma unroll
            for (int k = 0; k < 4; ++k) key[k] = __float_as_int(val[k]);
            auto count_ge = [&](const int cand) { int cnt = 0;
#pragma unroll
                for (int k = 0; k < 4; ++k) cnt += __builtin_popcountll(__ballot(key[k] >= cand));
                return cnt; };
            int thr = count_ge(1 << 30) >= 13 ? (1 << 30) : 0;
            for (int b = 28; b >= 0; b -= 2) {
                const int c1 = thr | (1 << b), c2 = thr | (2 << b), c3 = thr | (3 << b);
                const int n1 = count_ge(c1), n2 = count_ge(c2), n3 = count_ge(c3);
                thr = n3 >= 13 ? c3 : (n2 >= 13 ? c2 : (n1 >= 13 ? c1 : thr)); }
            int above = 0;
#pragma unroll
            for (int k = 0; k < 4; ++k) above += __builtin_popcountll(__ballot(key[k] > thr));
            int rem = 13 - above;
#pragma unroll
            for (int k = 0; k < 4; ++k) { const bool eq = (key[k] == thr); const unsigned long long E = __ballot(eq);
                const int rank = (int)__builtin_amdgcn_mbcnt_hi((unsigned)(E >> 32), __builtin_amdgcn_mbcnt_lo((unsigned)E, 0u));
                sel[k] = sel[k] | (key[k] > thr) | (eq & (rank < rem)); rem -= __builtin_popcountll(E); }
        }
#pragma unroll
        for (int k = 0; k < 4; ++k) { const unsigned long long bb = __ballot(sel[k]); if (lane == 0) { mk[(wave * 8 + qq) * 8 + 2 * k] = (unsigned)bb; mk[(wave * 8 + qq) * 8 + 2 * k + 1] = (unsigned)(bb >> 32); } }
    }
    LDS_WAIT(); asm volatile("" ::: "memory");
    if (lane < 16) { const int c = lane >> 3, w8 = lane & 7; const LAS unsigned* m0 = mk + (wave * 8 + 4 * c) * 8 + w8; const unsigned u = m0[0] | m0[8] | m0[16] | m0[24];
        wun[(wave * 2 + c) * 8 + w8] = u; (void)__hip_atomic_fetch_or(bun + w8, u, __ATOMIC_RELAXED, __HIP_MEMORY_SCOPE_WORKGROUP); }
    LDS_WAIT(); NSA_BAR();
    if (threadIdx.x < 256) { const int j = threadIdx.x; unsigned below = 0;
#pragma unroll
        for (int w8 = 0; w8 < 8; ++w8) { const unsigned u = bun[w8]; below += (w8 < (j >> 5)) ? __builtin_popcount(u) : 0; if (j == 255 && w8 == 7) {} }
        const unsigned uw = bun[j >> 5]; if ((uw >> (j & 31)) & 1u) jl[below + __builtin_popcount(uw & ((1u << (j & 31)) - 1u))] = (unsigned char)j;
        if (j == 0) { int n = 0;
#pragma unroll
            for (int w8 = 0; w8 < 8; ++w8) n += __builtin_popcount(bun[w8]); njp[0] = n; } }
    LDS_WAIT(); NSA_BAR();
    {
    ct_init(ct[0]); ct_init(ct[1]);
    {
        const int nj = __builtin_amdgcn_readfirstlane(njp[0]);
        const int nm = nj - 1, np = (nm + 1) >> 1;
        if (nm > 0) { const int j0 = __builtin_amdgcn_readfirstlane((int)jl[0]); nsa_stage(lds, ks + (size_t)(64 * j0) * 512, 10, vst + 64 * j0, 15, true, wave, SL);
          if (1 < nm) { const int j1 = __builtin_amdgcn_readfirstlane((int)jl[1]); nsa_stage(lds + 32768, ks + (size_t)(64 * j1) * 512, 10, vst + 64 * j1, 15, true, wave, SL); } }
        else nsa_stage(lds, ks + (size_t)(64 * Tq) * 512, 10, vst + 64 * Tq, 15, true, wave, SL);
        for (int p = 0; p < np; ++p) {
            NSA_WAITV(0); NSA_BAR();
            { LAS unsigned char* nb = lds + ((p + 1) & 1) * 65536;
              if (p + 1 < np) {
                const int j0 = __builtin_amdgcn_readfirstlane((int)jl[2 * p + 2]); nsa_stage(nb, ks + (size_t)(64 * j0) * 512, 10, vst + 64 * j0, 15, true, wave, SL);
                if (2 * p + 3 < nm) { const int j1 = __builtin_amdgcn_readfirstlane((int)jl[2 * p + 3]); nsa_stage(nb + 32768, ks + (size_t)(64 * j1) * 512, 10, vst + 64 * j1, 15, true, wave, SL); } }
              else nsa_stage(nb, ks + (size_t)(64 * Tq) * 512, 10, vst + 64 * Tq, 15, true, wave, SL); }
#pragma unroll
            for (int bq = 0; bq < 2; ++bq) {
                if (2 * p + bq < nm) {
                    const int j = __builtin_amdgcn_readfirstlane((int)jl[2 * p + bq]);
                    const LAS unsigned char* buf = lds + (p & 1) * 65536 + bq * 32768;
                    bool act[2], selq[2];
#pragma unroll
                    for (int c = 0; c < 2; ++c) { act[c] = (__builtin_amdgcn_readfirstlane(wun[(wave * 2 + c) * 8 + (j >> 5)]) >> (j & 31)) & 1u; selq[c] = (mk[(wave * 8 + 4 * c + qi) * 8 + (j >> 5)] >> (j & 31)) & 1u; }
                    if (act[0]) nsa_slc_fast<0>(ct, buf, selq[0], i16, g4);
                    if (act[1]) nsa_slc_fast<1>(ct, buf, selq[1], i16, g4);
                }
            }
        }
        NSA_WAITV(0); NSA_BAR();
        { const int j = Tq; const LAS unsigned char* buf = lds + (np & 1) * 65536;
          bool act[2], selq[2];
#pragma unroll
          for (int c = 0; c < 2; ++c) { act[c] = (__builtin_amdgcn_readfirstlane(wun[(wave * 2 + c) * 8 + (j >> 5)]) >> (j & 31)) & 1u; selq[c] = (mk[(wave * 8 + 4 * c + qi) * 8 + (j >> 5)] >> (j & 31)) & 1u; }
          if (act[0]) nsa_slc_tile<1>(ct, buf, selq, myq, j, i16, g4);
          if (act[1]) nsa_slc_tile<2>(ct, buf, selq, myq, j, i16, g4); }
    }
    }
#pragma unroll
    for (int c = 0; c < 2; ++c) { int ln = lane; asm volatile("" : "+v"(ln)); const int hd_ = grp * 4 + (ln & 3), mq_ = q0 + 4 * c + ((ln & 15) >> 2), g4_ = ln >> 4;
        const float l = ct_lsum2(ct[c]); const float gt = gates[(size_t)mq_ * 48 + 1 * 16 + hd_] * (l > 0.f ? 1.0f / l : 0.f); float* pp = part + (size_t)mq_ * 2048 + hd_ * 128 + 4 * g4_;
#pragma unroll
        for (int d = 0; d < 8; ++d) *(f32x4*)(pp + 16 * d) = *(const f32x4*)(pp + 16 * d) + ct[c].o[d] * gt; }
    {
    ct_init(ct[0]); ct_init(ct[1]);
    VM_WAIT(); NSA_BAR();
    { const int kb0 = (Tq >= 8 ? Tq - 8 : 0), nw = Tq - kb0 + 1;
#pragma unroll
      for (int p = 0; p < 3; ++p) if (p < nw) { const int tp = kb0 + p; nsa_stage(lds + p * 32768, kw + (size_t)(64 * tp) * 512, 10, vwt + 64 * tp, 15, true, wave, SL); }
      auto wstep = [&](const int st, auto MK) { constexpr bool MASKED = decltype(MK)::value;
          if (st + 2 < nw) NSA_WAITV(8); else if (st + 1 < nw) NSA_WAITV(4); else NSA_WAITV(0);
          NSA_BAR();
          if (st + 3 < nw) { const int tp = kb0 + st + 3; nsa_stage(lds + ((st + 3) & 3) * 32768, kw + (size_t)(64 * tp) * 512, 10, vwt + 64 * tp, 15, true, wave, SL); }
          const LAS unsigned char* buf = lds + (st & 3) * 32768;
#pragma unroll
          for (int h = 0; h < 2; ++h) { f32x4 s[2][2]; nsa_scores(ct, buf, h, act2, i16, g4, s);
              bf16x8 pb[2];
#pragma unroll
              for (int c = 0; c < 2; ++c) { bool valid[8];
#pragma unroll
                  for (int e = 0; e < 8; ++e) { const int key = 64 * (kb0 + st) + 32 * h + 8 * g4 + e; valid[e] = MASKED ? ((key <= myq[c]) & (key > myq[c] - 512)) : true; }
                  pb[c] = nsa_softmax<true>(ct[c], s[c], valid); }
              nsa_pv(ct, buf, h, act2, pb, i16, g4); } };
      wstep(0, std::true_type{});
      for (int st = 1; st + 1 < nw; ++st) wstep(st, std::false_type{});
      if (nw > 1) wstep(nw - 1, std::true_type{});
    }
    }
#pragma unroll
    for (int c = 0; c < 2; ++c) { int ln = lane; asm volatile("" : "+v"(ln)); const int hd_ = grp * 4 + (ln & 3), mq_ = q0 + 4 * c + ((ln & 15) >> 2), g4_ = ln >> 4;
        const float l = ct_lsum2(ct[c]); const float gt = gates[(size_t)mq_ * 48 + 2 * 16 + hd_] * (l > 0.f ? 1.0f / l : 0.f); const float* pp = part + (size_t)mq_ * 2048 + hd_ * 128 + 4 * g4_;
        unsigned char* po = ob + (size_t)mq_ * 2048 + hd_ * 128 + 4 * g4_;
#pragma unroll
        for (int d = 0; d < 8; ++d) {
            const f32x4 o = (*(const f32x4*)(pp + 16 * d) + ct[c].o[d] * gt) * 64.f;
            *(unsigned*)(po + 16 * d) = pk4_fp8(o.x, o.y, o.z, o.w); } }
}

#undef kc
#undef vct
#undef ks
#undef vst
#undef kw
#undef vwt
__device__ __forceinline__ void memattn_wave(const unsigned char* ws, int layer, int wu, int lane) {
    const int hd = wu & 3, qb0 = (wu >> 2) * 32; const int col = lane & 15, g4 = lane >> 4;
    const bf16_t* qm = (const bf16_t*)(ws + WS_QM); bf16_t* om = (bf16_t*)(ws + WS_OM);
    const bf16_t* km = (const bf16_t*)(ws + WS_KM) + (size_t)layer * 256 * 512 + hd * 128; const bf16_t* vmt = (const bf16_t*)(ws + WS_VMT) + (size_t)layer * 512 * 256 + (size_t)hd * 128 * 256;
    CT ct[2];
#pragma unroll
    for (int c = 0; c < 2; ++c) { ct_init(ct[c]);
#pragma unroll
        for (int ksx = 0; ksx < 4; ++ksx) ct[c].q[ksx] = *(const bf16x8*)(qm + (size_t)(qb0 + 16 * c + col) * 512 + hd * 128 + 32 * ksx + 8 * g4); }
    const bf16_t* k0 = km + (size_t)(8 * (col >> 2) + (col & 3)) * 512 + 8 * g4;
    const bf16_t* v0 = vmt + (size_t)col * 256 + 8 * g4;
    bf16x8 kf[8];
#pragma unroll
    for (int ks = 0; ks < 4; ++ks) { kf[2 * ks] = *(const bf16x8*)(k0 + 32 * ks); kf[2 * ks + 1] = *(const bf16x8*)(k0 + 4 * 512 + 32 * ks); }
#pragma unroll 1
    for (int st = 0; st < 8; ++st) {
        bf16x8 vf[8];
#pragma unroll
        for (int d = 0; d < 8; ++d) vf[d] = *(const bf16x8*)(v0 + (size_t)(16 * d) * 256 + 32 * st);
        PIN8(kf);
        f32x4 s[2][2];
#pragma unroll
        for (int c = 0; c < 2; ++c) { s[c][0] = (f32x4){0.f, 0.f, 0.f, 0.f}; s[c][1] = (f32x4){0.f, 0.f, 0.f, 0.f}; }
#pragma unroll
        for (int ks = 0; ks < 4; ++ks) {
#pragma unroll
            for (int c = 0; c < 2; ++c) { s[c][0] = mfma16(kf[2 * ks], ct[c].q[ks], s[c][0]); s[c][1] = mfma16(kf[2 * ks + 1], ct[c].q[ks], s[c][1]); } }
        if (st < 7) {
#pragma unroll
            for (int ks = 0; ks < 4; ++ks) { kf[2 * ks] = *(const bf16x8*)(k0 + (size_t)(32 * (st + 1)) * 512 + 32 * ks); kf[2 * ks + 1] = *(const bf16x8*)(k0 + (size_t)(32 * (st + 1) + 4) * 512 + 32 * ks); } }
        bf16x8 pb[2]; const bool valid[8] = {true, true, true, true, true, true, true, true};
#pragma unroll
        for (int c = 0; c < 2; ++c) pb[c] = nsa_softmax<true>(ct[c], s[c], valid);
        PIN8(vf);
#pragma unroll
        for (int d = 0; d < 8; ++d) {
#pragma unroll
            for (int c = 0; c < 2; ++c) ct[c].o[d] = mfma16(vf[d], pb[c], ct[c].o[d]); }
    }
#pragma unroll
    for (int c = 0; c < 2; ++c) { const float li = 1.0f / ct_lsum2(ct[c]);
#pragma unroll
        for (int d = 0; d < 8; ++d) { const f32x4 o = ct[c].o[d] * li; u32x2 w; w.x = cvt_pk_bf16(o.x, o.y); w.y = cvt_pk_bf16(o.z, o.w);
            *(u32x2*)(om + (size_t)(qb0 + 16 * c + col) * 512 + hd * 128 + 16 * d + 4 * g4) = w; } }
}

__device__ __forceinline__ void memattn_block(const unsigned char* ws, int layer, LAS unsigned char* lds, int blk, int G, int wave, int lane_in) {
    int lane = lane_in; asm volatile("" : "+v"(lane));
    const int hd = blk & 3, slot = blk >> 2, nb = G >> 2; const int col = lane & 15, g4 = lane >> 4;
    const bf16_t* qm = (const bf16_t*)(ws + WS_QM); bf16_t* om = (bf16_t*)(ws + WS_OM);
    const bf16_t* km = (const bf16_t*)(ws + WS_KM) + (size_t)layer * 256 * 512 + hd * 128; const bf16_t* vmt = (const bf16_t*)(ws + WS_VMT) + (size_t)layer * 512 * 256 + (size_t)hd * 128 * 256;
    const StageLane SL = stage_lane(wave, lane);
#pragma unroll
    for (int t = 0; t < 4; ++t) nsa_stage(lds + t * 32768, km + (size_t)(64 * t) * 512, 10, vmt + 64 * t, 9, true, wave, SL);
    const bool act2[2] = {true, true}; const bool valid[8] = {true, true, true, true, true, true, true, true};
    bool first = true;
    for (int tq = slot * NWAVES + wave; tq < T / 32; tq += nb * NWAVES) {
        const int qb0 = tq * 32;
        CT ct[2];
#pragma unroll
        for (int c = 0; c < 2; ++c) { ct_init(ct[c]);
#pragma unroll
            for (int ksx = 0; ksx < 4; ++ksx) ct[c].q[ksx] = *(const bf16x8*)(qm + (size_t)(qb0 + 16 * c + col) * 512 + hd * 128 + 32 * ksx + 8 * g4); }
        if (first) { VM_WAIT(); NSA_BAR(); first = false; }
#pragma unroll 1
        for (int t = 0; t < 4; ++t) { const LAS unsigned char* buf = lds + t * 32768;
#pragma unroll
            for (int h = 0; h < 2; ++h) { f32x4 s[2][2]; nsa_scores(ct, buf, h, act2, col, g4, s);
                bf16x8 pb[2];
#pragma unroll
                for (int c = 0; c < 2; ++c) pb[c] = nsa_softmax<true>(ct[c], s[c], valid);
                nsa_pv(ct, buf, h, act2, pb, col, g4); } }
#pragma unroll
        for (int c = 0; c < 2; ++c) { const float li = 1.0f / ct_lsum2(ct[c]);
#pragma unroll
            for (int d = 0; d < 8; ++d) { const f32x4 o = ct[c].o[d] * li; u32x2 w; w.x = cvt_pk_bf16(o.x, o.y); w.y = cvt_pk_bf16(o.z, o.w);
                *(u32x2*)(om + (size_t)(qb0 + 16 * c + col) * 512 + hd * 128 + 16 * d + 4 * g4) = w; } }
    }
    if (first) { VM_WAIT(); NSA_BAR(); }
}

__device__ __forceinline__ void pool_body(const int W, const float* __restrict__ h, const float* __restrict__ gain, bf16_t* __restrict__ dbuf, const LAS float* rs, int t0, int tid) {
    const int c0 = 4 * tid; const f32x4 g = *(const f32x4*)(gain + c0);
    f32x4 sum = (f32x4){0.f, 0.f, 0.f, 0.f};
    for (int i = 1; i < W; ++i) { const int t = t0 - i; if (t >= 0) sum += (*(const f32x4*)(h + (size_t)t * D + c0) * rs[15 - i]) * g; }
    for (int tc = 0; tc < 64; tc += 8) {
        f32x4 un[8], uo[8];
#pragma unroll
        for (int k = 0; k < 8; ++k) { const int t = t0 + tc + k, told = t - W + 1;
            un[k] = *(const f32x4*)(h + (size_t)t * D + c0); uo[k] = *(const f32x4*)(h + (size_t)(told >= 0 ? told : 0) * D + c0); }
#pragma unroll
        for (int k = 0; k < 8; ++k) { const int tt = tc + k, t = t0 + tt, told = t - W + 1; const f32x4 u = (un[k] * rs[15 + tt]) * g; sum += u;
            const float inv = 1.0f / (float)((t + 1 < W) ? (t + 1) : W); const f32x4 d = sum * inv - u;
            u32x2 w; w.x = cvt_pk_bf16(d.x, d.y); w.y = cvt_pk_bf16(d.z, d.w); *(u32x2*)(dbuf + (size_t)t * D + c0) = w;
            if (told >= 0) sum -= (uo[k] * rs[15 + tt - W + 1]) * g; }
    }
}

#define IN(k) (lo <= (k) && (k) < hi)
#define PH(k) ((((PHASE_MASK) >> (k)) & 1u) && IN(k))
#define SEAM(k) do { if ((((PHASE_MASK) >> ((k) + 1)) & 1u) && IN((k) + 1)) xcd_barrier(bar); } while (0)
template <int layer>
__device__ __forceinline__ void mem_layer(const Args& a, LAS unsigned char* lds, const XcdBarrier& bar, int lo, int hi, int G, int blk, int gw, int ngw, int lane) {
    using namespace gm;
    unsigned char* ws = a.ws;
    bf16_t* APA = (bf16_t*)(ws + WS_APA); bf16_t* APB = (bf16_t*)(ws + WS_APB); float* H = (float*)(ws + WS_H); float* SSQ = (float*)(ws + WS_SSQ);
        const int pq = layer ? 13 : 6;
        bf16_t* apin = layer ? APA : APB;
        if (PH(pq)) {
            Sched S; S.o.init(T / 256, 2, G, blk); S.A = (const char*)apin; S.B = (const char*)(ws + WS_MWQ) + (size_t)layer * 512 * D; S.a_tile = 256ull * D; S.b_tile = 256ull * D; S.pn_shift = 30; S.a_pn_bytes = 0; S.tile_e = nullptr; S.b_exp = 0;
            EpiMemQ E{(bf16_t*)(ws + WS_QM), SSQ};
            gemm_phase<EpiMemQ, Sched, false, true, 121, 125>(lds, D / 128, D, D, S, E, nullptr);
            {
                const int wave = __builtin_amdgcn_readfirstlane((int)threadIdx.x >> 6); const int r0 = layer ? TR_D2 : TR_D1, r1 = layer ? TR_D3 : TR_D2;
                if (G > 128) { if (blk >= 128) tr_moe_range(a, (LAS float*)(lds + wave * 8448), r0, r1, (blk - 128) * NWAVES + wave, (G - 128) * NWAVES, lane); }
                else { __syncthreads(); tr_moe_range(a, (LAS float*)(lds + wave * 8448), r0, r1, gw, ngw, lane); } }
#if (REPEAT_MASK & 64u)
            xcd_barrier(bar); gemm_phase<EpiMemQ, Sched, false>(lds, D / 64, D, D, S, E, nullptr);
#endif
            SEAM(pq);
        }
        if (PH(pq + 1)) {
            if ((G & 3) == 0) memattn_block(ws, layer, lds, blk, G, __builtin_amdgcn_readfirstlane((int)threadIdx.x >> 6), lane);
            else for (int wu = gw; wu < 2048; wu += ngw) memattn_wave(ws, layer, wu, lane);
            SEAM(pq + 1);
        }
        if (PH(pq + 2)) {
            Sched S; S.o.init(T / 256, 8, G, blk); S.A = (const char*)(ws + WS_OM); S.B = (const char*)(ws + WS_MWO) + (size_t)layer * D * 512 * 2; S.a_tile = 256ull * 512 * 2; S.b_tile = 256ull * 512 * 2; S.pn_shift = 30; S.a_pn_bytes = 0; S.tile_e = nullptr; S.b_exp = 0;
            if (layer == 0) { EpiRes<true, true, false> E{H, H, APA, a.in[5], SSQ, nullptr, nullptr}; gemm_phase<EpiRes<true, true, false>, Sched, false>(lds, 512 / 64, 512, 512, S, E, nullptr); }
            else { EpiRes<false, false, false> E{H, H, nullptr, nullptr, nullptr, nullptr, nullptr}; gemm_phase<EpiRes<false, false, false>, Sched, false>(lds, 512 / 64, 512, 512, S, E, nullptr); }
            SEAM(pq + 2);
        }
}
#undef IN
#undef PH
#undef SEAM
constexpr int NPHASE = 21;
__global__ void __launch_bounds__(NTHREADS, 2) mega_fwd(Args a) {
    extern __shared__ __attribute__((aligned(16))) unsigned char lds_raw[];
    LAS unsigned char* lds = (LAS unsigned char*)lds_raw;
    const int tid = threadIdx.x, lane = tid & 63, wave = __builtin_amdgcn_readfirstlane(tid >> 6);
    const int G = gridDim.x, blk = blockIdx.x, gw = blk * NWAVES + wave, ngw = G * NWAVES;
    unsigned char* ws = a.ws;
    volatile LAS unsigned* MISC = (volatile LAS unsigned*)(lds + MISC_OFF);
    if (tid < 64) MISC[tid] = 0u;
    __syncthreads();
    XcdBarrier bar = xcd_barrier_post((unsigned*)(ws + WS_CTL) + CW_BAR, MISC + 8);
    const int lo = a.ph_lo, hi = a.ph_hi;
#define IN(k) (lo <= (k) && (k) < hi)
#define PH(k) ((((PHASE_MASK) >> (k)) & 1u) && IN(k))
#define SEAM(k) do { if ((((PHASE_MASK) >> ((k) + 1)) & 1u) && IN((k) + 1)) xcd_barrier(bar); } while (0)
    using namespace gm;
    bf16_t* APA = (bf16_t*)(ws + WS_APA); bf16_t* APB = (bf16_t*)(ws + WS_APB); float* H = (float*)(ws + WS_H); float* SSQ = (float*)(ws + WS_SSQ);
    unsigned char* r1 = ws + WS_R1;

    if (PH(0)) {
#if (REPEAT_MASK & 1u)
        phase_prologue(a, lds, gw, ngw, wave, lane); xcd_barrier(bar);
#endif
        phase_prologue(a, lds, gw, ngw, wave, lane); SEAM(0); }

    if (PH(1)) {
        Sched S; S.o.init(T / 256, 20, G, blk); S.A = (const char*)APA; S.B = (const char*)(ws + WS_WIN); S.a_tile = 256ull * D; S.b_tile = 256ull * D; S.pn_shift = 30; S.a_pn_bytes = 0; S.tile_e = nullptr; S.b_exp = 0;
        EpiInProj E{(bf16_t*)(r1 + R_Q), (bf16_t*)(r1 + R_BLKK), (bf16_t*)(r1 + R_BLKV), (bf16_t*)(r1 + R_KS), (bf16_t*)(r1 + R_VS), (bf16_t*)(r1 + R_KW), (bf16_t*)(r1 + R_VW), (const float*)(ws + WS_ROPE)};
        gemm_phase<EpiInProj, Sched, false, true, 121, 125>(lds, D / 128, D, D, S, E, nullptr);
#if (REPEAT_MASK & 2u)
        xcd_barrier(bar); gemm_phase<EpiInProj, Sched, false>(lds, D / 64, D, D, S, E, nullptr);
#endif
        SEAM(1);
    }
    if (PH(2)) {
        if (blk < 32) { const int kv = blk >> 4, pm = blk & 15;
            OneUnit S; S.on = true; S.u.pm = pm; S.u.pn = 0; S.u.x0 = kv; S.u.x1 = 0; S.u.A = (const char*)(r1 + (kv ? R_BLKV : R_BLKK)) + (size_t)pm * 256 * 4096; S.u.B = (const char*)(ws + WS_C1) + (size_t)kv * 256 * 4096;
            EpiCmp1 E{(bf16_t*)(r1 + R_HID), (const float*)(ws + WS_B1)};
            gemm_phase<EpiCmp1, OneUnit, false, true, 121, 125>(lds, 4096 / 128, 4096, 4096, S, E, nullptr);
            VM_WAIT(); __syncthreads();
            OneUnit S2; S2.on = true; S2.u.pm = pm; S2.u.pn = 0; S2.u.x0 = kv; S2.u.x1 = 0; S2.u.A = (const char*)(r1 + R_HID) + ((size_t)kv * 4096 + pm * 256) * 256 * 2; S2.u.B = (const char*)(ws + WS_C2) + (size_t)kv * 256 * 256 * 2;
            EpiCmp2 E2{(bf16_t*)(r1 + R_KC), (bf16_t*)(r1 + R_VCT), (const float*)(ws + WS_ROPE)};
            gemm_phase<EpiCmp2, OneUnit, false>(lds, 256 / 64, 256, 256, S2, E2, nullptr);
        } else if (blk < 96) { const int pm = blk - 32;
            OneUnit S; S.on = true; S.u.pm = pm; S.u.pn = 0; S.u.x0 = 0; S.u.x1 = 0; S.u.A = (const char*)APA + (size_t)pm * 256 * D; S.u.B = (const char*)(ws + WS_WG);
            EpiGates E{(float*)(ws + WS_GATES), a.in[8]};
            gemm_phase<EpiGates, OneUnit, false, true, 121, 125>(lds, D / 128, D, D, S, E, nullptr);
        } else if (blk < 104) { const int l = (blk - 96) >> 2, pn = (blk - 96) & 3;
            OneUnit S; S.on = true; S.u.pm = 0; S.u.pn = pn; S.u.x0 = l; S.u.x1 = 0; S.u.A = (const char*)(ws + WS_MEMN) + (size_t)l * 256 * D * 2; S.u.B = (const char*)(ws + WS_MWKV) + ((size_t)l * 1024 + pn * 256) * D * 2;
            EpiMemKV E{(bf16_t*)(ws + WS_KM), (bf16_t*)(ws + WS_VMT)};
            gemm_phase<EpiMemKV, OneUnit, false>(lds, D / 64, D, D, S, E, nullptr);
        } else {
            LAS bf16_t* scr = (LAS bf16_t*)(lds + wave * 18432);
            const int w0 = (blk - 104) * NWAVES + wave, nw = (G - 104) * NWAVES;
            for (int it = w0; it < 2048; it += nw) { const int which = it >> 10, g = (it >> 8) & 3, tb = it & 255;
                vtrans_item((const bf16_t*)(r1 + (which ? R_VW : R_VS)) + (size_t)(tb * 64) * 512 + g * 128, (bf16_t*)(r1 + (which ? R_VWT : R_VST)) + (size_t)(g * 128) * T + tb * 64, scr, lane); }
            tr_moe_range(a, (LAS float*)(lds + wave * 18432), TR_D0, TR_D1, w0, nw, lane);
        }
        SEAM(2);
    }
    if (PH(4)) {
        unsigned* nsaq = (unsigned*)(ws + WS_CTL) + CW_NSAQ;
        for (;;) {
            if (tid == 0) MISC[16] = __hip_atomic_fetch_add(nsaq, 1u, __ATOMIC_RELAXED, __HIP_MEMORY_SCOPE_AGENT);
            __syncthreads();
            const unsigned u = MISC[16];
            if (u >= 1024u) break;
            nsa_unit(ws, 255 - (int)(u >> 2), (int)(u & 3u), lds, wave, lane);
            __syncthreads();
            { int ln = threadIdx.x; asm volatile("" : "+v"(ln)); ln &= 63;
              const int n0 = (int)u * TR_PER_UNIT, n1 = n0 + TR_PER_UNIT < TRN_TOTAL ? n0 + TR_PER_UNIT : TRN_TOTAL; tr_burst_nsa<4>(a, (LAS float*)(lds + wave * 8448), n0, n1, wave, NWAVES, ln); }
        }
        VM_WAIT(); __syncthreads();
        SEAM(4);
    }
    if (PH(5)) {
        Sched S; S.o.init(T / 256, 8, G, blk); S.A = (const char*)(r1 + R_BLKK); S.B = (const char*)(ws + WS_WOUT); S.a_tile = 256ull * D; S.b_tile = 256ull * D; S.pn_shift = 30; S.a_pn_bytes = 0; S.tile_e = nullptr; S.b_exp = 0;
        EpiRes<true, true, false, true> E{a.in[0], H, APB, a.in[3], SSQ, nullptr, nullptr};
        gemm_phase<EpiRes<true, true, false, true>, Sched, false, true, 121, 121>(lds, D / 128, D, D, S, E, nullptr);
        SEAM(5);
    }
    mem_layer<0>(a, lds, bar, lo, hi, G, blk, gw, ngw, lane);
        if (PH(9)) {
            Sched S; S.o.init(T / 256, 44, G, blk); S.A = (const char*)APA; S.B = (const char*)(ws + WS_FGU); S.a_tile = 256ull * D * 2; S.b_tile = 256ull * D * 2; S.pn_shift = 30; S.a_pn_bytes = 0; S.tile_e = nullptr; S.b_exp = 0;
            EpiSwiglu<true, true> E{(bf16_t*)r1, SSQ};
            gemm_phase<EpiSwiglu<true, true>, Sched, false>(lds, D / 64, D, D, S, E, nullptr);
#if (REPEAT_MASK & 512u)
            xcd_barrier(bar); gemm_phase<EpiSwiglu<true>, Sched, false>(lds, D / 64, D, D, S, E, nullptr);
#endif
            SEAM(9);
        }
        if (PH(10)) {
            Sched S; S.o.init(T / 256, 8, G, blk); S.A = (const char*)r1; S.B = (const char*)(ws + WS_FD); S.a_tile = 256ull * DFF; S.b_tile = 256ull * DFF; S.pn_shift = 30; S.a_pn_bytes = 0; S.tile_e = nullptr; S.b_exp = 0;
            EpiRes<false, true, false> E{H, H, nullptr, nullptr, SSQ, nullptr, nullptr};
            gemm_phase<EpiRes<false, true, false>, Sched, false, true, 120, 123>(lds, DFF / 128, DFF, DFF, S, E, nullptr);
            SEAM(10);
        }
        if (PH(11)) {
            LAS float* rs = (LAS float*)lds;
            for (int rep = 0; rep < ((PROBE_SMALL & 2) ? 3 : 1); ++rep) for (int tb = blk; tb < T / 64; tb += G) {
                const int t0 = tb * 64;
                if (tid < 79) { const int t = t0 - 15 + tid; float v = 0.f;
                    if (t >= 0) { const f32x4* sp = (const f32x4*)(SSQ + (size_t)t * 32); f32x4 s4 = sp[0];
#pragma unroll
                        for (int j = 1; j < 8; ++j) s4 += sp[j];
                        v = __builtin_amdgcn_rsqf(((s4.x + s4.y) + (s4.z + s4.w)) * (1.0f / D) + EPS); }
                    rs[tid] = v; }
                __syncthreads();
                const float* gain = a.in[2] + D;
                const int grp = tid >> 7;
                pool_body(2 << grp, H, gain, APB, rs, t0, tid);
                __syncthreads();
            }
            SEAM(11);
        }
        if (PH(12)) {
            Sched S; S.o.init(T / 256, 8, G, blk); S.A = (const char*)APB; S.B = (const char*)(ws + WS_PW); S.a_tile = 256ull * D * 2; S.b_tile = 256ull * 512 * 2; S.pn_shift = 1; S.a_pn_bytes = 512 * 2; S.tile_e = nullptr; S.b_exp = 0;
            EpiRes<true, true, true, true> E{H, H, APA, a.in[3] + D, SSQ, a.in[17], a.in[18]};
            gemm_phase<EpiRes<true, true, true, true>, Sched, false>(lds, 512 / 64, D, 512, S, E, nullptr);
            SEAM(12);
        }
    mem_layer<1>(a, lds, bar, lo, hi, G, blk, gw, ngw, lane);
    int* moi = (int*)(ws + WS_MOE); float* mof = (float*)(ws + WS_MOE);
    if (PH(16)) {
        int lane = threadIdx.x; asm volatile("" : "+v"(lane)); lane &= 63;
        LAS float* rl = (LAS float*)lds; LAS int* cnt = (LAS int*)(lds + 512 * 144);
        const float* router = a.in[26];
        for (int idx = tid; idx < 2048 * 8; idx += NTHREADS) { const int k = idx >> 3, e = idx & 7; rl[(k >> 2) * 36 + (k & 3) * 8 + e] = router[idx]; }
        for (int rep = 0; rep < ((PROBE_SMALL & 4) ? 3 : 1); ++rep) for (int tb = blk; tb < T / 64; tb += G) {
            if (tid < 8) cnt[tid] = 0;
            __syncthreads();
            const f32x4* gr = (const f32x4*)(a.in[5] + D) + lane;
            for (int i = 0; i < 8; ++i) {
                const int t = tb * 64 + wave * 8 + i;
                const f32x4* xr = (const f32x4*)(H + (size_t)t * D) + lane; f32x4 v[8]; float s = 0.f;
#pragma unroll
                for (int j = 0; j < 8; ++j) { v[j] = xr[64 * j]; s += (v[j].x * v[j].x + v[j].y * v[j].y) + (v[j].z * v[j].z + v[j].w * v[j].w); }
                const float r = __builtin_amdgcn_rsqf(wave_sum(s) * (1.0f / D) + EPS);
                float lg[8];
#pragma unroll
                for (int e = 0; e < 8; ++e) lg[e] = 0.f;
                unsigned* o8 = (unsigned*)((unsigned char*)APA + (size_t)t * D) + lane;
#pragma unroll
                for (int j = 0; j < 8; ++j) { const f32x4 u = (v[j] * r) * gr[64 * j]; o8[64 * j] = pk4_fp8(4.f * u.x, 4.f * u.y, 4.f * u.z, 4.f * u.w);
                    const LAS float* base = rl + (lane + 64 * j) * 36;
#pragma unroll
                    for (int rr = 0; rr < 4; ++rr) { const f32x4 w0 = *(const LAS f32x4*)(base + rr * 8), w1 = *(const LAS f32x4*)(base + rr * 8 + 4); const float uv = u[rr];
                        lg[0] += uv * w0.x; lg[1] += uv * w0.y; lg[2] += uv * w0.z; lg[3] += uv * w0.w; lg[4] += uv * w1.x; lg[5] += uv * w1.y; lg[6] += uv * w1.z; lg[7] += uv * w1.w; } }
#pragma unroll
                for (int e = 0; e < 8; ++e) lg[e] = wave_sum(lg[e]);
                int e0 = 0; float v0 = lg[0];
#pragma unroll
                for (int e = 1; e < 8; ++e) if (lg[e] > v0) { v0 = lg[e]; e0 = e; }
                int e1 = -1; float v1 = -3.0e38f;
#pragma unroll
                for (int e = 0; e < 8; ++e) if (e != e0 && lg[e] > v1) { v1 = lg[e]; e1 = e; }
                if (e1 < 0) { e1 = (e0 + 1) & 7; v1 = v0; }
                if (lane == 0) { const float w0 = 1.0f / (1.0f + __expf(v1 - v0)); moi[MO_TOPI + 2 * t] = e0; moi[MO_TOPI + 2 * t + 1] = e1; mof[MO_TOPW + 2 * t] = w0; mof[MO_TOPW + 2 * t + 1] = 1.0f - w0;
                    (void)__hip_atomic_fetch_add(cnt + e0, 1, __ATOMIC_RELAXED, __HIP_MEMORY_SCOPE_WORKGROUP); (void)__hip_atomic_fetch_add(cnt + e1, 1, __ATOMIC_RELAXED, __HIP_MEMORY_SCOPE_WORKGROUP); }
            }
            __syncthreads();
            if (tid < 8) moi[MO_CNTB + tb * 8 + tid] = cnt[tid];
            __syncthreads();
        }
        SEAM(16);
    }
    if (PH(17)) {
        LAS int* li = (LAS int*)lds;
        for (int tb = blk; tb < T / 64; tb += G) {
            if (tid < 8) { int tot = 0, pre = 0; for (int b = 0; b < T / 64; ++b) { const int c = moi[MO_CNTB + b * 8 + tid]; tot += c; if (b < tb) pre += c; } li[tid] = tot; li[16 + tid] = pre; }
            if (tid >= 64 && tid < 192) li[32 + tid - 64] = moi[MO_TOPI + tb * 128 + (tid - 64)];
            __syncthreads();
            if (tid == 0) { int p = 0; for (int e = 0; e < 8; ++e) { li[8 + e] = p; p += (li[e] + 255) / 256 * 256; } li[24] = p; }
            __syncthreads();
            if (tid < 128) { const int e = li[32 + tid]; int rank = 0; for (int m2 = 0; m2 < tid; ++m2) rank += (li[32 + m2] == e) ? 1 : 0;
                const int slot = li[8 + e] + li[16 + e] + rank, pairi = tb * 128 + tid;
                moi[MO_TOKS + slot] = pairi >> 1; moi[MO_PAIR + slot] = pairi; mof[MO_GATE + slot] = mof[MO_TOPW + pairi]; moi[MO_SLOT + pairi] = slot; }
            if (tb == 0) {
                for (int e = 0; e < 8; ++e) { const int beg = li[8 + e] + li[e], end = li[8 + e] + (li[e] + 255) / 256 * 256;
                    for (int s = beg + tid; s < end; s += NTHREADS) { moi[MO_TOKS + s] = 0; moi[MO_PAIR + s] = -1; mof[MO_GATE + s] = 0.f; }
                    const int t0 = li[8 + e] / 256, t1 = end / 256; for (int tt = t0 + tid; tt < t1; tt += NTHREADS) moi[MO_TILEE + tt] = e; }
                if (tid == 0) moi[MO_NT] = li[24] / 256;
            }
            __syncthreads();
        }
        SEAM(17);
    }
    if (PH(18)) {
        const int ntile = __builtin_amdgcn_readfirstlane(moi[MO_NT]);
        Sched S; S.o.init(ntile, 44, G, blk); S.A = (const char*)APA; S.B = (const char*)(ws + WS_MGU); S.a_tile = 0; S.b_tile = 256ull * D; S.pn_shift = 30; S.a_pn_bytes = 0; S.tile_e = moi + MO_TILEE; S.b_exp = 11264ull * D;
        EpiSwiglu<false, true> E{(bf16_t*)r1, nullptr};
        gemm_phase<EpiSwiglu<false, true>, Sched, true, true, 121, 125>(lds, D / 128, D, D, S, E, moi + MO_TOKS);
        SEAM(18);
    }
    if (PH(19)) {
        const int ntile = __builtin_amdgcn_readfirstlane(moi[MO_NT]);
        const MoeSplit ms = moe_split(ntile, G);
        SchedSK S; S.o.init(ms.F, 8, G, blk); S.A = (const char*)r1; S.B = (const char*)(ws + WS_MD); S.a_tile = 256ull * DFF; S.b_tile = 256ull * DFF; S.tile_e = moi + MO_TILEE; S.b_exp = 2048ull * DFF; S.F = ms.F; S.R = ms.R; S.sk = ms.sk; S.G = G; S.c = blk;
        EpiMoeDown E{APA, moi + MO_PAIR, mof + MO_GATE, (float*)(ws + WS_PART), ms.F * 256, ms.R * 256};
        gemm_phase<EpiMoeDown, SchedSK, false, true, 120, 123, true>(lds, DFF / 128, DFF, DFF, S, E, nullptr);
        SEAM(19);
    }
    if (PH(20)) {
        int lane = threadIdx.x; asm volatile("" : "+v"(lane)); lane &= 63;
        const MoeSplit ms = moe_split(__builtin_amdgcn_readfirstlane(moi[MO_NT]), G); const int tail0 = ms.sk > 1 ? ms.F * 256 : 0x7fffffff; const float* part = (const float*)(ws + WS_PART);
        int sl0 = 0, sl1 = 0;
        if (gw < T) { sl0 = __builtin_amdgcn_readfirstlane(moi[MO_SLOT + 2 * gw]); sl1 = __builtin_amdgcn_readfirstlane(moi[MO_SLOT + 2 * gw + 1]); }
        for (int rep = 0; rep < ((PROBE_SMALL & 8) ? 3 : 1); ++rep) for (int t = gw; t < T; t += ngw) {
            const f32x4* xr = (const f32x4*)(H + (size_t)t * D) + lane;
            f32x4 v[8];
            const int c0 = sl0, c1 = sl1; const int tn = t + ngw < T ? t + ngw : t;
            sl0 = __builtin_amdgcn_readfirstlane(moi[MO_SLOT + 2 * tn]); sl1 = __builtin_amdgcn_readfirstlane(moi[MO_SLOT + 2 * tn + 1]);
            if (c0 < tail0 && c1 < tail0) {
                const u32x2* y0 = (const u32x2*)(APA + (size_t)(2 * t) * D) + lane; const u32x2* y1 = (const u32x2*)(APA + (size_t)(2 * t + 1) * D) + lane;
#pragma unroll
                for (int j = 0; j < 8; ++j) { const u32x2 p0 = y0[64 * j], p1 = y1[64 * j];
                    f32x4 x = xr[64 * j];
                    x.x += __uint_as_float(p0.x << 16) + __uint_as_float(p1.x << 16); x.y += __uint_as_float(p0.x & 0xffff0000u) + __uint_as_float(p1.x & 0xffff0000u);
                    x.z += __uint_as_float(p0.y << 16) + __uint_as_float(p1.y << 16); x.w += __uint_as_float(p0.y & 0xffff0000u) + __uint_as_float(p1.y & 0xffff0000u);
                    v[j] = x; }
            } else {
#pragma unroll
                for (int j = 0; j < 8; ++j) v[j] = xr[64 * j];
#pragma unroll
                for (int k = 0; k < 2; ++k) {
                    const int slot = k ? c1 : c0;
                    if (slot < tail0) { const u32x2* y = (const u32x2*)(APA + (size_t)(2 * t + k) * D) + lane;
#pragma unroll
                        for (int j = 0; j < 8; ++j) { const u32x2 p0 = y[64 * j];
                            v[j].x += __uint_as_float(p0.x << 16); v[j].y += __uint_as_float(p0.x & 0xffff0000u); v[j].z += __uint_as_float(p0.y << 16); v[j].w += __uint_as_float(p0.y & 0xffff0000u); } }
                    else {
                        f32x4 ys[8];
                        for (int ks = 0; ks < ms.sk; ++ks) { const f32x4* pr = (const f32x4*)(part + ((size_t)ks * (ms.R * 256) + (slot - tail0)) * D) + lane;
#pragma unroll
                            for (int j = 0; j < 8; ++j) { const f32x4 q = pr[64 * j]; ys[j] = ks ? ys[j] + q : q; } }
#pragma unroll
                        for (int j = 0; j < 8; ++j) v[j] += ys[j]; }
                }
            }
            float s = 0.f;
#pragma unroll
            for (int j = 0; j < 8; ++j) { const f32x4 x = v[j]; s += (x.x * x.x + x.y * x.y) + (x.z * x.z + x.w * x.w); }
            const float r = __builtin_amdgcn_rsqf(wave_sum(s) * (1.0f / D) + EPS);
            const f32x4* gr = (const f32x4*)a.in[6] + lane; f32x4* orow = (f32x4*)(a.out + (size_t)t * D) + lane;
#pragma unroll
            for (int j = 0; j < 8; ++j) orow[64 * j] = (v[j] * r) * gr[64 * j];
        }
    }
#undef IN
#undef PH
#undef SEAM
}

extern "C" void kernel_launch(void* const* d_in, const int* in_sizes, int n_in, void* d_out, int out_size, void* d_ws, size_t ws_size, hipStream_t stream) {
    static int grid = 0;
    if (grid == 0) {
        if (n_in != 30 || out_size != T * D || ws_size < WS_END) { fprintf(stderr, "kernel_launch: unexpected shapes (n_in %d, out %d, ws %zu < %zu)\n", n_in, out_size, ws_size, (size_t)WS_END); grid = -1; return; }
        int dev = 0, cus = 0, per_cu = 0;
        if (hipGetDevice(&dev) != hipSuccess || hipDeviceGetAttribute(&cus, hipDeviceAttributeMultiprocessorCount, dev) != hipSuccess) { grid = -1; return; }
        if (hipFuncSetAttribute((const void*)mega_fwd, hipFuncAttributeMaxDynamicSharedMemorySize, LDS_BYTES) != hipSuccess) { fprintf(stderr, "kernel_launch: hipFuncSetAttribute failed\n"); grid = -1; return; }
        if (hipOccupancyMaxActiveBlocksPerMultiprocessor(&per_cu, (const void*)mega_fwd, NTHREADS, LDS_BYTES) != hipSuccess || per_cu < 1) { fprintf(stderr, "kernel_launch: occupancy query says %d\n", per_cu); (void)hipGetLastError(); grid = -1; return; }
        grid = cus;
    }
    if (grid < 0) return;
    (void)hipMemsetAsync((char*)d_ws + WS_CTL, 0, 1 * MiB, stream);
    Args a{};
    for (int i = 0; i < 30; ++i) a.in[i] = (const float*)d_in[i];
    a.out = (float*)d_out; a.ws = (unsigned char*)d_ws;
#if N_LAUNCH_MODE == 1
    a.ph_lo = 0; a.ph_hi = NPHASE;
    hipLaunchKernelGGL(mega_fwd, dim3(grid), dim3(NTHREADS), LDS_BYTES, stream, a);
#else
    for (int p = 0; p < NPHASE; ++p) { a.ph_lo = p; a.ph_hi = p + 1; hipLaunchKernelGGL(mega_fwd, dim3(grid), dim3(NTHREADS), LDS_BYTES, stream, a); }
#endif
}
```
